# Optimizing an MI355X kernel written in HIP

```python
import math
import jax, jax.numpy as jnp
from jax import lax
import numpy as np

D_MODEL = 1024
BATCH = 16
SEQ = 2048
DEPTH = 2

CTX_LEN = 256
GRID_W = 64
EPS = 1e-6

MLSTM_HEADS = 4
MLSTM_HEAD_DIM = D_MODEL // 8
MLSTM_WIDTH = MLSTM_HEADS * MLSTM_HEAD_DIM
MLSTM_CHUNK = 128
FORGET_BIAS = 4.0
SGU_GROUPS = 4
SGU_WIDTH = D_MODEL // 4
SGU_CHUNK = 128
CONV_WIDTH = D_MODEL // 4
CONV_K = 31

MIX_WIDTH = MLSTM_WIDTH + SGU_WIDTH + CONV_WIDTH
FFN_HIDDEN = int(math.ceil(8 * D_MODEL / 3 / 256)) * 256

Q_OFF = 0
K_OFF = MLSTM_WIDTH
V_OFF = 2 * MLSTM_WIDTH
O_OFF = 3 * MLSTM_WIDTH
GATE_OFF = 4 * MLSTM_WIDTH
SGU_OFF = GATE_OFF + 4 * MLSTM_HEADS
CONV_OFF = SGU_OFF + 2 * SGU_WIDTH
IN_COLS = CONV_OFF + 2 * CONV_WIDTH

kernel_name = 'hybrid_mlstm_sgu_conv_dit_block'


def rmsnorm(t, g):
    t32 = t.astype(jnp.float32)
    y = t32 * lax.rsqrt(jnp.mean(t32 * t32, axis=-1, keepdims=True) + EPS)
    return (y * g).astype(t.dtype)


def layernorm(t, g, b):
    t32 = t.astype(jnp.float32)
    mu = jnp.mean(t32, axis=-1, keepdims=True)
    d = t32 - mu
    var = jnp.mean(d * d, axis=-1, keepdims=True)
    return (d * lax.rsqrt(var + EPS) * g + b).astype(t.dtype)


def swiglu(h, w_gu, w_down):
    gate, up = jnp.split(h @ w_gu, 2, axis=-1)
    return (jax.nn.silu(gate) * up) @ w_down


def mlstm_inputs(p):
    B, L, _ = p.shape
    def heads(t):
        return t.reshape(B, L, MLSTM_HEADS, MLSTM_HEAD_DIM).transpose(0, 2, 1, 3).astype(jnp.float32)
    q = heads(p[..., Q_OFF:K_OFF])
    k = heads(p[..., K_OFF:V_OFF]) * (MLSTM_HEAD_DIM ** -0.5)
    v = heads(p[..., V_OFF:O_OFF])
    g = p[..., GATE_OFF:SGU_OFF].astype(jnp.float32).reshape(B, L, 4, MLSTM_HEADS).transpose(2, 0, 3, 1)
    gates = (g[0], jax.nn.log_sigmoid(g[1]), g[2], jax.nn.log_sigmoid(g[3]))
    return q, k, v, gates


def zero_state(batch):
    return (jnp.zeros((batch, MLSTM_HEADS, MLSTM_HEAD_DIM, MLSTM_HEAD_DIM), jnp.float32),
            jnp.zeros((batch, MLSTM_HEADS, MLSTM_HEAD_DIM), jnp.float32),
            jnp.zeros((batch, MLSTM_HEADS), jnp.float32))


def mlstm_scan(q, k, v, logi, logf, state, with_output):
    B, H, L, d = q.shape
    nc = L // MLSTM_CHUNK
    def to_chunks(t):
        t = t.reshape((B, H, nc, MLSTM_CHUNK) + t.shape[3:])
        return jnp.moveaxis(t, 2, 0)
    xs = tuple(to_chunks(t) for t in (q, k, v, logi, logf))
    order = jnp.tril(jnp.ones((MLSTM_CHUNK, MLSTM_CHUNK), bool))

    def step(carry, inp):
        C, n, m = carry
        qc, kc, vc, ic, fc = inp
        b = jnp.cumsum(fc, axis=-1)
        b_last = b[..., -1]
        w_log = b_last[..., None] - b + ic
        m_new = jnp.maximum(b_last + m, jnp.max(w_log, axis=-1))
        decay = jnp.exp(b_last + m - m_new)
        ks = kc * jnp.exp(w_log - m_new[..., None])[..., None]
        C_new = decay[..., None, None] * C + jnp.einsum('bhsk,bhsv->bhkv', ks, vc)
        n_new = decay[..., None] * n + jnp.sum(ks, axis=2)
        if not with_output:
            return (C_new, n_new, m_new), None
        a = b + m[..., None]
        Dlog = b[..., :, None] - b[..., None, :] + ic[..., None, :]
        Dlog = jnp.where(order, Dlog, -jnp.inf)
        m_t = jnp.maximum(a, jnp.max(Dlog, axis=-1))
        w_inter = jnp.exp(a - m_t)
        s = jnp.einsum('bhtk,bhsk->bhts', qc, kc) * jnp.exp(Dlog - m_t[..., None])
        num = w_inter[..., None] * jnp.einsum('bhtk,bhkv->bhtv', qc, C) + jnp.einsum('bhts,bhsv->bhtv', s, vc)
        den = w_inter * jnp.einsum('bhtk,bhk->bht', qc, n) + jnp.sum(s, axis=-1)
        h = num / jnp.maximum(jnp.abs(den), jnp.exp(-m_t))[..., None]
        return (C_new, n_new, m_new), h

    state, hs = lax.scan(step, state, xs)
    if not with_output:
        return None, state
    h = jnp.moveaxis(hs, 0, 2).reshape(B, H, L, d)
    return h, state


def _flip(t):
    return jnp.flip(t, axis=2)


def mlstm_bidir(q, k, v, gates, init_f, init_b, with_output):
    logi_f, logf_f, logi_b, logf_b = gates
    h_f, st_f = mlstm_scan(q, k, v, logi_f, logf_f, init_f, with_output)
    h_b, st_b = mlstm_scan(_flip(q), _flip(k), _flip(v), _flip(logi_b), _flip(logf_b), init_b, with_output)
    h = h_f + _flip(h_b) if with_output else None
    return h, st_f, st_b


def mlstm_post(h, o_pre, g):
    B, H, L, d = h.shape
    h = h * lax.rsqrt(jnp.mean(h * h, axis=-1, keepdims=True) + EPS)
    h = h.transpose(0, 2, 1, 3).reshape(B, L, H * d) * g
    return (h * jax.nn.sigmoid(o_pre.astype(jnp.float32))).astype(o_pre.dtype)


def chunk_sgu(z, ln_g, ln_b, w_s, b_s):
    z = jax.nn.gelu(z)
    u, v = jnp.split(z, 2, axis=-1)
    v = layernorm(v, ln_g, ln_b)
    B, L, C = v.shape
    vg = v.reshape(B, L // SGU_CHUNK, SGU_CHUNK, SGU_GROUPS, C // SGU_GROUPS)
    mixed = jnp.einsum('gpq,bnqgc->bnpgc', w_s, vg) + b_s.T[:, :, None]
    return u * mixed.reshape(B, L, C)


def dwconv1d(y, w, b):
    kw, ch = w.shape
    out = lax.conv_general_dilated(y, w.reshape(kw, 1, ch).astype(y.dtype), window_strides=(1,),
                                   padding=[(kw // 2, kw // 2)], dimension_numbers=('NWC', 'WIO', 'NWC'),
                                   feature_group_count=ch)
    return out + b


def axial_dwconv(y, w, b):
    B, L, C = y.shape
    rows = L // GRID_W
    half = C // 2
    yr = dwconv1d(y[..., :half].reshape(B * rows, GRID_W, half), w[:, :half], b[:half]).reshape(B, L, half)
    yc = y[..., half:].reshape(B, rows, GRID_W, half).transpose(0, 2, 1, 3).reshape(B * GRID_W, rows, half)
    yc = dwconv1d(yc, w[:, half:], b[half:]).reshape(B, GRID_W, rows, half).transpose(0, 2, 1, 3).reshape(B, L, half)
    return jnp.concatenate([yr, yc], axis=-1)


def conformer_conv(z, w_dw, b_dw, ln_g, ln_b, grid):
    a, g = jnp.split(z, 2, axis=-1)
    y = a * jax.nn.sigmoid(g)
    y = axial_dwconv(y, w_dw, b_dw) if grid else dwconv1d(y, w_dw, b_dw)
    return jax.nn.silu(layernorm(y, ln_g, ln_b))


def mix_groups(p, h_mlstm, mlstm_g, sgu_ln_g, sgu_ln_b, sgu_w, sgu_b, conv_w, conv_b, conv_ln_g, conv_ln_b, grid):
    y_a = mlstm_post(h_mlstm, p[..., O_OFF:GATE_OFF], mlstm_g)
    y_b = chunk_sgu(p[..., SGU_OFF:CONV_OFF], sgu_ln_g, sgu_ln_b, sgu_w, sgu_b)
    y_c = conformer_conv(p[..., CONV_OFF:IN_COLS], conv_w, conv_b, conv_ln_g, conv_ln_b, grid)
    return jnp.concatenate([y_a, y_b, y_c], axis=-1)


def setup_inputs(seed: int = 0) -> dict:
    key = jax.random.key(seed)
    ks = jax.random.split(key, 24)
    def nrm(k, shape, scale):
        return jax.random.normal(k, shape, jnp.float32) * scale
    fb = np.zeros((IN_COLS,), np.float32)
    fb[GATE_OFF + MLSTM_HEADS:GATE_OFF + 2 * MLSTM_HEADS] = FORGET_BIAS
    fb[GATE_OFF + 3 * MLSTM_HEADS:GATE_OFF + 4 * MLSTM_HEADS] = FORGET_BIAS
    return {
        'x': nrm(ks[0], (BATCH, SEQ, D_MODEL), 1.0),
        'c': nrm(ks[1], (BATCH, D_MODEL), 1.0),
        'ctx': nrm(ks[2], (BATCH, CTX_LEN, D_MODEL), 1.0),
        'c_ctx': nrm(ks[3], (D_MODEL,), 1.0),
        'w_mod': nrm(ks[4], (DEPTH, D_MODEL, 6 * D_MODEL), 0.5 * D_MODEL ** -0.5),
        'b_mod': nrm(ks[5], (DEPTH, 6 * D_MODEL), 0.02),
        'norm1_g': 1.0 + nrm(ks[6], (DEPTH, D_MODEL), 0.02),
        'w_in': nrm(ks[7], (DEPTH, D_MODEL, IN_COLS), D_MODEL ** -0.5),
        'b_in': nrm(ks[8], (DEPTH, IN_COLS), 0.02) + jnp.asarray(fb),
        'mlstm_g': 1.0 + nrm(ks[9], (DEPTH, MLSTM_WIDTH), 0.02),
        'sgu_ln_g': 1.0 + nrm(ks[10], (DEPTH, SGU_WIDTH), 0.02),
        'sgu_ln_b': nrm(ks[11], (DEPTH, SGU_WIDTH), 0.02),
        'sgu_w': nrm(ks[12], (DEPTH, SGU_GROUPS, SGU_CHUNK, SGU_CHUNK), SGU_CHUNK ** -0.5),
        'sgu_b': nrm(ks[13], (DEPTH, SGU_GROUPS, SGU_CHUNK), 0.02),
        'conv_w': nrm(ks[14], (DEPTH, CONV_K, CONV_WIDTH), CONV_K ** -0.5),
        'conv_b': nrm(ks[15], (DEPTH, CONV_WIDTH), 0.02),
        'conv_ln_g': 1.0 + nrm(ks[16], (DEPTH, CONV_WIDTH), 0.02),
        'conv_ln_b': nrm(ks[17], (DEPTH, CONV_WIDTH), 0.02),
        'w_out': nrm(ks[18], (DEPTH, MIX_WIDTH, D_MODEL), MIX_WIDTH ** -0.5),
        'norm2_g': 1.0 + nrm(ks[19], (DEPTH, D_MODEL), 0.02),
        'w_gu': nrm(ks[20], (DEPTH, D_MODEL, 2 * FFN_HIDDEN), D_MODEL ** -0.5),
        'w_down': nrm(ks[21], (DEPTH, FFN_HIDDEN, D_MODEL), FFN_HIDDEN ** -0.5),
        'final_g': 1.0 + nrm(ks[22], (D_MODEL,), 0.02),
    }


def reference(x, c, ctx, c_ctx, w_mod, b_mod, norm1_g, w_in, b_in, mlstm_g, sgu_ln_g, sgu_ln_b, sgu_w, sgu_b,
              conv_w, conv_b, conv_ln_g, conv_ln_b, w_out, norm2_g, w_gu, w_down, final_g):
    batch = x.shape[0]
    c_act = jax.nn.silu(c)
    cc_act = jax.nn.silu(c_ctx)
    xc = ctx
    for l in range(DEPTH):
        last = l == DEPTH - 1
        mod = (c_act @ w_mod[l] + b_mod[l])[:, None, :]
        modc = cc_act @ w_mod[l] + b_mod[l]
        sh1, sc1, g1, sh2, sc2, g2 = jnp.split(mod, 6, axis=-1)
        shc1, scc1, gc1, shc2, scc2, gc2 = jnp.split(modc, 6, axis=-1)

        px = (rmsnorm(x, norm1_g[l]) * (1.0 + sc1) + sh1) @ w_in[l] + b_in[l]
        pc = (rmsnorm(xc, norm1_g[l]) * (1.0 + scc1) + shc1) @ w_in[l] + b_in[l]
        qx, kx, vx, gtx = mlstm_inputs(px)
        qc, kc, vc, gtc = mlstm_inputs(pc)
        zs = zero_state(batch)
        h_c, st_f, st_b = mlstm_bidir(qc, kc, vc, gtc, zs, zs, not last)
        h_x, _, _ = mlstm_bidir(qx, kx, vx, gtx, st_f, st_b, True)

        y_x = mix_groups(px, h_x, mlstm_g[l], sgu_ln_g[l], sgu_ln_b[l], sgu_w[l], sgu_b[l],
                         conv_w[l], conv_b[l], conv_ln_g[l], conv_ln_b[l], True)
        x = x + g1 * (y_x @ w_out[l])
        x = x + g2 * swiglu(rmsnorm(x, norm2_g[l]) * (1.0 + sc2) + sh2, w_gu[l], w_down[l])

        if not last:
            y_c = mix_groups(pc, h_c, mlstm_g[l], sgu_ln_g[l], sgu_ln_b[l], sgu_w[l], sgu_b[l],
                             conv_w[l], conv_b[l], conv_ln_g[l], conv_ln_b[l], False)
            xc = xc + gc1 * (y_c @ w_out[l])
            xc = xc + gc2 * swiglu(rmsnorm(xc, norm2_g[l]) * (1.0 + scc2) + shc2, w_gu[l], w_down[l])
    return rmsnorm(x, final_g)
```

```cpp
#include <hip/hip_runtime.h>
#include <cstdio>
#include <cstdint>
#ifndef MK_ONE_LAUNCH
#define MK_ONE_LAUNCH 0
#endif
namespace pg8 {
#define PG8_LAS __attribute__((address_space(3)))
typedef unsigned short bf16_t;
typedef short bf16x8 __attribute__((ext_vector_type(8)));
typedef float f32x4 __attribute__((ext_vector_type(4)));
typedef unsigned u32x4 __attribute__((ext_vector_type(4)));
constexpr int BM = 256, BK = 64, HALF = 128, HTB = HALF * BK * 2  , STAGE_BYTES = 8 * HTB, NXCD = 8, WGM = 8;

__host__ __device__ __forceinline__ int lds_byte(int r, int c) { const int st = (r >> 4) * 2 + (c >> 5), rr = r & 15, cc = c & 31, ob = rr * 64 + cc * 2; return st * 1024 + (ob ^ (((ob >> 9) & 1) << 5)); }
__host__ __device__ __forceinline__ void stage_rc(int b, int& R, int& C) { const int st = b / 1024, sb = b % 1024, swz = sb ^ (((sb >> 9) & 1) << 5); R = (st >> 1) * 16 + swz / 64; C = (st & 1) * 32 + (swz % 64) / 2; }
__host__ __device__ __forceinline__ int perm32(int rho) { const int n = rho >> 4, i = rho & 15; return 8 * (i >> 2) + 4 * n + (i & 3); }

struct Unit { int pm, pn; };
struct Gemm { const bf16_t* A; const bf16_t* Bt; int M, N, K; };

struct StaticOrder {
    int nM, nN, nwg, G, c;
    __host__ __device__ void init(int M, int N, int G_, int c_) { nM = M / BM; nN = N / BM; nwg = nM * nN; G = G_; c = c_; }
    __host__ __device__ bool next(int i, Unit& u) const {
        const long L = (long)i * G + c; if (L >= nwg) return false;
        int wgid = (int)L; { const int q = nwg / NXCD, r = nwg % NXCD, xcd = wgid % NXCD, off = wgid / NXCD; wgid = (xcd < r ? xcd * (q + 1) : r * (q + 1) + (xcd - r) * q) + off; }
        const int nig = WGM * nN, gid = wgid / nig, fm = gid * WGM, gsz = (nM - fm) < WGM ? (nM - fm) : WGM;
        u.pm = fm + ((wgid % nig) % gsz); u.pn = (wgid % nig) / gsz; return true;
    }
    __device__ __forceinline__ void a_ready(const Unit&) const {}
    __device__ __forceinline__ void done(const Unit&) const {}
};

__device__ __forceinline__ unsigned cvt_pk_bf16(float lo, float hi) { unsigned r; asm volatile("v_cvt_pk_bf16_f32 %0, %1, %2" : "=v"(r) : "v"(lo), "v"(hi)); return r; }
template <class Epi, class Sched, bool ALIGN_EPI = false, bool SP2 = false>
__device__ __forceinline__ void gemm_phase(PG8_LAS unsigned char* lds, const Gemm g, const Sched& S, const Epi& E, const int tid) {
    const int wid = __builtin_amdgcn_readfirstlane(tid >> 6), lane = tid & 63, wr = wid >> 2, wc = wid & 3, fr = lane & 15, fq = lane >> 4;
    const int K = g.K, nt = K / BK;
    unsigned voffA[2], voffB[2];
#pragma unroll
    for (int i = 0; i < 2; ++i) { int R, C; stage_rc(tid * 16 + i * 8192, R, C); const int Rb = Epi::PERM ? ((R & ~31) + perm32(R & 31)) : R;
        voffA[i] = (unsigned)(R * K + C) * 2u; voffB[i] = (unsigned)(Rb * K + C) * 2u; }
    const size_t kstep = (size_t)(BK * 2);
    const size_t hstep = (size_t)HALF * K * 2;
    const size_t tstep = 2 * hstep;
    const unsigned ldsw = (unsigned)wid * 1024u;
    const int aoff = lds_byte(wr * 64 + fr, fq * 8), boff = lds_byte(wc * 32 + fr, fq * 8);
#define PG8_SA(b, h) (((b) * 2 + (h)) * HTB)
#define PG8_SB(b, h) ((4 + (b) * 2 + (h)) * HTB)
#define PG8_STAGE(bufoff, gbase, voff) do { _Pragma("unroll") for (int _i = 0; _i < 2; ++_i) \
        __builtin_amdgcn_global_load_lds((const unsigned*)((const char*)(gbase) + (voff)[_i]), (PG8_LAS unsigned*)(lds + (bufoff) + ldsw + _i * 8192), 16, 0, 0); } while (0)
#define PG8_LDA(dst, b, h) do { _Pragma("unroll") for (int m = 0; m < 4; ++m) _Pragma("unroll") for (int k = 0; k < 2; ++k) dst[m][k] = *(const PG8_LAS bf16x8*)(lds + PG8_SA(b, h) + aoff + m * 2048 + k * 1024); } while (0)
#define PG8_LDB(dst, b, h) do { _Pragma("unroll") for (int n = 0; n < 2; ++n) _Pragma("unroll") for (int k = 0; k < 2; ++k) dst[n][k] = *(const PG8_LAS bf16x8*)(lds + PG8_SB(b, h) + boff + n * 2048 + k * 1024); } while (0)
#define PG8_MMA(ai, bj, At, Bt) do { __builtin_amdgcn_s_setprio(1); _Pragma("unroll") for (int m = 0; m < 4; ++m) _Pragma("unroll") for (int n = 0; n < 2; ++n) _Pragma("unroll") for (int k = 0; k < 2; ++k) \
        acc[ai][bj][m][n] = __builtin_amdgcn_mfma_f32_16x16x32_bf16(Bt[n][k], At[m][k], acc[ai][bj][m][n], 0, 0, 0); __builtin_amdgcn_s_setprio(0); } while (0)
#define PG8_WAIT_V(n) asm volatile("s_waitcnt vmcnt(" #n ")" ::: "memory")
#define PG8_WAIT_L(n) asm volatile("s_waitcnt lgkmcnt(" #n ")" ::: "memory")
#define PG8_BAR __builtin_amdgcn_s_barrier()
#define PG8_SCHED __builtin_amdgcn_sched_barrier(0)
    Unit cur, nxt; int ui = 0;
    if (!S.next(0, cur)) return;
    f32x4 acc[2][2][4][2];
#pragma unroll
    for (int a = 0; a < 2; ++a)
#pragma unroll
        for (int b = 0; b < 2; ++b)
#pragma unroll
            for (int m = 0; m < 4; ++m)
#pragma unroll
                for (int n = 0; n < 2; ++n) acc[a][b][m][n] = (f32x4){0.f, 0.f, 0.f, 0.f};
    bf16x8 At[4][2], B0[2][2], B1[2][2];
    const char* cA = (const char*)g.A + (size_t)cur.pm * tstep; const char* cB = (const char*)g.Bt + (size_t)cur.pn * tstep;
    S.a_ready(cur);
    if constexpr (SP2) {
        PG8_STAGE(PG8_SB(0, 0), cB, voffB); PG8_STAGE(PG8_SB(0, 1), cB + hstep, voffB); PG8_STAGE(PG8_SA(0, 0), cA, voffA); PG8_STAGE(PG8_SA(0, 1), cA + hstep, voffA);
        if (wr == 1) PG8_BAR;
        PG8_WAIT_V(2); PG8_BAR;
        PG8_STAGE(PG8_SB(1, 0), cB + kstep, voffB); PG8_STAGE(PG8_SA(1, 0), cA + kstep, voffA); PG8_STAGE(PG8_SB(1, 1), cB + hstep + kstep, voffB);
        PG8_WAIT_V(6); PG8_BAR;
    } else {
        PG8_STAGE(PG8_SB(0, 0), cB, voffB); PG8_STAGE(PG8_SA(0, 0), cA, voffA); PG8_STAGE(PG8_SB(0, 1), cB + hstep, voffB); PG8_STAGE(PG8_SA(0, 1), cA + hstep, voffA);
        if (wr == 1) PG8_BAR;
        PG8_WAIT_V(4); PG8_BAR;
        PG8_STAGE(PG8_SB(1, 0), cB + kstep, voffB); PG8_STAGE(PG8_SA(1, 0), cA + kstep, voffA); PG8_STAGE(PG8_SB(1, 1), cB + hstep + kstep, voffB);
        PG8_WAIT_V(6); PG8_BAR;
    }
    for (;;) {
        const bool has_next = S.next(ui + 1, nxt);
        const char* nA = has_next ? (const char*)g.A + (size_t)nxt.pm * tstep : cA; const char* nB = has_next ? (const char*)g.Bt + (size_t)nxt.pn * tstep : cB;
        for (int t = 0; t < nt; t += 2) {
            const bool last = (t == nt - 2);
            const char* a1 = cA + (size_t)(t + 1) * kstep;
            const char* a2 = last ? nA : cA + (size_t)(t + 2) * kstep; const char* b2 = last ? nB : cB + (size_t)(t + 2) * kstep;
            const char* a3 = a2 + kstep; const char* b3 = b2 + kstep;
            if (last && has_next) S.a_ready(nxt);
            if constexpr (SP2) {
            PG8_LDB(B0, 0, 0); PG8_LDB(B1, 0, 1); PG8_SCHED; PG8_LDA(At, 0, 0); PG8_STAGE(PG8_SA(1, 1), a1 + hstep, voffA);
            PG8_WAIT_V(8); PG8_WAIT_L(0); PG8_BAR; PG8_MMA(0, 0, At, B0); PG8_MMA(0, 1, At, B1); PG8_BAR; PG8_SCHED;
            PG8_LDA(At, 0, 1); PG8_STAGE(PG8_SB(0, 0), b2, voffB); PG8_STAGE(PG8_SB(0, 1), b2 + hstep, voffB); PG8_STAGE(PG8_SA(0, 0), a2, voffA);
            PG8_WAIT_V(8); PG8_WAIT_L(0); PG8_BAR; PG8_MMA(1, 0, At, B0); PG8_MMA(1, 1, At, B1); PG8_BAR; PG8_SCHED;
            PG8_LDB(B0, 1, 0); PG8_LDB(B1, 1, 1); PG8_SCHED; PG8_LDA(At, 1, 0); PG8_STAGE(PG8_SA(0, 1), a2 + hstep, voffA);
            PG8_WAIT_V(8); PG8_WAIT_L(0); PG8_BAR; PG8_MMA(0, 0, At, B0); PG8_MMA(0, 1, At, B1); PG8_BAR; PG8_SCHED;
            PG8_LDA(At, 1, 1); PG8_STAGE(PG8_SB(1, 0), b3, voffB); PG8_STAGE(PG8_SB(1, 1), b3 + hstep, voffB); PG8_STAGE(PG8_SA(1, 0), a3, voffA);
            PG8_WAIT_V(8); PG8_WAIT_L(0); PG8_BAR; PG8_MMA(1, 0, At, B0); PG8_MMA(1, 1, At, B1); PG8_BAR; PG8_SCHED;
            } else {
            PG8_LDB(B0, 0, 0); PG8_SCHED; PG8_LDA(At, 0, 0); PG8_STAGE(PG8_SA(1, 1), a1 + hstep, voffA);
            PG8_WAIT_L(8); PG8_BAR; PG8_WAIT_L(0); PG8_MMA(0, 0, At, B0); PG8_BAR; PG8_SCHED;
            PG8_LDB(B1, 0, 1); PG8_STAGE(PG8_SB(0, 0), b2, voffB);
            PG8_BAR; PG8_WAIT_L(0); PG8_MMA(0, 1, At, B1); PG8_BAR;
            PG8_LDA(At, 0, 1); PG8_STAGE(PG8_SA(0, 0), a2, voffA);
            PG8_BAR; PG8_WAIT_L(0); PG8_MMA(1, 0, At, B0); PG8_BAR; PG8_SCHED;
            PG8_STAGE(PG8_SB(0, 1), b2 + hstep, voffB);
            PG8_WAIT_V(6); PG8_BAR; PG8_MMA(1, 1, At, B1); PG8_BAR;
            PG8_LDB(B0, 1, 0); PG8_SCHED; PG8_LDA(At, 1, 0); PG8_STAGE(PG8_SA(0, 1), a2 + hstep, voffA);
            PG8_WAIT_L(8); PG8_BAR; PG8_WAIT_L(0); PG8_MMA(0, 0, At, B0); PG8_BAR; PG8_SCHED;
            PG8_LDB(B1, 1, 1); PG8_STAGE(PG8_SB(1, 0), b3, voffB);
            PG8_BAR; PG8_WAIT_L(0); PG8_MMA(0, 1, At, B1); PG8_BAR;
            PG8_LDA(At, 1, 1); PG8_STAGE(PG8_SA(1, 0), a3, voffA);
            PG8_BAR; PG8_WAIT_L(0); PG8_MMA(1, 0, At, B0); PG8_BAR; PG8_SCHED;
            PG8_STAGE(PG8_SB(1, 1), b3 + hstep, voffB);
            PG8_WAIT_V(6); PG8_BAR; PG8_MMA(1, 1, At, B1); PG8_BAR;
            }
        }
        if constexpr (ALIGN_EPI) { if (wr == 0) PG8_BAR; }
        if constexpr (!Epi::AFTER_DRAIN) { E(acc, cur, wr, wc, fr, fq); S.done(cur); }
        if (!has_next) break;
#pragma unroll
        for (int a = 0; a < 2; ++a)
#pragma unroll
            for (int b = 0; b < 2; ++b)
#pragma unroll
                for (int m = 0; m < 4; ++m)
#pragma unroll
                    for (int n = 0; n < 2; ++n) acc[a][b][m][n] = (f32x4){0.f, 0.f, 0.f, 0.f};
        cur = nxt; cA = nA; cB = nB; ++ui;
        if constexpr (ALIGN_EPI) { if (wr == 1) PG8_BAR; }
    }
    PG8_WAIT_V(0);
    if constexpr (!ALIGN_EPI) { if (wr == 0) PG8_BAR; }
    PG8_BAR;
    if constexpr (Epi::AFTER_DRAIN) { E.fused(acc, cur, wr, wc, fr, fq, lds, wid, lane); S.done(cur); }
#undef PG8_SA
#undef PG8_SB
#undef PG8_STAGE
#undef PG8_LDA
#undef PG8_LDB
#undef PG8_MMA
#undef PG8_WAIT_V
#undef PG8_WAIT_L
#undef PG8_BAR
#undef PG8_SCHED
}
}
namespace pg8 {
__device__ __forceinline__ u32x4 pack8(const f32x4& v0, const f32x4& v1) { u32x4 w; w.x = cvt_pk_bf16(v0[0], v0[1]); w.y = cvt_pk_bf16(v0[2], v0[3]); w.z = cvt_pk_bf16(v1[0], v1[1]); w.w = cvt_pk_bf16(v1[2], v1[3]); return w; }
__device__ __forceinline__ float sigm(float x) { return __builtin_amdgcn_rcpf(1.0f + __expf(-x)); }
__device__ __forceinline__ f32x4 sigm4(const f32x4& v) { return (f32x4){sigm(v[0]), sigm(v[1]), sigm(v[2]), sigm(v[3])}; }
__device__ __forceinline__ float gelu_t(float x) { const float u = 1.5957691216057308f * (x + 0.044715f * x * x * x); return x * sigm(u); }
__device__ __forceinline__ f32x4 gelu4(const f32x4& v) { return (f32x4){gelu_t(v[0]), gelu_t(v[1]), gelu_t(v[2]), gelu_t(v[3])}; }

struct EpiIn {
    static constexpr bool PERM = true, AFTER_DRAIN = false;
    unsigned char* P; const float* bias;
    __device__ __forceinline__ void operator()(const f32x4 (&acc)[2][2][4][2], const Unit& u, int wr, int wc, int fr, int fq) const {
        const int pn = u.pn, row0 = u.pm * BM + wr * 64 + fr, cl = wc * 32 + 8 * fq;
        f32x4 bv[2][2];
#pragma unroll
        for (int bj = 0; bj < 2; ++bj)
#pragma unroll
            for (int n = 0; n < 2; ++n) bv[bj][n] = *(const f32x4*)(bias + pn * BM + bj * HALF + cl + 4 * n);
        if (pn < 10) {
            bf16_t* base = (bf16_t*)(P + (size_t)(pn >> 1) * (36u << 20));
            const float sc = (pn >= 2 && pn < 4) ? 0.08838834764831845f : 1.0f;
            const int act = pn < 6 ? 0 : pn < 8 ? 1 : 2;
            const int dcol = (pn & 1) * BM + cl;
#pragma unroll
            for (int ai = 0; ai < 2; ++ai)
#pragma unroll
                for (int m = 0; m < 4; ++m) { bf16_t* rowp = base + (size_t)(row0 + ai * HALF + m * 16) * 512 + dcol;
#pragma unroll
                    for (int bj = 0; bj < 2; ++bj) { f32x4 v0 = acc[ai][bj][m][0] + bv[bj][0], v1 = acc[ai][bj][m][1] + bv[bj][1];
                        if (act == 1) { v0 = sigm4(v0); v1 = sigm4(v1); } else if (act == 2) { v0 = gelu4(v0); v1 = gelu4(v1); } else { v0 = v0 * sc; v1 = v1 * sc; }
                        *(u32x4*)(rowp + bj * HALF) = pack8(v0, v1); } }
        } else if (pn < 12) {
            const int dcol = (pn - 10) * HALF + cl;
#pragma unroll
            for (int ai = 0; ai < 2; ++ai)
#pragma unroll
                for (int m = 0; m < 4; ++m) { bf16_t* rowp = (bf16_t*)(P + (size_t)5 * (36u << 20)) + (size_t)(row0 + ai * HALF + m * 16) * 256 + dcol;
                    const f32x4 a0 = acc[ai][0][m][0] + bv[0][0], a1 = acc[ai][0][m][1] + bv[0][1];
                    const f32x4 g0 = sigm4(acc[ai][1][m][0] + bv[1][0]), g1 = sigm4(acc[ai][1][m][1] + bv[1][1]);
                    *(u32x4*)rowp = pack8(a0 * g0, a1 * g1); }
        } else {
            if (wc == 0 && fq < 2) {
#pragma unroll
                for (int ai = 0; ai < 2; ++ai)
#pragma unroll
                    for (int m = 0; m < 4; ++m) { float* rowp = (float*)(P + (size_t)5 * (36u << 20) + (18u << 20)) + (size_t)(row0 + ai * HALF + m * 16) * 16 + 8 * fq;
                        *(f32x4*)rowp = acc[ai][0][m][0] + bv[0][0]; *(f32x4*)(rowp + 4) = acc[ai][0][m][1] + bv[0][1]; }
            }
        }
    }
};

struct EpiGU {
    static constexpr bool PERM = true, AFTER_DRAIN = false;
    bf16_t* H;
    __device__ __forceinline__ void operator()(const f32x4 (&acc)[2][2][4][2], const Unit& u, int wr, int wc, int fr, int fq) const {
        const int row0 = u.pm * BM + wr * 64 + fr, dcol = u.pn * HALF + wc * 32 + 8 * fq;
#pragma unroll
        for (int ai = 0; ai < 2; ++ai)
#pragma unroll
            for (int m = 0; m < 4; ++m) { bf16_t* rowp = H + (size_t)(row0 + ai * HALF + m * 16) * 2816 + dcol;
                const f32x4 g0 = acc[ai][0][m][0], g1 = acc[ai][0][m][1];
                *(u32x4*)rowp = pack8(g0 * sigm4(g0) * acc[ai][1][m][0], g1 * sigm4(g1) * acc[ai][1][m][1]); }
    }
};

struct EpiRes {
    static constexpr bool PERM = false, AFTER_DRAIN = false;
    const float* baseL; float* outL; const float* baseC; float* outC; const float* gate; int nlat;
    __device__ __forceinline__ void operator()(const f32x4 (&acc)[2][2][4][2], const Unit& u, int wr, int wc, int fr, int fq) const {
        const int trow = u.pm * BM; const bool lat = trow < nlat;
        const float* base = lat ? baseL + (size_t)trow * 1024 : baseC + (size_t)(trow - nlat) * 1024;
        float* out = lat ? outL + (size_t)trow * 1024 : outC + (size_t)(trow - nlat) * 1024;
        const float* gv = gate + (size_t)(lat ? (trow >> 11) : 16) * 6144;
        const int r0 = wr * 64 + fr, col0 = u.pn * BM + wc * 32 + 4 * fq;
        f32x4 g[2][2];
#pragma unroll
        for (int bj = 0; bj < 2; ++bj)
#pragma unroll
            for (int n = 0; n < 2; ++n) g[bj][n] = *(const f32x4*)(gv + col0 + bj * HALF + n * 16);
#pragma unroll
        for (int ai = 0; ai < 2; ++ai)
#pragma unroll
            for (int m = 0; m < 4; ++m) { const size_t off = (size_t)(r0 + ai * HALF + m * 16) * 1024 + col0;
#pragma unroll
                for (int bj = 0; bj < 2; ++bj)
#pragma unroll
                    for (int n = 0; n < 2; ++n) { const f32x4 b = *(const f32x4*)(base + off + bj * HALF + n * 16);
                        *(f32x4*)(out + off + bj * HALF + n * 16) = b + g[bj][n] * acc[ai][bj][m][n]; } }
    }
};
}
constexpr int D = 1024, NB = 16, SEQ = 2048, CTXL = 256, DEPTH = 2;
constexpr int ML = NB * SEQ, MC = NB * CTXL, MT = ML + MC;
constexpr int NIN_O = 3088, NIN = 3328, FF = 2816, NGU = 2 * FF;
constexpr int HW = 512;
constexpr int MODW = 6 * D;
constexpr float EPS = 1e-6f;
constexpr int NWAVES = 8, NTHREADS = 512;

constexpr size_t MiB = 1u << 20;
constexpr size_t WS_CTL = 0;
constexpr size_t WS_MOD = 1 * MiB;
constexpr size_t ZERO_BYTES = 2 * MiB;
constexpr size_t WS_BIN = 2 * MiB;
constexpr size_t WS_W = 3 * MiB, W_LAYER = 25 * MiB;
constexpr size_t WO_IN = 0, WO_OUT = 6 * MiB + 512 * 1024, WO_GU = WO_OUT + 2 * MiB, WO_DOWN = WO_GU + 11 * MiB;
constexpr size_t WS_XC = 53 * MiB;
constexpr size_t WS_A = 69 * MiB;
constexpr size_t WS_P = 141 * MiB;
constexpr size_t WS_Q = WS_P, WS_K = WS_Q + 36 * MiB, WS_V = WS_K + 36 * MiB, WS_OG = WS_V + 36 * MiB, WS_Z = WS_OG + 36 * MiB, WS_YC = WS_Z + 36 * MiB, WS_GT = WS_YC + 18 * MiB;
constexpr size_t WS_H = WS_P;
constexpr size_t WS_Y = 342 * MiB;
constexpr size_t WS_HS0 = WS_A, WS_HS1 = 414 * MiB;
constexpr size_t WS_END = 486 * MiB;
static_assert(WS_GT + (size_t)MT * 16 * 4 <= WS_Y && WS_H + (size_t)MT * FF * 2 <= WS_Y && WS_W + 2 * W_LAYER <= WS_XC && WO_DOWN + (size_t)D * FF * 2 <= W_LAYER, "ws map");

constexpr int RING_BYTES = 131072, MISC_OFF = RING_BYTES + 320, LDS_BYTES = 147456;

#define GAS __attribute__((address_space(1)))
#define LAS __attribute__((address_space(3)))
typedef unsigned short bf16;
typedef unsigned v4u __attribute__((ext_vector_type(4)));
typedef unsigned v2u __attribute__((ext_vector_type(2)));
typedef float f32x4 __attribute__((ext_vector_type(4)));
typedef float f32x2 __attribute__((ext_vector_type(2)));
#define LDS_WAIT() asm volatile("s_waitcnt lgkmcnt(0)" ::: "memory")
__device__ __forceinline__ unsigned f2bf(float f) { unsigned u = __builtin_bit_cast(unsigned, f); return (u + 0x7fffu + ((u >> 16) & 1u)) >> 16; }
__device__ __forceinline__ unsigned pk2(float lo, float hi) { return f2bf(lo) | (f2bf(hi) << 16); }
__device__ __forceinline__ float bf2f(unsigned short b) { return __builtin_bit_cast(float, (unsigned)b << 16); }
__device__ __forceinline__ float bflo(unsigned w) { return __builtin_bit_cast(float, w << 16); }
__device__ __forceinline__ float bfhi(unsigned w) { return __builtin_bit_cast(float, w & 0xffff0000u); }
__device__ __forceinline__ float fsigmoid(float x) { return __builtin_amdgcn_rcpf(1.0f + __expf(-x)); }
__device__ __forceinline__ float wave_sum(float v) {
#pragma unroll
    for (int o = 1; o < 64; o <<= 1) v += __shfl_xor(v, o);
    return v;
}
__device__ __forceinline__ int modrow_of(int row) { return row < ML ? (row >> 11) : 16; }
#define XB_TMO      128
#define XB_XCNT(j)  (256  + 64 * (j))
#define XB_XSUB(j)  (1280 + 64 * (j))
#define XB_XGEN(j)  (2304 + 64 * (j))
#define XB_TOP      3328
#define XB_TOPGEN   3392
#define XCD_BAR_WORDS 3456
#define XB_SPIN_CAP (1u << 18)

__device__ __forceinline__ unsigned xb_ld(unsigned* p)              { return __hip_atomic_load(p, __ATOMIC_RELAXED, __HIP_MEMORY_SCOPE_AGENT); }
__device__ __forceinline__ unsigned xb_add(unsigned* p, unsigned v) { return __hip_atomic_fetch_add(p, v, __ATOMIC_RELAXED, __HIP_MEMORY_SCOPE_AGENT); }
__device__ __forceinline__ unsigned xb_xcc_id() { return (unsigned)__builtin_amdgcn_s_getreg((3 << 11) | 20) & 0xFu; }
#define XB_SPIN(cond, bar) do { unsigned _sp = 0; while (cond) { __builtin_amdgcn_s_sleep(1); \
    if ((++_sp & 255u) == 0u) { if (xb_ld(&(bar)[XB_TMO])) break; if (_sp > XB_SPIN_CAP) { atomicAdd(&(bar)[XB_TMO], 1u); break; } } } } while (0)

struct XcdBarrier {
    unsigned* bar; unsigned x;
    volatile LAS unsigned* st;
};

__device__ __forceinline__ XcdBarrier xcd_barrier_post(unsigned* bar, volatile LAS unsigned* st) {
    XcdBarrier b; b.bar = bar; b.x = xb_xcc_id(); b.st = st;
    if (threadIdx.x == 0) (void)xb_add(&bar[XB_XCNT(b.x)], 1u);
    return b;
}
__device__ __forceinline__ void xcd_barrier_complete(unsigned* bar, unsigned x, unsigned& nloc, unsigned& nx) {
    const unsigned G = gridDim.x * gridDim.y * gridDim.z;
    unsigned sum, cnt, mine, sp = 0u;
    for (;;) {
        sum = 0u; cnt = 0u; mine = 0u;
#pragma unroll
        for (unsigned j = 0; j < 16; ++j) { const unsigned c = xb_ld(&bar[XB_XCNT(j)]); sum += c; cnt += (c > 0u) ? 1u : 0u; mine = (j == x) ? c : mine; }
        if (sum == G) break;
        __builtin_amdgcn_s_sleep(1);
        if ((++sp & 255u) == 0u) { if (xb_ld(&bar[XB_TMO])) break; if (sp > XB_SPIN_CAP) { atomicAdd(&bar[XB_TMO], 1u); break; } }
    }
    nloc = mine > 0u ? mine : 1u; nx = cnt > 0u ? cnt : 1u;
}

__device__ __forceinline__ void xcd_barrier(const XcdBarrier& b) {
    asm volatile("s_waitcnt vmcnt(0)" ::: "memory");
    __syncthreads();
    if (threadIdx.x == 0) {
        unsigned* bar = b.bar;
        __builtin_amdgcn_s_waitcnt(0);
        unsigned nloc = b.st[0], nx = b.st[1];
        if (nloc == 0u) { xcd_barrier_complete(bar, b.x, nloc, nx); b.st[0] = nloc; b.st[1] = nx; }
        const unsigned old = xb_add(&bar[XB_XSUB(b.x)], 1u);
        const unsigned gen = old / nloc;
        if (old + 1u == (gen + 1u) * nloc) {
            __builtin_amdgcn_fence(__ATOMIC_RELEASE, "agent");
            asm volatile("s_waitcnt vmcnt(0)" ::: "memory");
            const unsigned og = xb_add(&bar[XB_TOP], 1u);
            const unsigned tg = og / nx;
            if (og + 1u == (tg + 1u) * nx) xb_add(&bar[XB_TOPGEN], 1u);
            else XB_SPIN(xb_ld(&bar[XB_TOPGEN]) == tg, bar);
            __builtin_amdgcn_fence(__ATOMIC_ACQUIRE, "agent");
            xb_add(&bar[XB_XGEN(b.x)], 1u);
            asm volatile("s_waitcnt vmcnt(0)" ::: "memory");
        } else {
            XB_SPIN(xb_ld(&bar[XB_XGEN(b.x)]) == gen, bar);
            __builtin_amdgcn_fence(__ATOMIC_ACQUIRE, "agent");
            asm volatile("s_waitcnt vmcnt(0)" ::: "memory");
        }
    }
    __syncthreads();
}

struct Args { const float* in[23]; float* out; unsigned char* ws; int ph_lo, ph_hi; };
enum { I_X = 0, I_C, I_CTX, I_CCTX, I_WMOD, I_BMOD, I_N1G, I_WIN, I_BIN, I_MG, I_SLG, I_SLB, I_SW, I_SB, I_CW, I_CB, I_CLG, I_CLB, I_WOUT, I_N2G, I_WGU, I_WDOWN, I_FG };

__device__ __forceinline__ int win_src_col(int n) {
    if (n < 2048) return n;
    if (n < 2560) return n + 16;
    if (n < 3072) { const int j = n - 2560, tile = j >> 8, jj = j & 255; return 2576 + (jj >> 7) * 256 + tile * 128 + (jj & 127); }
    if (n < 3088) return 2048 + (n - 3072);
    return -1;
}
__device__ __forceinline__ int wgu_src_col(int n) { const int tile = n >> 8, jj = n & 255; return (jj >> 7) * FF + tile * 128 + (jj & 127); }

__device__ __forceinline__ void transpose_item(const float* W, int K, int Nsrc, bf16* WT, int n0, int srcc0, int nvalid, int k0, LAS float* scr, int lane) {
    const int c = lane & 31;
#pragma unroll 8
    for (int i = 0; i < 32; ++i) { const int kk = 2 * i + (lane >> 5);
        float v = 0.f; if (srcc0 >= 0 && c < nvalid) v = W[(size_t)(k0 + kk) * Nsrc + srcc0 + c];
        scr[kk * 33 + c] = v; }
    LDS_WAIT(); asm volatile("" ::: "memory");
    const int c8 = lane & 7;
#pragma unroll
    for (int j = 0; j < 4; ++j) { const int n = (lane >> 3) + 8 * j; const LAS float* s = scr + (8 * c8) * 33 + n;
        v4u o; o.x = pk2(s[0 * 33], s[1 * 33]); o.y = pk2(s[2 * 33], s[3 * 33]); o.z = pk2(s[4 * 33], s[5 * 33]); o.w = pk2(s[6 * 33], s[7 * 33]);
        *(v4u*)(WT + (size_t)(n0 + n) * K + k0 + 8 * c8) = o; }
    LDS_WAIT(); asm volatile("" ::: "memory");
}

__device__ __forceinline__ void phase_prologue(const Args& a, LAS unsigned char* lds, int G, int tid, int lane, int wave) {
    unsigned char* ws = a.ws;
    LAS float* scr = (LAS float*)(lds + wave * 16384);
    const int gw = blockIdx.x * NWAVES + wave, NGW = G * NWAVES;
    constexpr int I_IN = 16 * (NIN / 32), I_OUT = 16 * 32, I_GU = 16 * (NGU / 32), I_DN = (FF / 64) * 32, I_LAYER = I_IN + I_OUT + I_GU + I_DN;
    for (int it = gw; it < 2 * I_LAYER; it += NGW) {
        const int l = it / I_LAYER; int r = it % I_LAYER;
        unsigned char* wl = ws + WS_W + (size_t)l * W_LAYER;
        if (r < I_IN) { const int kb = r / (NIN / 32), nb = r % (NIN / 32), n0 = nb * 32, sc = win_src_col(n0);
            transpose_item(a.in[I_WIN] + (size_t)l * D * NIN_O, D, NIN_O, (bf16*)(wl + WO_IN), n0, sc, n0 == 3072 ? 16 : 32, kb * 64, scr, lane); continue; }
        r -= I_IN;
        if (r < I_OUT) { const int kb = r / 32, nb = r % 32;
            transpose_item(a.in[I_WOUT] + (size_t)l * D * D, D, D, (bf16*)(wl + WO_OUT), nb * 32, nb * 32, 32, kb * 64, scr, lane); continue; }
        r -= I_OUT;
        if (r < I_GU) { const int kb = r / (NGU / 32), nb = r % (NGU / 32), n0 = nb * 32;
            transpose_item(a.in[I_WGU] + (size_t)l * D * NGU, D, NGU, (bf16*)(wl + WO_GU), n0, wgu_src_col(n0), 32, kb * 64, scr, lane); continue; }
        r -= I_GU;
        { const int kb = r / 32, nb = r % 32;
            transpose_item(a.in[I_WDOWN] + (size_t)l * FF * D, FF, D, (bf16*)(wl + WO_DOWN), nb * 32, nb * 32, 32, kb * 64, scr, lane); }
    }
    for (int e = blockIdx.x * NTHREADS + tid; e < 2 * NIN; e += G * NTHREADS) { const int l = e / NIN, n = e % NIN, s = win_src_col(n);
        ((float*)(ws + WS_BIN))[e] = s >= 0 ? a.in[I_BIN][l * NIN_O + s] : 0.f; }
    __syncthreads();
    LAS float* sl = (LAS float*)lds;
    float* MOD = (float*)(ws + WS_MOD);
    for (int it = blockIdx.x; it < 2 * 12 * 16; it += G) {
        const int l = it / 192, jb = (it % 192) / 16, ks = it % 16;
        for (int e = tid; e < 17 * 64; e += NTHREADS) { const int r = e >> 6, k = e & 63; const float cv = r < 16 ? a.in[I_C][r * D + ks * 64 + k] : a.in[I_CCTX][ks * 64 + k]; sl[e] = cv * fsigmoid(cv); }
        __syncthreads();
        const int j = jb * 512 + tid;
        float acc[17];
#pragma unroll
        for (int r = 0; r < 17; ++r) acc[r] = 0.f;
        const float* wp = a.in[I_WMOD] + (size_t)l * D * MODW + (size_t)(ks * 64) * MODW + j;
#pragma unroll 4
        for (int k = 0; k < 64; ++k) { const float w = wp[(size_t)k * MODW];
#pragma unroll
            for (int r = 0; r < 17; ++r) acc[r] += sl[r * 64 + k] * w; }
        const float bm = ks == 0 ? a.in[I_BMOD][l * MODW + j] : 0.f;
#pragma unroll
        for (int r = 0; r < 17; ++r) atomicAdd(MOD + (size_t)(l * 17 + r) * MODW + j, acc[r] + bm);
        __syncthreads();
    }
}

__device__ __forceinline__ void phase_norm(const float* xl, const float* xc, bf16* A, const float* g, const float* mod, int sh_off, int nrows, int G, int lane, int wave) {
    const int gw = blockIdx.x * NWAVES + wave, NGW = G * NWAVES;
    for (int r = gw; r < nrows; r += NGW) {
        const float* xr = r < ML ? xl + (size_t)r * D : xc + (size_t)(r - ML) * D;
        const float* mr = mod + (size_t)modrow_of(r) * MODW + sh_off;
        f32x4 v[4]; float s = 0.f;
#pragma unroll
        for (int j = 0; j < 4; ++j) { v[j] = ((const f32x4*)xr)[lane + 64 * j]; s += (v[j].x * v[j].x + v[j].y * v[j].y) + (v[j].z * v[j].z + v[j].w * v[j].w); }
        const float rstd = 1.0f / sqrtf(wave_sum(s) * (1.0f / D) + EPS);
        unsigned long long* o8 = (unsigned long long*)(A + (size_t)r * D) + lane;
#pragma unroll
        for (int j = 0; j < 4; ++j) { const int c = (lane + 64 * j) * 4;
            const f32x4 gg = *(const f32x4*)(g + c), sh = *(const f32x4*)(mr + c), sc = *(const f32x4*)(mr + D + c);
            const f32x4 y = v[j] * rstd * gg * (1.0f + sc) + sh;
            o8[64 * j] = (unsigned long long)pk2(y.x, y.y) | ((unsigned long long)pk2(y.z, y.w) << 32); }
    }
}

__device__ __forceinline__ void phase_final(float* x, const float* g, int G, int lane, int wave) {
    const int gw = blockIdx.x * NWAVES + wave, NGW = G * NWAVES;
    for (int r = gw; r < ML; r += NGW) {
        float* xr = x + (size_t)r * D;
        f32x4 v[4]; float s = 0.f;
#pragma unroll
        for (int j = 0; j < 4; ++j) { v[j] = ((const f32x4*)xr)[lane + 64 * j]; s += (v[j].x * v[j].x + v[j].y * v[j].y) + (v[j].z * v[j].z + v[j].w * v[j].w); }
        const float rstd = 1.0f / sqrtf(wave_sum(s) * (1.0f / D) + EPS);
#pragma unroll
        for (int j = 0; j < 4; ++j) { const f32x4 gg = ((const f32x4*)g)[lane + 64 * j]; ((f32x4*)xr)[lane + 64 * j] = v[j] * rstd * gg; }
    }
}

constexpr int TB = 16;
__device__ __forceinline__ void mlstm_scan_item(const bf16* Q, const bf16* K, const bf16* V, const float* GT, float* HS0, float* HS1, int item, bool ctx_out, LAS unsigned char* lds, int tid) {
    const int b = item >> 3, h = (item >> 1) & 3, dir = item & 1;
    const int dv = tid & 127, kq = tid >> 7;
    LAS float* kbuf = (LAS float*)lds;
    LAS float* vbuf = kbuf + TB * 128;
    LAS float* qbuf = vbuf + TB * 128;
    LAS float* ibuf = qbuf + TB * 128;
    LAS float* fbuf = ibuf + TB;
    LAS float* red = fbuf + TB;
    LAS float* redd = red + 2 * 4 * 128;
    float* HS = dir ? HS1 : HS0;
    float C[32], nn[32];
#pragma unroll
    for (int j = 0; j < 32; ++j) { C[j] = 0.f; nn[j] = 0.f; }
    float m = 0.f; int par = 0;
    for (int s0 = 0; s0 < CTXL + SEQ; s0 += TB) {
        const bool isctx = s0 < CTXL; const int len = isctx ? CTXL : SEQ, i0 = isctx ? s0 : s0 - CTXL;
        const int rbase = isctx ? ML + b * CTXL : b * SEQ;
        for (int e = tid; e < TB * 384; e += NTHREADS) { const int tok = e / 384, c = e % 384, which = c >> 7, d = c & 127;
            const int t = dir ? (len - 1 - (i0 + tok)) : (i0 + tok); const size_t off = (size_t)(rbase + t) * HW + h * 128 + d;
            const bf16* src = which == 0 ? K : which == 1 ? V : Q;
            (which == 0 ? kbuf : which == 1 ? vbuf : qbuf)[tok * 128 + d] = bf2f(src[off]); }
        if (tid < TB) { const int t = dir ? (len - 1 - (i0 + tid)) : (i0 + tid); const float* gp = GT + (size_t)(rbase + t) * 16 + dir * 8 + h;
            const float iv = gp[0], fv = gp[4];
            ibuf[tid] = iv; fbuf[tid] = fminf(fv, 0.f) - log1pf(__expf(-fabsf(fv))); }
        __syncthreads();
        const bool wr_out = !isctx || ctx_out;
        for (int tok = 0; tok < TB; ++tok) {
            const float it = ibuf[tok], lf = fbuf[tok];
            const float mn = fmaxf(lf + m, it), aa = __expf(lf + m - mn), bc = __expf(it - mn); m = mn;
            const float vv = vbuf[tok * 128 + dv] * bc;
            float part = 0.f, dpart = 0.f;
            const LAS float* kp = kbuf + tok * 128 + kq * 32; const LAS float* qp = qbuf + tok * 128 + kq * 32;
#pragma unroll
            for (int j = 0; j < 32; ++j) { const float kk = kp[j], qq = qp[j];
                C[j] = aa * C[j] + kk * vv; part += C[j] * qq;
                nn[j] = aa * nn[j] + bc * kk; dpart += nn[j] * qq; }
            red[(par * 4 + kq) * 128 + dv] = part; if (dv == 0) redd[par * 4 + kq] = dpart;
            __syncthreads();
            if (tid < 128 && wr_out) {
                const float num = (red[(par * 4 + 0) * 128 + tid] + red[(par * 4 + 1) * 128 + tid]) + (red[(par * 4 + 2) * 128 + tid] + red[(par * 4 + 3) * 128 + tid]);
                const float den = (redd[par * 4 + 0] + redd[par * 4 + 1]) + (redd[par * 4 + 2] + redd[par * 4 + 3]);
                const int t = dir ? (len - 1 - (i0 + tok)) : (i0 + tok);
                HS[(size_t)(rbase + t) * HW + h * 128 + tid] = num / fmaxf(fabsf(den), __expf(-m));
            }
            par ^= 1;
        }
    }
    __syncthreads();
}

__device__ __forceinline__ void phase_mlstm_post(const float* HS0, const float* HS1, const bf16* OG, const float* mg, bf16* Y, int nrows, int G, int lane, int wave) {
    const int gw = blockIdx.x * NWAVES + wave, NGW = G * NWAVES;
    for (int r = gw; r < nrows; r += NGW) {
        const size_t off = (size_t)r * HW + lane * 8;
        const f32x4 a0 = *(const f32x4*)(HS0 + off), a1 = *(const f32x4*)(HS0 + off + 4), b0 = *(const f32x4*)(HS1 + off), b1 = *(const f32x4*)(HS1 + off + 4);
        const f32x4 h0 = a0 + b0, h1 = a1 + b1;
        float s = (h0.x * h0.x + h0.y * h0.y) + (h0.z * h0.z + h0.w * h0.w) + (h1.x * h1.x + h1.y * h1.y) + (h1.z * h1.z + h1.w * h1.w);
        s += __shfl_xor(s, 1); s += __shfl_xor(s, 2); s += __shfl_xor(s, 4); s += __shfl_xor(s, 8);
        const float rs = 1.0f / sqrtf(s * (1.0f / 128.0f) + EPS);
        const v4u og = *(const v4u*)(OG + off);
        const f32x4 g0 = *(const f32x4*)(mg + lane * 8), g1 = *(const f32x4*)(mg + lane * 8 + 4);
        v4u o;
        o.x = pk2(h0.x * rs * g0.x * bflo(og.x), h0.y * rs * g0.y * bfhi(og.x)); o.y = pk2(h0.z * rs * g0.z * bflo(og.y), h0.w * rs * g0.w * bfhi(og.y));
        o.z = pk2(h1.x * rs * g1.x * bflo(og.z), h1.y * rs * g1.y * bfhi(og.z)); o.w = pk2(h1.z * rs * g1.z * bflo(og.w), h1.w * rs * g1.w * bfhi(og.w));
        *(v4u*)(Y + (size_t)r * D + lane * 8) = o;
    }
}

__device__ __forceinline__ void sgu_item(const bf16* Z, const float* lg, const float* lb, const float* sw, const float* sb, bf16* Y, int chunk, LAS unsigned char* lds, int tid, int lane, int wave) {
    LAS float* vn = (LAS float*)lds;
    const int row0 = chunk * 128;
    for (int t = wave; t < 128; t += NWAVES) {
        const v2u raw = *(const v2u*)(Z + (size_t)(row0 + t) * 512 + 256 + lane * 4);
        const float x0 = bflo(raw.x), x1 = bfhi(raw.x), x2 = bflo(raw.y), x3 = bfhi(raw.y);
        const float mu = wave_sum((x0 + x1) + (x2 + x3)) * (1.0f / 256.0f);
        const float d0 = x0 - mu, d1 = x1 - mu, d2 = x2 - mu, d3 = x3 - mu;
        const float var = wave_sum((d0 * d0 + d1 * d1) + (d2 * d2 + d3 * d3)) * (1.0f / 256.0f);
        const float rs = 1.0f / sqrtf(var + EPS);
        const f32x4 g = *(const f32x4*)(lg + lane * 4), bb = *(const f32x4*)(lb + lane * 4);
        *(LAS f32x4*)(vn + t * 256 + lane * 4) = (f32x4){d0 * rs * g.x + bb.x, d1 * rs * g.y + bb.y, d2 * rs * g.z + bb.z, d3 * rs * g.w + bb.w};
    }
    __syncthreads();
    const int ch = tid & 255, ph = tid >> 8, g = __builtin_amdgcn_readfirstlane(ch >> 6);
    const float* wg = sw + (size_t)g * 128 * 128; const float* bg = sb + g * 128;
    for (int p = ph * 64; p < ph * 64 + 64; ++p) {
        const float* wr = wg + p * 128; float acc = 0.f;
#pragma unroll 8
        for (int q = 0; q < 128; ++q) acc += wr[q] * vn[q * 256 + ch];
        const float u = bf2f(Z[(size_t)(row0 + p) * 512 + ch]);
        Y[(size_t)(row0 + p) * D + 512 + ch] = (bf16)f2bf(u * (acc + bg[p]));
    }
    __syncthreads();
}

__device__ __forceinline__ void conv_rows(const bf16* YC, const float* cw, const float* cb, const float* lg, const float* lb, bf16* Y, int row0, int nrows, int lane, int wave) {
    const int c0 = lane * 4;
    for (int rr = wave; rr < nrows; rr += NWAVES) {
        const int r = row0 + rr;
        f32x4 acc = *(const f32x4*)(cb + c0);
        int base, pos, len, stride;
        if (r < ML) { const int b = r >> 11, t = r & 2047;
            if (lane < 32) { base = (b << 11) + (t & ~63); pos = t & 63; len = 64; stride = 1; }
            else           { base = (b << 11) + (t & 63); pos = t >> 6; len = 32; stride = 64; } }
        else { const int rc = r - ML; base = ML + (rc & ~255); pos = rc & 255; len = 256; stride = 1; }
#pragma unroll 1
        for (int k = 0; k < 31; ++k) { const int p = pos + k - 15;
            if (p >= 0 && p < len) { const v2u raw = *(const v2u*)(YC + (size_t)(base + p * stride) * 256 + c0); const f32x4 w = *(const f32x4*)(cw + k * 256 + c0);
                acc.x += w.x * bflo(raw.x); acc.y += w.y * bfhi(raw.x); acc.z += w.z * bflo(raw.y); acc.w += w.w * bfhi(raw.y); } }
        const float mu = wave_sum((acc.x + acc.y) + (acc.z + acc.w)) * (1.0f / 256.0f);
        const float d0 = acc.x - mu, d1 = acc.y - mu, d2 = acc.z - mu, d3 = acc.w - mu;
        const float var = wave_sum((d0 * d0 + d1 * d1) + (d2 * d2 + d3 * d3)) * (1.0f / 256.0f);
        const float rs = 1.0f / sqrtf(var + EPS);
        const f32x4 g = *(const f32x4*)(lg + c0), bb = *(const f32x4*)(lb + c0);
        float y0 = d0 * rs * g.x + bb.x, y1 = d1 * rs * g.y + bb.y, y2 = d2 * rs * g.z + bb.z, y3 = d3 * rs * g.w + bb.w;
        y0 *= fsigmoid(y0); y1 *= fsigmoid(y1); y2 *= fsigmoid(y2); y3 *= fsigmoid(y3);
        v2u o; o.x = pk2(y0, y1); o.y = pk2(y2, y3);
        *(v2u*)(Y + (size_t)r * D + 768 + c0) = o;
    }
}
constexpr int N_PHASES = 18;
#ifndef MK_ONE_LAUNCH
#define MK_ONE_LAUNCH 0
#endif
#ifndef PH_MASK
#define PH_MASK 0x3ff
#endif
#define PH_EN(b) (((PH_MASK) >> (b)) & 1)

__global__ void __launch_bounds__(NTHREADS, 2) fwd_kernel(Args args) {
    extern __shared__ __attribute__((aligned(16))) unsigned char lds_raw[];
    LAS unsigned char* lds = (LAS unsigned char*)lds_raw;
    const int G = gridDim.x;
    unsigned char* ws = args.ws;
    volatile LAS unsigned* MISC = (volatile LAS unsigned*)(lds + MISC_OFF);
    for (int u = threadIdx.x; u < (LDS_BYTES - RING_BYTES) / 4; u += NTHREADS) ((LAS unsigned*)(lds + RING_BYTES))[u] = 0u;
    __syncthreads();
    XcdBarrier bar; bar.bar = (unsigned*)(ws + WS_CTL) + 4096; bar.x = 0; bar.st = nullptr;
    const int lo = args.ph_lo, hi = args.ph_hi;
    if (hi - lo > 1) bar = xcd_barrier_post((unsigned*)(ws + WS_CTL) + 4096, MISC + 8);
#define IN(k) (lo <= (k) && (k) < hi)
#define SEAM(k) do { if (IN(k) && IN((k) + 1)) xcd_barrier(bar); } while (0)

#pragma unroll 1
    for (int ph = lo; ph < hi; ++ph) {
        int tid = threadIdx.x; asm volatile("" : "+v"(tid));
        const int lane = tid & 63, wave = __builtin_amdgcn_readfirstlane(tid >> 6);
        if (ph == 0) { if (PH_EN(8)) phase_prologue(args, lds, G, tid, lane, wave); }
        else if (ph == N_PHASES - 1) { if (PH_EN(9)) phase_final(args.out, args.in[I_FG], G, lane, wave); }
        else {
            const int l = (ph - 1) >> 3, k = (ph - 1) & 7;
            const bool last = (l == DEPTH - 1);
            const int mrest = last ? ML : MT;
            const float* modl = (const float*)(ws + WS_MOD) + (size_t)l * 17 * MODW;
            const unsigned char* wl = ws + WS_W + (size_t)l * W_LAYER;
            if (k == 0 && PH_EN(0)) {
                phase_norm(l == 0 ? args.in[I_X] : args.out, l == 0 ? args.in[I_CTX] : (const float*)(ws + WS_XC), (bf16*)(ws + WS_A), args.in[I_N1G] + l * D, modl, 0, MT, G, lane, wave);
            } else if (k == 1 && PH_EN(1)) {
                pg8::Gemm g{(const bf16*)(ws + WS_A), (const bf16*)(wl + WO_IN), MT, NIN, D}; pg8::StaticOrder S; S.init(MT, NIN, G, (int)blockIdx.x);
                pg8::EpiIn E{ws + WS_P, (const float*)(ws + WS_BIN) + l * NIN};
                pg8::gemm_phase<pg8::EpiIn, pg8::StaticOrder, true, true>(lds, g, S, E, tid);
            } else if (k == 2 && PH_EN(2)) {
                const int nscan = G >= 256 ? 128 : G / 2;
                if ((int)blockIdx.x < nscan) {
                    for (int it = blockIdx.x; it < 128; it += nscan)
                        mlstm_scan_item((const bf16*)(ws + WS_Q), (const bf16*)(ws + WS_K), (const bf16*)(ws + WS_V), (const float*)(ws + WS_GT), (float*)(ws + WS_HS0), (float*)(ws + WS_HS1), it, !last, lds, tid);
                } else {
                    const int nch = mrest / 128;
                    for (int it = blockIdx.x - nscan; it < nch; it += G - nscan) {
                        sgu_item((const bf16*)(ws + WS_Z), args.in[I_SLG] + l * 256, args.in[I_SLB] + l * 256, args.in[I_SW] + (size_t)l * 4 * 128 * 128, args.in[I_SB] + l * 4 * 128, (bf16*)(ws + WS_Y), it, lds, tid, lane, wave);
                        conv_rows((const bf16*)(ws + WS_YC), args.in[I_CW] + l * 31 * 256, args.in[I_CB] + l * 256, args.in[I_CLG] + l * 256, args.in[I_CLB] + l * 256, (bf16*)(ws + WS_Y), it * 128, 128, lane, wave);
                    }
                }
            } else if (k == 3 && PH_EN(3)) {
                phase_mlstm_post((const float*)(ws + WS_HS0), (const float*)(ws + WS_HS1), (const bf16*)(ws + WS_OG), args.in[I_MG] + l * HW, (bf16*)(ws + WS_Y), mrest, G, lane, wave);
            } else if (k == 4 && PH_EN(4)) {
                pg8::Gemm g{(const bf16*)(ws + WS_Y), (const bf16*)(wl + WO_OUT), mrest, D, D}; pg8::StaticOrder S; S.init(mrest, D, G, (int)blockIdx.x);
                pg8::EpiRes E{l == 0 ? args.in[I_X] : args.out, args.out, l == 0 ? args.in[I_CTX] : (const float*)(ws + WS_XC), (float*)(ws + WS_XC), modl + 2 * D, ML};
                pg8::gemm_phase<pg8::EpiRes, pg8::StaticOrder, true, true>(lds, g, S, E, tid);
            } else if (k == 5 && PH_EN(5)) {
                phase_norm(args.out, (const float*)(ws + WS_XC), (bf16*)(ws + WS_A), args.in[I_N2G] + l * D, modl, 3 * D, mrest, G, lane, wave);
            } else if (k == 6 && PH_EN(6)) {
                pg8::Gemm g{(const bf16*)(ws + WS_A), (const bf16*)(wl + WO_GU), mrest, NGU, D}; pg8::StaticOrder S; S.init(mrest, NGU, G, (int)blockIdx.x);
                pg8::EpiGU E{(bf16*)(ws + WS_H)};
                pg8::gemm_phase<pg8::EpiGU, pg8::StaticOrder, true, true>(lds, g, S, E, tid);
            } else if (PH_EN(7)) {
                pg8::Gemm g{(const bf16*)(ws + WS_H), (const bf16*)(wl + WO_DOWN), mrest, D, FF}; pg8::StaticOrder S; S.init(mrest, D, G, (int)blockIdx.x);
                pg8::EpiRes E{args.out, args.out, (const float*)(ws + WS_XC), (float*)(ws + WS_XC), modl + 5 * D, ML};
                pg8::gemm_phase<pg8::EpiRes, pg8::StaticOrder, true, true>(lds, g, S, E, tid);
            }
        }
        if (ph + 1 < hi) xcd_barrier(bar);
    }
#undef IN
#undef SEAM
}

extern "C" void kernel_launch(void* const* d_in, const int* in_sizes, int n_in, void* d_out, int out_size, void* d_ws, size_t ws_size, hipStream_t stream) {
    static int grid = 0;
    if (grid == 0) {
        if (n_in != 23 || in_sizes[0] != ML * D || out_size != ML * D || ws_size < WS_END) {
            fprintf(stderr, "kernel_launch: unexpected problem (n_in %d, in0 %d, out %d, ws %zu < %zu); nothing launched\n", n_in, n_in > 0 ? in_sizes[0] : -1, out_size, ws_size, (size_t)WS_END); grid = -1; return; }
        int dev = 0, cus = 0, per_cu = 0;
        if (hipGetDevice(&dev) != hipSuccess || hipDeviceGetAttribute(&cus, hipDeviceAttributeMultiprocessorCount, dev) != hipSuccess) { grid = -1; return; }
        if (hipFuncSetAttribute((const void*)fwd_kernel, hipFuncAttributeMaxDynamicSharedMemorySize, LDS_BYTES) != hipSuccess) { fprintf(stderr, "kernel_launch: hipFuncSetAttribute failed\n"); grid = -1; return; }
        if (hipOccupancyMaxActiveBlocksPerMultiprocessor(&per_cu, (const void*)fwd_kernel, NTHREADS, LDS_BYTES) != hipSuccess || per_cu < 1) {
            fprintf(stderr, "kernel_launch: occupancy query reports %d blocks per CU\n", per_cu); per_cu = 1; }
        (void)hipGetLastError();
        grid = cus;
    }
    if (grid < 0) return;
    if (hipMemsetAsync((char*)d_ws + WS_CTL, 0, ZERO_BYTES, stream) != hipSuccess) { fprintf(stderr, "kernel_launch: memset failed\n"); return; }
    Args a{};
    for (int i = 0; i < 23; ++i) a.in[i] = (const float*)d_in[i];
    a.out = (float*)d_out; a.ws = (unsigned char*)d_ws;
#if MK_ONE_LAUNCH
    a.ph_lo = 0; a.ph_hi = N_PHASES;
    hipLaunchKernelGGL(fwd_kernel, dim3(grid), dim3(NTHREADS), LDS_BYTES, stream, a);
#else
    for (int p = 0; p < N_PHASES; ++p) { a.ph_lo = p; a.ph_hi = p + 1; hipLaunchKernelGGL(fwd_kernel, dim3(grid), dim3(NTHREADS), LDS_BYTES, stream, a); }
#endif
    const hipError_t le = hipPeekAtLastError();
    if (le != hipSuccess) fprintf(stderr, "kernel_launch: launch failed: %s\n", hipGetErrorName(le));
}
```

```cpp
#include <hip/hip_runtime.h>
#include <cstdio>
#include <cstdint>
#ifndef MK_ONE_LAUNCH
#define MK_ONE_LAUNCH 1
#endif
namespace pg8 {
#define PG8_LAS __attribute__((address_space(3)))
typedef unsigned short bf16_t;
typedef short bf16x8 __attribute__((ext_vector_type(8)));
typedef float f32x4 __attribute__((ext_vector_type(4)));
typedef unsigned u32x4 __attribute__((ext_vector_type(4)));
constexpr int BM = 256, BK = 64, HALF = 128, HTB = HALF * BK * 2  , STAGE_BYTES = 8 * HTB, NXCD = 8, WGM = 8;

__host__ __device__ __forceinline__ int lds_byte(int r, int c) { const int st = (r >> 4) * 2 + (c >> 5), rr = r & 15, cc = c & 31, ob = rr * 64 + cc * 2; return st * 1024 + (ob ^ (((ob >> 9) & 1) << 5)); }
__host__ __device__ __forceinline__ void stage_rc(int b, int& R, int& C) { const int st = b / 1024, sb = b % 1024, swz = sb ^ (((sb >> 9) & 1) << 5); R = (st >> 1) * 16 + swz / 64; C = (st & 1) * 32 + (swz % 64) / 2; }
__host__ __device__ __forceinline__ int perm32(int rho) { const int n = rho >> 4, i = rho & 15; return 8 * (i >> 2) + 4 * n + (i & 3); }

struct Unit { int pm, pn; };
struct Gemm { const bf16_t* A; const bf16_t* Bt; int M, N, K; };

struct StaticOrder {
    int nM, nN, nwg, G, c;
    __host__ __device__ void init(int M, int N, int G_, int c_) { nM = M / BM; nN = N / BM; nwg = nM * nN; G = G_; c = c_; }
    __host__ __device__ bool next(int i, Unit& u) const {
        const long L = (long)i * G + c; if (L >= nwg) return false;
        int wgid = (int)L; { const int q = nwg / NXCD, r = nwg % NXCD, xcd = wgid % NXCD, off = wgid / NXCD; wgid = (xcd < r ? xcd * (q + 1) : r * (q + 1) + (xcd - r) * q) + off; }
        const int nig = WGM * nN, gid = wgid / nig, fm = gid * WGM, gsz = (nM - fm) < WGM ? (nM - fm) : WGM;
        u.pm = fm + ((wgid % nig) % gsz); u.pn = (wgid % nig) / gsz; return true;
    }
    __device__ __forceinline__ void a_ready(const Unit&) const {}
    __device__ __forceinline__ void done(const Unit&) const {}
};

__device__ __forceinline__ unsigned cvt_pk_bf16(float lo, float hi) { unsigned r; asm volatile("v_cvt_pk_bf16_f32 %0, %1, %2" : "=v"(r) : "v"(lo), "v"(hi)); return r; }
template <class Epi, class Sched, bool ALIGN_EPI = false, bool SP2 = false>
__device__ __forceinline__ void gemm_phase(PG8_LAS unsigned char* lds, const Gemm g, const Sched& S, const Epi& E, const int tid) {
    const int wid = __builtin_amdgcn_readfirstlane(tid >> 6), lane = tid & 63, wr = wid >> 2, wc = wid & 3, fr = lane & 15, fq = lane >> 4;
    const int K = g.K, nt = K / BK;
    unsigned voffA[2], voffB[2];
#pragma unroll
    for (int i = 0; i < 2; ++i) { int R, C; stage_rc(tid * 16 + i * 8192, R, C); const int Rb = Epi::PERM ? ((R & ~31) + perm32(R & 31)) : R;
        voffA[i] = (unsigned)(R * K + C) * 2u; voffB[i] = (unsigned)(Rb * K + C) * 2u; }
    const size_t kstep = (size_t)(BK * 2);
    const size_t hstep = (size_t)HALF * K * 2;
    const size_t tstep = 2 * hstep;
    const unsigned ldsw = (unsigned)wid * 1024u;
    const int aoff = lds_byte(wr * 64 + fr, fq * 8), boff = lds_byte(wc * 32 + fr, fq * 8);
#define PG8_SA(b, h) (((b) * 2 + (h)) * HTB)
#define PG8_SB(b, h) ((4 + (b) * 2 + (h)) * HTB)
#define PG8_STAGE(bufoff, gbase, voff) do { _Pragma("unroll") for (int _i = 0; _i < 2; ++_i) \
        __builtin_amdgcn_global_load_lds((const unsigned*)((const char*)(gbase) + (voff)[_i]), (PG8_LAS unsigned*)(lds + (bufoff) + ldsw + _i * 8192), 16, 0, 0); } while (0)
#define PG8_LDA(dst, b, h) do { _Pragma("unroll") for (int m = 0; m < 4; ++m) _Pragma("unroll") for (int k = 0; k < 2; ++k) dst[m][k] = *(const PG8_LAS bf16x8*)(lds + PG8_SA(b, h) + aoff + m * 2048 + k * 1024); } while (0)
#define PG8_LDB(dst, b, h) do { _Pragma("unroll") for (int n = 0; n < 2; ++n) _Pragma("unroll") for (int k = 0; k < 2; ++k) dst[n][k] = *(const PG8_LAS bf16x8*)(lds + PG8_SB(b, h) + boff + n * 2048 + k * 1024); } while (0)
#define PG8_MMA(ai, bj, At, Bt) do { __builtin_amdgcn_s_setprio(1); _Pragma("unroll") for (int m = 0; m < 4; ++m) _Pragma("unroll") for (int n = 0; n < 2; ++n) _Pragma("unroll") for (int k = 0; k < 2; ++k) \
        acc[ai][bj][m][n] = __builtin_amdgcn_mfma_f32_16x16x32_bf16(Bt[n][k], At[m][k], acc[ai][bj][m][n], 0, 0, 0); __builtin_amdgcn_s_setprio(0); } while (0)
#define PG8_WAIT_V(n) asm volatile("s_waitcnt vmcnt(" #n ")" ::: "memory")
#define PG8_WAIT_L(n) asm volatile("s_waitcnt lgkmcnt(" #n ")" ::: "memory")
#define PG8_BAR __builtin_amdgcn_s_barrier()
#define PG8_SCHED __builtin_amdgcn_sched_barrier(0)
    Unit cur, nxt; int ui = 0;
    if (!S.next(0, cur)) return;
    f32x4 acc[2][2][4][2];
#pragma unroll
    for (int a = 0; a < 2; ++a)
#pragma unroll
        for (int b = 0; b < 2; ++b)
#pragma unroll
            for (int m = 0; m < 4; ++m)
#pragma unroll
                for (int n = 0; n < 2; ++n) acc[a][b][m][n] = (f32x4){0.f, 0.f, 0.f, 0.f};
    bf16x8 At[4][2], B0[2][2], B1[2][2];
    const char* cA = (const char*)g.A + (size_t)cur.pm * tstep; const char* cB = (const char*)g.Bt + (size_t)cur.pn * tstep;
    S.a_ready(cur);
    if constexpr (SP2) {
        PG8_STAGE(PG8_SB(0, 0), cB, voffB); PG8_STAGE(PG8_SB(0, 1), cB + hstep, voffB); PG8_STAGE(PG8_SA(0, 0), cA, voffA); PG8_STAGE(PG8_SA(0, 1), cA + hstep, voffA);
        if (wr == 1) PG8_BAR;
        PG8_WAIT_V(2); PG8_BAR;
        PG8_STAGE(PG8_SB(1, 0), cB + kstep, voffB); PG8_STAGE(PG8_SA(1, 0), cA + kstep, voffA); PG8_STAGE(PG8_SB(1, 1), cB + hstep + kstep, voffB);
        PG8_WAIT_V(6); PG8_BAR;
    } else {
        PG8_STAGE(PG8_SB(0, 0), cB, voffB); PG8_STAGE(PG8_SA(0, 0), cA, voffA); PG8_STAGE(PG8_SB(0, 1), cB + hstep, voffB); PG8_STAGE(PG8_SA(0, 1), cA + hstep, voffA);
        if (wr == 1) PG8_BAR;
        PG8_WAIT_V(4); PG8_BAR;
        PG8_STAGE(PG8_SB(1, 0), cB + kstep, voffB); PG8_STAGE(PG8_SA(1, 0), cA + kstep, voffA); PG8_STAGE(PG8_SB(1, 1), cB + hstep + kstep, voffB);
        PG8_WAIT_V(6); PG8_BAR;
    }
    for (;;) {
        const bool has_next = S.next(ui + 1, nxt);
        const char* nA = has_next ? (const char*)g.A + (size_t)nxt.pm * tstep : cA; const char* nB = has_next ? (const char*)g.Bt + (size_t)nxt.pn * tstep : cB;
        for (int t = 0; t < nt; t += 2) {
            const bool last = (t == nt - 2);
            const char* a1 = cA + (size_t)(t + 1) * kstep;
            const char* a2 = last ? nA : cA + (size_t)(t + 2) * kstep; const char* b2 = last ? nB : cB + (size_t)(t + 2) * kstep;
            const char* a3 = a2 + kstep; const char* b3 = b2 + kstep;
            if (last && has_next) S.a_ready(nxt);
            if constexpr (SP2) {
            PG8_LDB(B0, 0, 0); PG8_LDB(B1, 0, 1); PG8_SCHED; PG8_LDA(At, 0, 0); PG8_STAGE(PG8_SA(1, 1), a1 + hstep, voffA);
            PG8_WAIT_V(8); PG8_WAIT_L(0); PG8_BAR; PG8_MMA(0, 0, At, B0); PG8_MMA(0, 1, At, B1); PG8_BAR; PG8_SCHED;
            PG8_LDA(At, 0, 1); PG8_STAGE(PG8_SB(0, 0), b2, voffB); PG8_STAGE(PG8_SB(0, 1), b2 + hstep, voffB); PG8_STAGE(PG8_SA(0, 0), a2, voffA);
            PG8_WAIT_V(8); PG8_WAIT_L(0); PG8_BAR; PG8_MMA(1, 0, At, B0); PG8_MMA(1, 1, At, B1); PG8_BAR; PG8_SCHED;
            PG8_LDB(B0, 1, 0); PG8_LDB(B1, 1, 1); PG8_SCHED; PG8_LDA(At, 1, 0); PG8_STAGE(PG8_SA(0, 1), a2 + hstep, voffA);
            PG8_WAIT_V(8); PG8_WAIT_L(0); PG8_BAR; PG8_MMA(0, 0, At, B0); PG8_MMA(0, 1, At, B1); PG8_BAR; PG8_SCHED;
            PG8_LDA(At, 1, 1); PG8_STAGE(PG8_SB(1, 0), b3, voffB); PG8_STAGE(PG8_SB(1, 1), b3 + hstep, voffB); PG8_STAGE(PG8_SA(1, 0), a3, voffA);
            PG8_WAIT_V(8); PG8_WAIT_L(0); PG8_BAR; PG8_MMA(1, 0, At, B0); PG8_MMA(1, 1, At, B1); PG8_BAR; PG8_SCHED;
            } else {
            PG8_LDB(B0, 0, 0); PG8_SCHED; PG8_LDA(At, 0, 0); PG8_STAGE(PG8_SA(1, 1), a1 + hstep, voffA);
            PG8_WAIT_L(8); PG8_BAR; PG8_WAIT_L(0); PG8_MMA(0, 0, At, B0); PG8_BAR; PG8_SCHED;
            PG8_LDB(B1, 0, 1); PG8_STAGE(PG8_SB(0, 0), b2, voffB);
            PG8_BAR; PG8_WAIT_L(0); PG8_MMA(0, 1, At, B1); PG8_BAR;
            PG8_LDA(At, 0, 1); PG8_STAGE(PG8_SA(0, 0), a2, voffA);
            PG8_BAR; PG8_WAIT_L(0); PG8_MMA(1, 0, At, B0); PG8_BAR; PG8_SCHED;
            PG8_STAGE(PG8_SB(0, 1), b2 + hstep, voffB);
            PG8_WAIT_V(6); PG8_BAR; PG8_MMA(1, 1, At, B1); PG8_BAR;
            PG8_LDB(B0, 1, 0); PG8_SCHED; PG8_LDA(At, 1, 0); PG8_STAGE(PG8_SA(0, 1), a2 + hstep, voffA);
            PG8_WAIT_L(8); PG8_BAR; PG8_WAIT_L(0); PG8_MMA(0, 0, At, B0); PG8_BAR; PG8_SCHED;
            PG8_LDB(B1, 1, 1); PG8_STAGE(PG8_SB(1, 0), b3, voffB);
            PG8_BAR; PG8_WAIT_L(0); PG8_MMA(0, 1, At, B1); PG8_BAR;
            PG8_LDA(At, 1, 1); PG8_STAGE(PG8_SA(1, 0), a3, voffA);
            PG8_BAR; PG8_WAIT_L(0); PG8_MMA(1, 0, At, B0); PG8_BAR; PG8_SCHED;
            PG8_STAGE(PG8_SB(1, 1), b3 + hstep, voffB);
            PG8_WAIT_V(6); PG8_BAR; PG8_MMA(1, 1, At, B1); PG8_BAR;
            }
        }
        if constexpr (ALIGN_EPI) { if (wr == 0) PG8_BAR; }
        if constexpr (!Epi::AFTER_DRAIN) { E(acc, cur, wr, wc, fr, fq); S.done(cur); }
        if (!has_next) break;
#pragma unroll
        for (int a = 0; a < 2; ++a)
#pragma unroll
            for (int b = 0; b < 2; ++b)
#pragma unroll
                for (int m = 0; m < 4; ++m)
#pragma unroll
                    for (int n = 0; n < 2; ++n) acc[a][b][m][n] = (f32x4){0.f, 0.f, 0.f, 0.f};
        cur = nxt; cA = nA; cB = nB; ++ui;
        if constexpr (ALIGN_EPI) { if (wr == 1) PG8_BAR; }
    }
    PG8_WAIT_V(0);
    if constexpr (!ALIGN_EPI) { if (wr == 0) PG8_BAR; }
    PG8_BAR;
    if constexpr (Epi::AFTER_DRAIN) { E.fused(acc, cur, wr, wc, fr, fq, lds, wid, lane); S.done(cur); }
#undef PG8_SA
#undef PG8_SB
#undef PG8_STAGE
#undef PG8_LDA
#undef PG8_LDB
#undef PG8_MMA
#undef PG8_WAIT_V
#undef PG8_WAIT_L
#undef PG8_BAR
#undef PG8_SCHED
}
}
namespace pg8 {
__device__ __forceinline__ u32x4 pack8(const f32x4& v0, const f32x4& v1) { u32x4 w; w.x = cvt_pk_bf16(v0[0], v0[1]); w.y = cvt_pk_bf16(v0[2], v0[3]); w.z = cvt_pk_bf16(v1[0], v1[1]); w.w = cvt_pk_bf16(v1[2], v1[3]); return w; }
__device__ __forceinline__ float sigm(float x) { return __builtin_amdgcn_rcpf(1.0f + __expf(-x)); }
__device__ __forceinline__ f32x4 sigm4(const f32x4& v) { return (f32x4){sigm(v[0]), sigm(v[1]), sigm(v[2]), sigm(v[3])}; }
__device__ __forceinline__ float gelu_t(float x) { const float u = 1.5957691216057308f * (x + 0.044715f * x * x * x); return x * sigm(u); }
__device__ __forceinline__ f32x4 gelu4(const f32x4& v) { return (f32x4){gelu_t(v[0]), gelu_t(v[1]), gelu_t(v[2]), gelu_t(v[3])}; }

struct EpiIn {
    static constexpr bool PERM = true, AFTER_DRAIN = false;
    unsigned char* P; const float* bias;
    __device__ __forceinline__ void operator()(const f32x4 (&acc)[2][2][4][2], const Unit& u, int wr, int wc, int fr, int fq) const {
        const int pn = u.pn, row0 = u.pm * BM + wr * 64 + fr, cl = wc * 32 + 8 * fq;
        f32x4 bv[2][2];
#pragma unroll
        for (int bj = 0; bj < 2; ++bj)
#pragma unroll
            for (int n = 0; n < 2; ++n) bv[bj][n] = *(const f32x4*)(bias + pn * BM + bj * HALF + cl + 4 * n);
        if (pn < 10) {
            bf16_t* base = (bf16_t*)(P + (size_t)(pn >> 1) * (36u << 20));
            const float sc = (pn >= 2 && pn < 4) ? 0.08838834764831845f : 1.0f;
            const int act = pn < 6 ? 0 : pn < 8 ? 1 : 2;
            const int dcol = (pn & 1) * BM + cl;
#pragma unroll
            for (int ai = 0; ai < 2; ++ai)
#pragma unroll
                for (int m = 0; m < 4; ++m) { bf16_t* rowp = base + (size_t)(row0 + ai * HALF + m * 16) * 512 + dcol;
#pragma unroll
                    for (int bj = 0; bj < 2; ++bj) { f32x4 v0 = acc[ai][bj][m][0] + bv[bj][0], v1 = acc[ai][bj][m][1] + bv[bj][1];
                        if (act == 1) { v0 = sigm4(v0); v1 = sigm4(v1); } else if (act == 2) { v0 = gelu4(v0); v1 = gelu4(v1); } else { v0 = v0 * sc; v1 = v1 * sc; }
                        *(u32x4*)(rowp + bj * HALF) = pack8(v0, v1); } }
        } else if (pn < 12) {
            const int dcol = (pn - 10) * HALF + cl;
#pragma unroll
            for (int ai = 0; ai < 2; ++ai)
#pragma unroll
                for (int m = 0; m < 4; ++m) { bf16_t* rowp = (bf16_t*)(P + (size_t)5 * (36u << 20)) + (size_t)(row0 + ai * HALF + m * 16) * 256 + dcol;
                    const f32x4 a0 = acc[ai][0][m][0] + bv[0][0], a1 = acc[ai][0][m][1] + bv[0][1];
                    const f32x4 g0 = sigm4(acc[ai][1][m][0] + bv[1][0]), g1 = sigm4(acc[ai][1][m][1] + bv[1][1]);
                    *(u32x4*)rowp = pack8(a0 * g0, a1 * g1); }
        } else {
            if (wc == 0 && fq < 2) {
#pragma unroll
                for (int ai = 0; ai < 2; ++ai)
#pragma unroll
                    for (int m = 0; m < 4; ++m) { float* rowp = (float*)(P + (size_t)5 * (36u << 20) + (18u << 20)) + (size_t)(row0 + ai * HALF + m * 16) * 16 + 8 * fq;
                        *(f32x4*)rowp = acc[ai][0][m][0] + bv[0][0]; *(f32x4*)(rowp + 4) = acc[ai][0][m][1] + bv[0][1]; }
            }
        }
    }
};

struct EpiGU {
    static constexpr bool PERM = true, AFTER_DRAIN = false;
    bf16_t* H;
    __device__ __forceinline__ void operator()(const f32x4 (&acc)[2][2][4][2], const Unit& u, int wr, int wc, int fr, int fq) const {
        const int row0 = u.pm * BM + wr * 64 + fr, dcol = u.pn * HALF + wc * 32 + 8 * fq;
#pragma unroll
        for (int ai = 0; ai < 2; ++ai)
#pragma unroll
            for (int m = 0; m < 4; ++m) { bf16_t* rowp = H + (size_t)(row0 + ai * HALF + m * 16) * 2816 + dcol;
                const f32x4 g0 = acc[ai][0][m][0], g1 = acc[ai][0][m][1];
                *(u32x4*)rowp = pack8(g0 * sigm4(g0) * acc[ai][1][m][0], g1 * sigm4(g1) * acc[ai][1][m][1]); }
    }
};

struct EpiRes {
    static constexpr bool PERM = false, AFTER_DRAIN = false;
    const float* baseL; float* outL; const float* baseC; float* outC; const float* gate; int nlat;
    __device__ __forceinline__ void operator()(const f32x4 (&acc)[2][2][4][2], const Unit& u, int wr, int wc, int fr, int fq) const {
        const int trow = u.pm * BM; const bool lat = trow < nlat;
        const float* base = lat ? baseL + (size_t)trow * 1024 : baseC + (size_t)(trow - nlat) * 1024;
        float* out = lat ? outL + (size_t)trow * 1024 : outC + (size_t)(trow - nlat) * 1024;
        const float* gv = gate + (size_t)(lat ? (trow >> 11) : 16) * 6144;
        const int r0 = wr * 64 + fr, col0 = u.pn * BM + wc * 32 + 4 * fq;
        f32x4 g[2][2];
#pragma unroll
        for (int bj = 0; bj < 2; ++bj)
#pragma unroll
            for (int n = 0; n < 2; ++n) g[bj][n] = *(const f32x4*)(gv + col0 + bj * HALF + n * 16);
#pragma unroll
        for (int ai = 0; ai < 2; ++ai)
#pragma unroll
            for (int m = 0; m < 4; ++m) { const size_t off = (size_t)(r0 + ai * HALF + m * 16) * 1024 + col0;
#pragma unroll
                for (int bj = 0; bj < 2; ++bj)
#pragma unroll
                    for (int n = 0; n < 2; ++n) { const f32x4 b = *(const f32x4*)(base + off + bj * HALF + n * 16);
                        *(f32x4*)(out + off + bj * HALF + n * 16) = b + g[bj][n] * acc[ai][bj][m][n]; } }
    }
};
}
constexpr int D = 1024, NB = 16, SEQ = 2048, CTXL = 256, DEPTH = 2;
constexpr int ML = NB * SEQ, MC = NB * CTXL, MT = ML + MC;
constexpr int NIN_O = 3088, NIN = 3328, FF = 2816, NGU = 2 * FF;
constexpr int HW = 512;
constexpr int MODW = 6 * D;
constexpr float EPS = 1e-6f;
constexpr int NWAVES = 8, NTHREADS = 512;

constexpr size_t MiB = 1u << 20;
constexpr size_t WS_CTL = 0;
constexpr size_t WS_MOD = 1 * MiB;
constexpr size_t ZERO_BYTES = 2 * MiB;
constexpr size_t WS_BIN = 2 * MiB;
constexpr size_t WS_W = 3 * MiB, W_LAYER = 25 * MiB;
constexpr size_t WO_IN = 0, WO_OUT = 6 * MiB + 512 * 1024, WO_GU = WO_OUT + 2 * MiB, WO_DOWN = WO_GU + 11 * MiB;
constexpr size_t WS_XC = 53 * MiB;
constexpr size_t WS_A = 69 * MiB;
constexpr size_t WS_P = 141 * MiB;
constexpr size_t WS_Q = WS_P, WS_K = WS_Q + 36 * MiB, WS_V = WS_K + 36 * MiB, WS_OG = WS_V + 36 * MiB, WS_Z = WS_OG + 36 * MiB, WS_YC = WS_Z + 36 * MiB, WS_GT = WS_YC + 18 * MiB;
constexpr size_t WS_H = WS_P;
constexpr size_t WS_Y = 342 * MiB;
constexpr size_t WS_HS0 = WS_A, WS_HS1 = 414 * MiB;
constexpr size_t WS_END = 486 * MiB;
static_assert(WS_GT + (size_t)MT * 16 * 4 <= WS_Y && WS_H + (size_t)MT * FF * 2 <= WS_Y && WS_W + 2 * W_LAYER <= WS_XC && WO_DOWN + (size_t)D * FF * 2 <= W_LAYER, "ws map");

constexpr int RING_BYTES = 131072, MISC_OFF = RING_BYTES + 320, LDS_BYTES = 147456;

#define GAS __attribute__((address_space(1)))
#define LAS __attribute__((address_space(3)))
typedef unsigned short bf16;
typedef unsigned v4u __attribute__((ext_vector_type(4)));
typedef unsigned v2u __attribute__((ext_vector_type(2)));
typedef float f32x4 __attribute__((ext_vector_type(4)));
typedef float f32x2 __attribute__((ext_vector_type(2)));
#define LDS_WAIT() asm volatile("s_waitcnt lgkmcnt(0)" ::: "memory")
__device__ __forceinline__ unsigned f2bf(float f) { unsigned u = __builtin_bit_cast(unsigned, f); return (u + 0x7fffu + ((u >> 16) & 1u)) >> 16; }
__device__ __forceinline__ unsigned pk2(float lo, float hi) { return f2bf(lo) | (f2bf(hi) << 16); }
__device__ __forceinline__ float bf2f(unsigned short b) { return __builtin_bit_cast(float, (unsigned)b << 16); }
__device__ __forceinline__ float bflo(unsigned w) { return __builtin_bit_cast(float, w << 16); }
__device__ __forceinline__ float bfhi(unsigned w) { return __builtin_bit_cast(float, w & 0xffff0000u); }
__device__ __forceinline__ float fsigmoid(float x) { return __builtin_amdgcn_rcpf(1.0f + __expf(-x)); }
__device__ __forceinline__ float wave_sum(float v) {
#pragma unroll
    for (int o = 1; o < 64; o <<= 1) v += __shfl_xor(v, o);
    return v;
}
__device__ __forceinline__ int modrow_of(int row) { return row < ML ? (row >> 11) : 16; }
#define XB_TMO      128
#define XB_XCNT(j)  (256  + 64 * (j))
#define XB_XSUB(j)  (1280 + 64 * (j))
#define XB_XGEN(j)  (2304 + 64 * (j))
#define XB_TOP      3328
#define XB_TOPGEN   3392
#define XCD_BAR_WORDS 3456
#define XB_SPIN_CAP (1u << 18)

__device__ __forceinline__ unsigned xb_ld(unsigned* p)              { return __hip_atomic_load(p, __ATOMIC_RELAXED, __HIP_MEMORY_SCOPE_AGENT); }
__device__ __forceinline__ unsigned xb_add(unsigned* p, unsigned v) { return __hip_atomic_fetch_add(p, v, __ATOMIC_RELAXED, __HIP_MEMORY_SCOPE_AGENT); }
__device__ __forceinline__ unsigned xb_xcc_id() { return (unsigned)__builtin_amdgcn_s_getreg((3 << 11) | 20) & 0xFu; }
#define XB_SPIN(cond, bar) do { unsigned _sp = 0; while (cond) { __builtin_amdgcn_s_sleep(1); \
    if ((++_sp & 255u) == 0u) { if (xb_ld(&(bar)[XB_TMO])) break; if (_sp > XB_SPIN_CAP) { atomicAdd(&(bar)[XB_TMO], 1u); break; } } } } while (0)

struct XcdBarrier {
    unsigned* bar; unsigned x;
    volatile LAS unsigned* st;
};

__device__ __forceinline__ XcdBarrier xcd_barrier_post(unsigned* bar, volatile LAS unsigned* st) {
    XcdBarrier b; b.bar = bar; b.x = xb_xcc_id(); b.st = st;
    if (threadIdx.x == 0) (void)xb_add(&bar[XB_XCNT(b.x)], 1u);
    return b;
}
__device__ __forceinline__ void xcd_barrier_complete(unsigned* bar, unsigned x, unsigned& nloc, unsigned& nx) {
    const unsigned G = gridDim.x * gridDim.y * gridDim.z;
    unsigned sum, cnt, mine, sp = 0u;
    for (;;) {
        sum = 0u; cnt = 0u; mine = 0u;
#pragma unroll
        for (unsigned j = 0; j < 16; ++j) { const unsigned c = xb_ld(&bar[XB_XCNT(j)]); sum += c; cnt += (c > 0u) ? 1u : 0u; mine = (j == x) ? c : mine; }
        if (sum == G) break;
        __builtin_amdgcn_s_sleep(1);
        if ((++sp & 255u) == 0u) { if (xb_ld(&bar[XB_TMO])) break; if (sp > XB_SPIN_CAP) { atomicAdd(&bar[XB_TMO], 1u); break; } }
    }
    nloc = mine > 0u ? mine : 1u; nx = cnt > 0u ? cnt : 1u;
}

__device__ __forceinline__ void xcd_barrier(const XcdBarrier& b) {
    asm volatile("s_waitcnt vmcnt(0)" ::: "memory");
    __syncthreads();
    if (threadIdx.x == 0) {
        unsigned* bar = b.bar;
        __builtin_amdgcn_s_waitcnt(0);
        unsigned nloc = b.st[0], nx = b.st[1];
        if (nloc == 0u) { xcd_barrier_complete(bar, b.x, nloc, nx); b.st[0] = nloc; b.st[1] = nx; }
        const unsigned old = xb_add(&bar[XB_XSUB(b.x)], 1u);
        const unsigned gen = old / nloc;
        if (old + 1u == (gen + 1u) * nloc) {
            __builtin_amdgcn_fence(__ATOMIC_RELEASE, "agent");
            asm volatile("s_waitcnt vmcnt(0)" ::: "memory");
            const unsigned og = xb_add(&bar[XB_TOP], 1u);
            const unsigned tg = og / nx;
            if (og + 1u == (tg + 1u) * nx) xb_add(&bar[XB_TOPGEN], 1u);
            else XB_SPIN(xb_ld(&bar[XB_TOPGEN]) == tg, bar);
            __builtin_amdgcn_fence(__ATOMIC_ACQUIRE, "agent");
            xb_add(&bar[XB_XGEN(b.x)], 1u);
            asm volatile("s_waitcnt vmcnt(0)" ::: "memory");
        } else {
            XB_SPIN(xb_ld(&bar[XB_XGEN(b.x)]) == gen, bar);
            __builtin_amdgcn_fence(__ATOMIC_ACQUIRE, "agent");
            asm volatile("s_waitcnt vmcnt(0)" ::: "memory");
        }
    }
    __syncthreads();
}

struct Args { const float* in[23]; float* out; unsigned char* ws; int ph_lo, ph_hi; };
enum { I_X = 0, I_C, I_CTX, I_CCTX, I_WMOD, I_BMOD, I_N1G, I_WIN, I_BIN, I_MG, I_SLG, I_SLB, I_SW, I_SB, I_CW, I_CB, I_CLG, I_CLB, I_WOUT, I_N2G, I_WGU, I_WDOWN, I_FG };

__device__ __forceinline__ int win_src_col(int n) {
    if (n < 2048) return n;
    if (n < 2560) return n + 16;
    if (n < 3072) { const int j = n - 2560, tile = j >> 8, jj = j & 255; return 2576 + (jj >> 7) * 256 + tile * 128 + (jj & 127); }
    if (n < 3088) return 2048 + (n - 3072);
    return -1;
}
__device__ __forceinline__ int wgu_src_col(int n) { const int tile = n >> 8, jj = n & 255; return (jj >> 7) * FF + tile * 128 + (jj & 127); }

__device__ __forceinline__ void transpose_item(const float* W, int K, int Nsrc, bf16* WT, int n0, int srcc0, int nvalid, int k0, LAS float* scr, int lane) {
    const int c = lane & 31;
#pragma unroll 8
    for (int i = 0; i < 32; ++i) { const int kk = 2 * i + (lane >> 5);
        float v = 0.f; if (srcc0 >= 0 && c < nvalid) v = W[(size_t)(k0 + kk) * Nsrc + srcc0 + c];
        scr[kk * 33 + c] = v; }
    LDS_WAIT(); asm volatile("" ::: "memory");
    const int c8 = lane & 7;
#pragma unroll
    for (int j = 0; j < 4; ++j) { const int n = (lane >> 3) + 8 * j; const LAS float* s = scr + (8 * c8) * 33 + n;
        v4u o; o.x = pk2(s[0 * 33], s[1 * 33]); o.y = pk2(s[2 * 33], s[3 * 33]); o.z = pk2(s[4 * 33], s[5 * 33]); o.w = pk2(s[6 * 33], s[7 * 33]);
        *(v4u*)(WT + (size_t)(n0 + n) * K + k0 + 8 * c8) = o; }
    LDS_WAIT(); asm volatile("" ::: "memory");
}

__device__ __forceinline__ void phase_prologue(const Args& a, LAS unsigned char* lds, int G, int tid, int lane, int wave) {
    unsigned char* ws = a.ws;
    LAS float* scr = (LAS float*)(lds + wave * 16384);
    const int gw = blockIdx.x * NWAVES + wave, NGW = G * NWAVES;
    constexpr int I_IN = 16 * (NIN / 32), I_OUT = 16 * 32, I_GU = 16 * (NGU / 32), I_DN = (FF / 64) * 32, I_LAYER = I_IN + I_OUT + I_GU + I_DN;
    for (int it = gw; it < 2 * I_LAYER; it += NGW) {
        const int l = it / I_LAYER; int r = it % I_LAYER;
        unsigned char* wl = ws + WS_W + (size_t)l * W_LAYER;
        if (r < I_IN) { const int kb = r / (NIN / 32), nb = r % (NIN / 32), n0 = nb * 32, sc = win_src_col(n0);
            transpose_item(a.in[I_WIN] + (size_t)l * D * NIN_O, D, NIN_O, (bf16*)(wl + WO_IN), n0, sc, n0 == 3072 ? 16 : 32, kb * 64, scr, lane); continue; }
        r -= I_IN;
        if (r < I_OUT) { const int kb = r / 32, nb = r % 32;
            transpose_item(a.in[I_WOUT] + (size_t)l * D * D, D, D, (bf16*)(wl + WO_OUT), nb * 32, nb * 32, 32, kb * 64, scr, lane); continue; }
        r -= I_OUT;
        if (r < I_GU) { const int kb = r / (NGU / 32), nb = r % (NGU / 32), n0 = nb * 32;
            transpose_item(a.in[I_WGU] + (size_t)l * D * NGU, D, NGU, (bf16*)(wl + WO_GU), n0, wgu_src_col(n0), 32, kb * 64, scr, lane); continue; }
        r -= I_GU;
        { const int kb = r / 32, nb = r % 32;
            transpose_item(a.in[I_WDOWN] + (size_t)l * FF * D, FF, D, (bf16*)(wl + WO_DOWN), nb * 32, nb * 32, 32, kb * 64, scr, lane); }
    }
    for (int e = blockIdx.x * NTHREADS + tid; e < 2 * NIN; e += G * NTHREADS) { const int l = e / NIN, n = e % NIN, s = win_src_col(n);
        ((float*)(ws + WS_BIN))[e] = s >= 0 ? a.in[I_BIN][l * NIN_O + s] : 0.f; }
    __syncthreads();
    LAS float* sl = (LAS float*)lds;
    float* MOD = (float*)(ws + WS_MOD);
    for (int it = blockIdx.x; it < 2 * 12 * 16; it += G) {
        const int l = it / 192, jb = (it % 192) / 16, ks = it % 16;
        for (int e = tid; e < 17 * 64; e += NTHREADS) { const int r = e >> 6, k = e & 63; const float cv = r < 16 ? a.in[I_C][r * D + ks * 64 + k] : a.in[I_CCTX][ks * 64 + k]; sl[e] = cv * fsigmoid(cv); }
        __syncthreads();
        const int j = jb * 512 + tid;
        float acc[17];
#pragma unroll
        for (int r = 0; r < 17; ++r) acc[r] = 0.f;
        const float* wp = a.in[I_WMOD] + (size_t)l * D * MODW + (size_t)(ks * 64) * MODW + j;
#pragma unroll 4
        for (int k = 0; k < 64; ++k) { const float w = wp[(size_t)k * MODW];
#pragma unroll
            for (int r = 0; r < 17; ++r) acc[r] += sl[r * 64 + k] * w; }
        const float bm = ks == 0 ? a.in[I_BMOD][l * MODW + j] : 0.f;
#pragma unroll
        for (int r = 0; r < 17; ++r) atomicAdd(MOD + (size_t)(l * 17 + r) * MODW + j, acc[r] + bm);
        __syncthreads();
    }
}

__device__ __forceinline__ void phase_norm(const float* xl, const float* xc, bf16* A, const float* g, const float* mod, int sh_off, int nrows, int G, int lane, int wave) {
    const int gw = blockIdx.x * NWAVES + wave, NGW = G * NWAVES;
    for (int r = gw; r < nrows; r += NGW) {
        const float* xr = r < ML ? xl + (size_t)r * D : xc + (size_t)(r - ML) * D;
        const float* mr = mod + (size_t)modrow_of(r) * MODW + sh_off;
        f32x4 v[4]; float s = 0.f;
#pragma unroll
        for (int j = 0; j < 4; ++j) { v[j] = ((const f32x4*)xr)[lane + 64 * j]; s += (v[j].x * v[j].x + v[j].y * v[j].y) + (v[j].z * v[j].z + v[j].w * v[j].w); }
        const float rstd = 1.0f / sqrtf(wave_sum(s) * (1.0f / D) + EPS);
        unsigned long long* o8 = (unsigned long long*)(A + (size_t)r * D) + lane;
#pragma unroll
        for (int j = 0; j < 4; ++j) { const int c = (lane + 64 * j) * 4;
            const f32x4 gg = *(const f32x4*)(g + c), sh = *(const f32x4*)(mr + c), sc = *(const f32x4*)(mr + D + c);
            const f32x4 y = v[j] * rstd * gg * (1.0f + sc) + sh;
            o8[64 * j] = (unsigned long long)pk2(y.x, y.y) | ((unsigned long long)pk2(y.z, y.w) << 32); }
    }
}

__device__ __forceinline__ void phase_final(float* x, const float* g, int G, int lane, int wave) {
    const int gw = blockIdx.x * NWAVES + wave, NGW = G * NWAVES;
    for (int r = gw; r < ML; r += NGW) {
        float* xr = x + (size_t)r * D;
        f32x4 v[4]; float s = 0.f;
#pragma unroll
        for (int j = 0; j < 4; ++j) { v[j] = ((const f32x4*)xr)[lane + 64 * j]; s += (v[j].x * v[j].x + v[j].y * v[j].y) + (v[j].z * v[j].z + v[j].w * v[j].w); }
        const float rstd = 1.0f / sqrtf(wave_sum(s) * (1.0f / D) + EPS);
#pragma unroll
        for (int j = 0; j < 4; ++j) { const f32x4 gg = ((const f32x4*)g)[lane + 64 * j]; ((f32x4*)xr)[lane + 64 * j] = v[j] * rstd * gg; }
    }
}

constexpr int TB = 16;
__device__ __forceinline__ void mlstm_scan_item(const bf16* Q, const bf16* K, const bf16* V, const float* GT, float* HS0, float* HS1, int item, bool ctx_out, LAS unsigned char* lds, int tid) {
    const int b = item >> 3, h = (item >> 1) & 3, dir = item & 1;
    const int dv = tid & 127, kq = tid >> 7;
    LAS float* kbuf = (LAS float*)lds;
    LAS float* vbuf = kbuf + TB * 128;
    LAS float* qbuf = vbuf + TB * 128;
    LAS float* ibuf = qbuf + TB * 128;
    LAS float* fbuf = ibuf + TB;
    LAS float* red = fbuf + TB;
    LAS float* redd = red + 2 * 4 * 128;
    float* HS = dir ? HS1 : HS0;
    float C[32], nn[32];
#pragma unroll
    for (int j = 0; j < 32; ++j) { C[j] = 0.f; nn[j] = 0.f; }
    float m = 0.f; int par = 0;
    for (int s0 = 0; s0 < CTXL + SEQ; s0 += TB) {
        const bool isctx = s0 < CTXL; const int len = isctx ? CTXL : SEQ, i0 = isctx ? s0 : s0 - CTXL;
        const int rbase = isctx ? ML + b * CTXL : b * SEQ;
        for (int e = tid; e < TB * 384; e += NTHREADS) { const int tok = e / 384, c = e % 384, which = c >> 7, d = c & 127;
            const int t = dir ? (len - 1 - (i0 + tok)) : (i0 + tok); const size_t off = (size_t)(rbase + t) * HW + h * 128 + d;
            const bf16* src = which == 0 ? K : which == 1 ? V : Q;
            (which == 0 ? kbuf : which == 1 ? vbuf : qbuf)[tok * 128 + d] = bf2f(src[off]); }
        if (tid < TB) { const int t = dir ? (len - 1 - (i0 + tid)) : (i0 + tid); const float* gp = GT + (size_t)(rbase + t) * 16 + dir * 8 + h;
            const float iv = gp[0], fv = gp[4];
            ibuf[tid] = iv; fbuf[tid] = fminf(fv, 0.f) - log1pf(__expf(-fabsf(fv))); }
        __syncthreads();
        const bool wr_out = !isctx || ctx_out;
        for (int tok = 0; tok < TB; ++tok) {
            const float it = ibuf[tok], lf = fbuf[tok];
            const float mn = fmaxf(lf + m, it), aa = __expf(lf + m - mn), bc = __expf(it - mn); m = mn;
            const float vv = vbuf[tok * 128 + dv] * bc;
            float part = 0.f, dpart = 0.f;
            const LAS float* kp = kbuf + tok * 128 + kq * 32; const LAS float* qp = qbuf + tok * 128 + kq * 32;
#pragma unroll
            for (int j = 0; j < 32; ++j) { const float kk = kp[j], qq = qp[j];
                C[j] = aa * C[j] + kk * vv; part += C[j] * qq;
                nn[j] = aa * nn[j] + bc * kk; dpart += nn[j] * qq; }
            red[(par * 4 + kq) * 128 + dv] = part; if (dv == 0) redd[par * 4 + kq] = dpart;
            __syncthreads();
            if (tid < 128 && wr_out) {
                const float num = (red[(par * 4 + 0) * 128 + tid] + red[(par * 4 + 1) * 128 + tid]) + (red[(par * 4 + 2) * 128 + tid] + red[(par * 4 + 3) * 128 + tid]);
                const float den = (redd[par * 4 + 0] + redd[par * 4 + 1]) + (redd[par * 4 + 2] + redd[par * 4 + 3]);
                const int t = dir ? (len - 1 - (i0 + tok)) : (i0 + tok);
                HS[(size_t)(rbase + t) * HW + h * 128 + tid] = num / fmaxf(fabsf(den), __expf(-m));
            }
            par ^= 1;
        }
    }
    __syncthreads();
}

__device__ __forceinline__ void phase_mlstm_post(const float* HS0, const float* HS1, const bf16* OG, const float* mg, bf16* Y, int nrows, int G, int lane, int wave) {
    const int gw = blockIdx.x * NWAVES + wave, NGW = G * NWAVES;
    for (int r = gw; r < nrows; r += NGW) {
        const size_t off = (size_t)r * HW + lane * 8;
        const f32x4 a0 = *(const f32x4*)(HS0 + off), a1 = *(const f32x4*)(HS0 + off + 4), b0 = *(const f32x4*)(HS1 + off), b1 = *(const f32x4*)(HS1 + off + 4);
        const f32x4 h0 = a0 + b0, h1 = a1 + b1;
        float s = (h0.x * h0.x + h0.y * h0.y) + (h0.z * h0.z + h0.w * h0.w) + (h1.x * h1.x + h1.y * h1.y) + (h1.z * h1.z + h1.w * h1.w);
        s += __shfl_xor(s, 1); s += __shfl_xor(s, 2); s += __shfl_xor(s, 4); s += __shfl_xor(s, 8);
        const float rs = 1.0f / sqrtf(s * (1.0f / 128.0f) + EPS);
        const v4u og = *(const v4u*)(OG + off);
        const f32x4 g0 = *(const f32x4*)(mg + lane * 8), g1 = *(const f32x4*)(mg + lane * 8 + 4);
        v4u o;
        o.x = pk2(h0.x * rs * g0.x * bflo(og.x), h0.y * rs * g0.y * bfhi(og.x)); o.y = pk2(h0.z * rs * g0.z * bflo(og.y), h0.w * rs * g0.w * bfhi(og.y));
        o.z = pk2(h1.x * rs * g1.x * bflo(og.z), h1.y * rs * g1.y * bfhi(og.z)); o.w = pk2(h1.z * rs * g1.z * bflo(og.w), h1.w * rs * g1.w * bfhi(og.w));
        *(v4u*)(Y + (size_t)r * D + lane * 8) = o;
    }
}

__device__ __forceinline__ void sgu_item(const bf16* Z, const float* lg, const float* lb, const float* sw, const float* sb, bf16* Y, int chunk, LAS unsigned char* lds, int tid, int lane, int wave) {
    LAS float* vn = (LAS float*)lds;
    const int row0 = chunk * 128;
    for (int t = wave; t < 128; t += NWAVES) {
        const v2u raw = *(const v2u*)(Z + (size_t)(row0 + t) * 512 + 256 + lane * 4);
        const float x0 = bflo(raw.x), x1 = bfhi(raw.x), x2 = bflo(raw.y), x3 = bfhi(raw.y);
        const float mu = wave_sum((x0 + x1) + (x2 + x3)) * (1.0f / 256.0f);
        const float d0 = x0 - mu, d1 = x1 - mu, d2 = x2 - mu, d3 = x3 - mu;
        const float var = wave_sum((d0 * d0 + d1 * d1) + (d2 * d2 + d3 * d3)) * (1.0f / 256.0f);
        const float rs = 1.0f / sqrtf(var + EPS);
        const f32x4 g = *(const f32x4*)(lg + lane * 4), bb = *(const f32x4*)(lb + lane * 4);
        *(LAS f32x4*)(vn + t * 256 + lane * 4) = (f32x4){d0 * rs * g.x + bb.x, d1 * rs * g.y + bb.y, d2 * rs * g.z + bb.z, d3 * rs * g.w + bb.w};
    }
    __syncthreads();
    const int ch = tid & 255, ph = tid >> 8, g = __builtin_amdgcn_readfirstlane(ch >> 6);
    const float* wg = sw + (size_t)g * 128 * 128; const float* bg = sb + g * 128;
    for (int p = ph * 64; p < ph * 64 + 64; ++p) {
        const float* wr = wg + p * 128; float acc = 0.f;
#pragma unroll 8
        for (int q = 0; q < 128; ++q) acc += wr[q] * vn[q * 256 + ch];
        const float u = bf2f(Z[(size_t)(row0 + p) * 512 + ch]);
        Y[(size_t)(row0 + p) * D + 512 + ch] = (bf16)f2bf(u * (acc + bg[p]));
    }
    __syncthreads();
}

__device__ __forceinline__ void conv_rows(const bf16* YC, const float* cw, const float* cb, const float* lg, const float* lb, bf16* Y, int row0, int nrows, int lane, int wave) {
    const int c0 = lane * 4;
    for (int rr = wave; rr < nrows; rr += NWAVES) {
        const int r = row0 + rr;
        f32x4 acc = *(const f32x4*)(cb + c0);
        int base, pos, len, stride;
        if (r < ML) { const int b = r >> 11, t = r & 2047;
            if (lane < 32) { base = (b << 11) + (t & ~63); pos = t & 63; len = 64; stride = 1; }
            else           { base = (b << 11) + (t & 63); pos = t >> 6; len = 32; stride = 64; } }
        else { const int rc = r - ML; base = ML + (rc & ~255); pos = rc & 255; len = 256; stride = 1; }
#pragma unroll 1
        for (int k = 0; k < 31; ++k) { const int p = pos + k - 15;
            if (p >= 0 && p < len) { const v2u raw = *(const v2u*)(YC + (size_t)(base + p * stride) * 256 + c0); const f32x4 w = *(const f32x4*)(cw + k * 256 + c0);
                acc.x += w.x * bflo(raw.x); acc.y += w.y * bfhi(raw.x); acc.z += w.z * bflo(raw.y); acc.w += w.w * bfhi(raw.y); } }
        const float mu = wave_sum((acc.x + acc.y) + (acc.z + acc.w)) * (1.0f / 256.0f);
        const float d0 = acc.x - mu, d1 = acc.y - mu, d2 = acc.z - mu, d3 = acc.w - mu;
        const float var = wave_sum((d0 * d0 + d1 * d1) + (d2 * d2 + d3 * d3)) * (1.0f / 256.0f);
        const float rs = 1.0f / sqrtf(var + EPS);
        const f32x4 g = *(const f32x4*)(lg + c0), bb = *(const f32x4*)(lb + c0);
        float y0 = d0 * rs * g.x + bb.x, y1 = d1 * rs * g.y + bb.y, y2 = d2 * rs * g.z + bb.z, y3 = d3 * rs * g.w + bb.w;
        y0 *= fsigmoid(y0); y1 *= fsigmoid(y1); y2 *= fsigmoid(y2); y3 *= fsigmoid(y3);
        v2u o; o.x = pk2(y0, y1); o.y = pk2(y2, y3);
        *(v2u*)(Y + (size_t)r * D + 768 + c0) = o;
    }
}
constexpr int N_PHASES = 18;
#ifndef MK_ONE_LAUNCH
#define MK_ONE_LAUNCH 0
#endif
#ifndef PH_MASK
#define PH_MASK 0x3ff
#endif
#define PH_EN(b) (((PH_MASK) >> (b)) & 1)

__global__ void __launch_bounds__(NTHREADS, 2) fwd_kernel(Args args) {
    extern __shared__ __attribute__((aligned(16))) unsigned char lds_raw[];
    LAS unsigned char* lds = (LAS unsigned char*)lds_raw;
    const int G = gridDim.x;
    unsigned char* ws = args.ws;
    volatile LAS unsigned* MISC = (volatile LAS unsigned*)(lds + MISC_OFF);
    for (int u = threadIdx.x; u < (LDS_BYTES - RING_BYTES) / 4; u += NTHREADS) ((LAS unsigned*)(lds + RING_BYTES))[u] = 0u;
    __syncthreads();
    XcdBarrier bar; bar.bar = (unsigned*)(ws + WS_CTL) + 4096; bar.x = 0; bar.st = nullptr;
    const int lo = args.ph_lo, hi = args.ph_hi;
    if (hi - lo > 1) bar = xcd_barrier_post((unsigned*)(ws + WS_CTL) + 4096, MISC + 8);
#define IN(k) (lo <= (k) && (k) < hi)
#define SEAM(k) do { if (IN(k) && IN((k) + 1)) xcd_barrier(bar); } while (0)

#pragma unroll 1
    for (int ph = lo; ph < hi; ++ph) {
        int tid = threadIdx.x; asm volatile("" : "+v"(tid));
        const int lane = tid & 63, wave = __builtin_amdgcn_readfirstlane(tid >> 6);
        if (ph == 0) { if (PH_EN(8)) phase_prologue(args, lds, G, tid, lane, wave); }
        else if (ph == N_PHASES - 1) { if (PH_EN(9)) phase_final(args.out, args.in[I_FG], G, lane, wave); }
        else {
            const int l = (ph - 1) >> 3, k = (ph - 1) & 7;
            const bool last = (l == DEPTH - 1);
            const int mrest = last ? ML : MT;
            const float* modl = (const float*)(ws + WS_MOD) + (size_t)l * 17 * MODW;
            const unsigned char* wl = ws + WS_W + (size_t)l * W_LAYER;
            if (k == 0 && PH_EN(0)) {
                phase_norm(l == 0 ? args.in[I_X] : args.out, l == 0 ? args.in[I_CTX] : (const float*)(ws + WS_XC), (bf16*)(ws + WS_A), args.in[I_N1G] + l * D, modl, 0, MT, G, lane, wave);
            } else if (k == 1 && PH_EN(1)) {
                pg8::Gemm g{(const bf16*)(ws + WS_A), (const bf16*)(wl + WO_IN), MT, NIN, D}; pg8::StaticOrder S; S.init(MT, NIN, G, (int)blockIdx.x);
                pg8::EpiIn E{ws + WS_P, (const float*)(ws + WS_BIN) + l * NIN};
                pg8::gemm_phase<pg8::EpiIn, pg8::StaticOrder, true, true>(lds, g, S, E, tid);
            } else if (k == 2 && PH_EN(2)) {
                const int nscan = G >= 256 ? 128 : G / 2;
                if ((int)blockIdx.x < nscan) {
                    for (int it = blockIdx.x; it < 128; it += nscan)
                        mlstm_scan_item((const bf16*)(ws + WS_Q), (const bf16*)(ws + WS_K), (const bf16*)(ws + WS_V), (const float*)(ws + WS_GT), (float*)(ws + WS_HS0), (float*)(ws + WS_HS1), it, !last, lds, tid);
                } else {
                    const int nch = mrest / 128;
                    for (int it = blockIdx.x - nscan; it < nch; it += G - nscan) {
                        sgu_item((const bf16*)(ws + WS_Z), args.in[I_SLG] + l * 256, args.in[I_SLB] + l * 256, args.in[I_SW] + (size_t)l * 4 * 128 * 128, args.in[I_SB] + l * 4 * 128, (bf16*)(ws + WS_Y), it, lds, tid, lane, wave);
                        conv_rows((const bf16*)(ws + WS_YC), args.in[I_CW] + l * 31 * 256, args.in[I_CB] + l * 256, args.in[I_CLG] + l * 256, args.in[I_CLB] + l * 256, (bf16*)(ws + WS_Y), it * 128, 128, lane, wave);
                    }
                }
            } else if (k == 3 && PH_EN(3)) {
                phase_mlstm_post((const float*)(ws + WS_HS0), (const float*)(ws + WS_HS1), (const bf16*)(ws + WS_OG), args.in[I_MG] + l * HW, (bf16*)(ws + WS_Y), mrest, G, lane, wave);
            } else if (k == 4 && PH_EN(4)) {
                pg8::Gemm g{(const bf16*)(ws + WS_Y), (const bf16*)(wl + WO_OUT), mrest, D, D}; pg8::StaticOrder S; S.init(mrest, D, G, (int)blockIdx.x);
                pg8::EpiRes E{l == 0 ? args.in[I_X] : args.out, args.out, l == 0 ? args.in[I_CTX] : (const float*)(ws + WS_XC), (float*)(ws + WS_XC), modl + 2 * D, ML};
                pg8::gemm_phase<pg8::EpiRes, pg8::StaticOrder, true, true>(lds, g, S, E, tid);
            } else if (k == 5 && PH_EN(5)) {
                phase_norm(args.out, (const float*)(ws + WS_XC), (bf16*)(ws + WS_A), args.in[I_N2G] + l * D, modl, 3 * D, mrest, G, lane, wave);
            } else if (k == 6 && PH_EN(6)) {
                pg8::Gemm g{(const bf16*)(ws + WS_A), (const bf16*)(wl + WO_GU), mrest, NGU, D}; pg8::StaticOrder S; S.init(mrest, NGU, G, (int)blockIdx.x);
                pg8::EpiGU E{(bf16*)(ws + WS_H)};
                pg8::gemm_phase<pg8::EpiGU, pg8::StaticOrder, true, true>(lds, g, S, E, tid);
            } else if (PH_EN(7)) {
                pg8::Gemm g{(const bf16*)(ws + WS_H), (const bf16*)(wl + WO_DOWN), mrest, D, FF}; pg8::StaticOrder S; S.init(mrest, D, G, (int)blockIdx.x);
                pg8::EpiRes E{args.out, args.out, (const float*)(ws + WS_XC), (float*)(ws + WS_XC), modl + 5 * D, ML};
                pg8::gemm_phase<pg8::EpiRes, pg8::StaticOrder, true, true>(lds, g, S, E, tid);
            }
        }
        if (ph + 1 < hi) xcd_barrier(bar);
    }
#undef IN
#undef SEAM
}

extern "C" void kernel_launch(void* const* d_in, const int* in_sizes, int n_in, void* d_out, int out_size, void* d_ws, size_t ws_size, hipStream_t stream) {
    static int grid = 0;
    if (grid == 0) {
        if (n_in != 23 || in_sizes[0] != ML * D || out_size != ML * D || ws_size < WS_END) {
            fprintf(stderr, "kernel_launch: unexpected problem (n_in %d, in0 %d, out %d, ws %zu < %zu); nothing launched\n", n_in, n_in > 0 ? in_sizes[0] : -1, out_size, ws_size, (size_t)WS_END); grid = -1; return; }
        int dev = 0, cus = 0, per_cu = 0;
        if (hipGetDevice(&dev) != hipSuccess || hipDeviceGetAttribute(&cus, hipDeviceAttributeMultiprocessorCount, dev) != hipSuccess) { grid = -1; return; }
        if (hipFuncSetAttribute((const void*)fwd_kernel, hipFuncAttributeMaxDynamicSharedMemorySize, LDS_BYTES) != hipSuccess) { fprintf(stderr, "kernel_launch: hipFuncSetAttribute failed\n"); grid = -1; return; }
        if (hipOccupancyMaxActiveBlocksPerMultiprocessor(&per_cu, (const void*)fwd_kernel, NTHREADS, LDS_BYTES) != hipSuccess || per_cu < 1) {
            fprintf(stderr, "kernel_launch: occupancy query reports %d blocks per CU\n", per_cu); per_cu = 1; }
        (void)hipGetLastError();
        grid = cus;
    }
    if (grid < 0) return;
    if (hipMemsetAsync((char*)d_ws + WS_CTL, 0, ZERO_BYTES, stream) != hipSuccess) { fprintf(stderr, "kernel_launch: memset failed\n"); return; }
    Args a{};
    for (int i = 0; i < 23; ++i) a.in[i] = (const float*)d_in[i];
    a.out = (float*)d_out; a.ws = (unsigned char*)d_ws;
#if MK_ONE_LAUNCH
    a.ph_lo = 0; a.ph_hi = N_PHASES;
    hipLaunchKernelGGL(fwd_kernel, dim3(grid), dim3(NTHREADS), LDS_BYTES, stream, a);
#else
    for (int p = 0; p < N_PHASES; ++p) { a.ph_lo = p; a.ph_hi = p + 1; hipLaunchKernelGGL(fwd_kernel, dim3(grid), dim3(NTHREADS), LDS_BYTES, stream, a); }
#endif
    const hipError_t le = hipPeekAtLastError();
    if (le != hipSuccess) fprintf(stderr, "kernel_launch: launch failed: %s\n", hipGetErrorName(le));
}
```

```cpp
#include <hip/hip_runtime.h>
#include <cstdio>
#include <cstdint>
#ifndef MK_ONE_LAUNCH
#define MK_ONE_LAUNCH 1
#endif
namespace pg8 {
#define PG8_LAS __attribute__((address_space(3)))
typedef unsigned short bf16_t;
typedef short bf16x8 __attribute__((ext_vector_type(8)));
typedef float f32x4 __attribute__((ext_vector_type(4)));
typedef unsigned u32x4 __attribute__((ext_vector_type(4)));
constexpr int BM = 256, BK = 64, HALF = 128, HTB = HALF * BK * 2  , STAGE_BYTES = 8 * HTB, NXCD = 8, WGM = 8;

__host__ __device__ __forceinline__ int lds_byte(int r, int c) { const int st = (r >> 4) * 2 + (c >> 5), rr = r & 15, cc = c & 31, ob = rr * 64 + cc * 2; return st * 1024 + (ob ^ (((ob >> 9) & 1) << 5)); }
__host__ __device__ __forceinline__ void stage_rc(int b, int& R, int& C) { const int st = b / 1024, sb = b % 1024, swz = sb ^ (((sb >> 9) & 1) << 5); R = (st >> 1) * 16 + swz / 64; C = (st & 1) * 32 + (swz % 64) / 2; }
__host__ __device__ __forceinline__ int perm32(int rho) { const int n = rho >> 4, i = rho & 15; return 8 * (i >> 2) + 4 * n + (i & 3); }

struct Unit { int pm, pn; };
struct Gemm { const bf16_t* A; const bf16_t* Bt; int M, N, K; };

struct StaticOrder {
    int nM, nN, nwg, G, c;
    __host__ __device__ void init(int M, int N, int G_, int c_) { nM = M / BM; nN = N / BM; nwg = nM * nN; G = G_; c = c_; }
    __host__ __device__ bool next(int i, Unit& u) const {
        const long L = (long)i * G + c; if (L >= nwg) return false;
        int wgid = (int)L; { const int q = nwg / NXCD, r = nwg % NXCD, xcd = wgid % NXCD, off = wgid / NXCD; wgid = (xcd < r ? xcd * (q + 1) : r * (q + 1) + (xcd - r) * q) + off; }
        const int nig = WGM * nN, gid = wgid / nig, fm = gid * WGM, gsz = (nM - fm) < WGM ? (nM - fm) : WGM;
        u.pm = fm + ((wgid % nig) % gsz); u.pn = (wgid % nig) / gsz; return true;
    }
    __device__ __forceinline__ void a_ready(const Unit&) const {}
    __device__ __forceinline__ void done(const Unit&) const {}
};

__device__ __forceinline__ unsigned cvt_pk_bf16(float lo, float hi) { unsigned r; asm volatile("v_cvt_pk_bf16_f32 %0, %1, %2" : "=v"(r) : "v"(lo), "v"(hi)); return r; }
template <class Epi, class Sched, bool ALIGN_EPI = false, bool SP2 = false>
__device__ __forceinline__ void gemm_phase(PG8_LAS unsigned char* lds, const Gemm g, const Sched& S, const Epi& E, const int tid) {
    const int wid = __builtin_amdgcn_readfirstlane(tid >> 6), lane = tid & 63, wr = wid >> 2, wc = wid & 3, fr = lane & 15, fq = lane >> 4;
    const int K = g.K, nt = K / BK;
    unsigned voffA[2], voffB[2];
#pragma unroll
    for (int i = 0; i < 2; ++i) { int R, C; stage_rc(tid * 16 + i * 8192, R, C); const int Rb = Epi::PERM ? ((R & ~31) + perm32(R & 31)) : R;
        voffA[i] = (unsigned)(R * K + C) * 2u; voffB[i] = (unsigned)(Rb * K + C) * 2u; }
    const size_t kstep = (size_t)(BK * 2);
    const size_t hstep = (size_t)HALF * K * 2;
    const size_t tstep = 2 * hstep;
    const unsigned ldsw = (unsigned)wid * 1024u;
    const int aoff = lds_byte(wr * 64 + fr, fq * 8), boff = lds_byte(wc * 32 + fr, fq * 8);
#define PG8_SA(b, h) (((b) * 2 + (h)) * HTB)
#define PG8_SB(b, h) ((4 + (b) * 2 + (h)) * HTB)
#define PG8_STAGE(bufoff, gbase, voff) do { _Pragma("unroll") for (int _i = 0; _i < 2; ++_i) \
        __builtin_amdgcn_global_load_lds((const unsigned*)((const char*)(gbase) + (voff)[_i]), (PG8_LAS unsigned*)(lds + (bufoff) + ldsw + _i * 8192), 16, 0, 0); } while (0)
#define PG8_LDA(dst, b, h) do { _Pragma("unroll") for (int m = 0; m < 4; ++m) _Pragma("unroll") for (int k = 0; k < 2; ++k) dst[m][k] = *(const PG8_LAS bf16x8*)(lds + PG8_SA(b, h) + aoff + m * 2048 + k * 1024); } while (0)
#define PG8_LDB(dst, b, h) do { _Pragma("unroll") for (int n = 0; n < 2; ++n) _Pragma("unroll") for (int k = 0; k < 2; ++k) dst[n][k] = *(const PG8_LAS bf16x8*)(lds + PG8_SB(b, h) + boff + n * 2048 + k * 1024); } while (0)
#define PG8_MMA(ai, bj, At, Bt) do { __builtin_amdgcn_s_setprio(1); _Pragma("unroll") for (int m = 0; m < 4; ++m) _Pragma("unroll") for (int n = 0; n < 2; ++n) _Pragma("unroll") for (int k = 0; k < 2; ++k) \
        acc[ai][bj][m][n] = __builtin_amdgcn_mfma_f32_16x16x32_bf16(Bt[n][k], At[m][k], acc[ai][bj][m][n], 0, 0, 0); __builtin_amdgcn_s_setprio(0); } while (0)
#define PG8_WAIT_V(n) asm volatile("s_waitcnt vmcnt(" #n ")" ::: "memory")
#define PG8_WAIT_L(n) asm volatile("s_waitcnt lgkmcnt(" #n ")" ::: "memory")
#define PG8_BAR __builtin_amdgcn_s_barrier()
#define PG8_SCHED __builtin_amdgcn_sched_barrier(0)
    Unit cur, nxt; int ui = 0;
    if (!S.next(0, cur)) return;
    f32x4 acc[2][2][4][2];
#pragma unroll
    for (int a = 0; a < 2; ++a)
#pragma unroll
        for (int b = 0; b < 2; ++b)
#pragma unroll
            for (int m = 0; m < 4; ++m)
#pragma unroll
                for (int n = 0; n < 2; ++n) acc[a][b][m][n] = (f32x4){0.f, 0.f, 0.f, 0.f};
    bf16x8 At[4][2], B0[2][2], B1[2][2];
    const char* cA = (const char*)g.A + (size_t)cur.pm * tstep; const char* cB = (const char*)g.Bt + (size_t)cur.pn * tstep;
    S.a_ready(cur);
    if constexpr (SP2) {
        PG8_STAGE(PG8_SB(0, 0), cB, voffB); PG8_STAGE(PG8_SB(0, 1), cB + hstep, voffB); PG8_STAGE(PG8_SA(0, 0), cA, voffA); PG8_STAGE(PG8_SA(0, 1), cA + hstep, voffA);
        if (wr == 1) PG8_BAR;
        PG8_WAIT_V(2); PG8_BAR;
        PG8_STAGE(PG8_SB(1, 0), cB + kstep, voffB); PG8_STAGE(PG8_SA(1, 0), cA + kstep, voffA); PG8_STAGE(PG8_SB(1, 1), cB + hstep + kstep, voffB);
        PG8_WAIT_V(6); PG8_BAR;
    } else {
        PG8_STAGE(PG8_SB(0, 0), cB, voffB); PG8_STAGE(PG8_SA(0, 0), cA, voffA); PG8_STAGE(PG8_SB(0, 1), cB + hstep, voffB); PG8_STAGE(PG8_SA(0, 1), cA + hstep, voffA);
        if (wr == 1) PG8_BAR;
        PG8_WAIT_V(4); PG8_BAR;
        PG8_STAGE(PG8_SB(1, 0), cB + kstep, voffB); PG8_STAGE(PG8_SA(1, 0), cA + kstep, voffA); PG8_STAGE(PG8_SB(1, 1), cB + hstep + kstep, voffB);
        PG8_WAIT_V(6); PG8_BAR;
    }
    for (;;) {
        const bool has_next = S.next(ui + 1, nxt);
        const char* nA = has_next ? (const char*)g.A + (size_t)nxt.pm * tstep : cA; const char* nB = has_next ? (const char*)g.Bt + (size_t)nxt.pn * tstep : cB;
        for (int t = 0; t < nt; t += 2) {
            const bool last = (t == nt - 2);
            const char* a1 = cA + (size_t)(t + 1) * kstep;
            const char* a2 = last ? nA : cA + (size_t)(t + 2) * kstep; const char* b2 = last ? nB : cB + (size_t)(t + 2) * kstep;
            const char* a3 = a2 + kstep; const char* b3 = b2 + kstep;
            if (last && has_next) S.a_ready(nxt);
            if constexpr (SP2) {
            PG8_LDB(B0, 0, 0); PG8_LDB(B1, 0, 1); PG8_SCHED; PG8_LDA(At, 0, 0); PG8_STAGE(PG8_SA(1, 1), a1 + hstep, voffA);
            PG8_WAIT_V(8); PG8_WAIT_L(0); PG8_BAR; PG8_MMA(0, 0, At, B0); PG8_MMA(0, 1, At, B1); PG8_BAR; PG8_SCHED;
            PG8_LDA(At, 0, 1); PG8_STAGE(PG8_SB(0, 0), b2, voffB); PG8_STAGE(PG8_SB(0, 1), b2 + hstep, voffB); PG8_STAGE(PG8_SA(0, 0), a2, voffA);
            PG8_WAIT_V(8); PG8_WAIT_L(0); PG8_BAR; PG8_MMA(1, 0, At, B0); PG8_MMA(1, 1, At, B1); PG8_BAR; PG8_SCHED;
            PG8_LDB(B0, 1, 0); PG8_LDB(B1, 1, 1); PG8_SCHED; PG8_LDA(At, 1, 0); PG8_STAGE(PG8_SA(0, 1), a2 + hstep, voffA);
            PG8_WAIT_V(8); PG8_WAIT_L(0); PG8_BAR; PG8_MMA(0, 0, At, B0); PG8_MMA(0, 1, At, B1); PG8_BAR; PG8_SCHED;
            PG8_LDA(At, 1, 1); PG8_STAGE(PG8_SB(1, 0), b3, voffB); PG8_STAGE(PG8_SB(1, 1), b3 + hstep, voffB); PG8_STAGE(PG8_SA(1, 0), a3, voffA);
            PG8_WAIT_V(8); PG8_WAIT_L(0); PG8_BAR; PG8_MMA(1, 0, At, B0); PG8_MMA(1, 1, At, B1); PG8_BAR; PG8_SCHED;
            } else {
            PG8_LDB(B0, 0, 0); PG8_SCHED; PG8_LDA(At, 0, 0); PG8_STAGE(PG8_SA(1, 1), a1 + hstep, voffA);
            PG8_WAIT_L(8); PG8_BAR; PG8_WAIT_L(0); PG8_MMA(0, 0, At, B0); PG8_BAR; PG8_SCHED;
            PG8_LDB(B1, 0, 1); PG8_STAGE(PG8_SB(0, 0), b2, voffB);
            PG8_BAR; PG8_WAIT_L(0); PG8_MMA(0, 1, At, B1); PG8_BAR;
            PG8_LDA(At, 0, 1); PG8_STAGE(PG8_SA(0, 0), a2, voffA);
            PG8_BAR; PG8_WAIT_L(0); PG8_MMA(1, 0, At, B0); PG8_BAR; PG8_SCHED;
            PG8_STAGE(PG8_SB(0, 1), b2 + hstep, voffB);
            PG8_WAIT_V(6); PG8_BAR; PG8_MMA(1, 1, At, B1); PG8_BAR;
            PG8_LDB(B0, 1, 0); PG8_SCHED; PG8_LDA(At, 1, 0); PG8_STAGE(PG8_SA(0, 1), a2 + hstep, voffA);
            PG8_WAIT_L(8); PG8_BAR; PG8_WAIT_L(0); PG8_MMA(0, 0, At, B0); PG8_BAR; PG8_SCHED;
            PG8_LDB(B1, 1, 1); PG8_STAGE(PG8_SB(1, 0), b3, voffB);
            PG8_BAR; PG8_WAIT_L(0); PG8_MMA(0, 1, At, B1); PG8_BAR;
            PG8_LDA(At, 1, 1); PG8_STAGE(PG8_SA(1, 0), a3, voffA);
            PG8_BAR; PG8_WAIT_L(0); PG8_MMA(1, 0, At, B0); PG8_BAR; PG8_SCHED;
            PG8_STAGE(PG8_SB(1, 1), b3 + hstep, voffB);
            PG8_WAIT_V(6); PG8_BAR; PG8_MMA(1, 1, At, B1); PG8_BAR;
            }
        }
        if constexpr (ALIGN_EPI) { if (wr == 0) PG8_BAR; }
        if constexpr (!Epi::AFTER_DRAIN) { E(acc, cur, wr, wc, fr, fq); S.done(cur); }
        if (!has_next) break;
#pragma unroll
        for (int a = 0; a < 2; ++a)
#pragma unroll
            for (int b = 0; b < 2; ++b)
#pragma unroll
                for (int m = 0; m < 4; ++m)
#pragma unroll
                    for (int n = 0; n < 2; ++n) acc[a][b][m][n] = (f32x4){0.f, 0.f, 0.f, 0.f};
        cur = nxt; cA = nA; cB = nB; ++ui;
        if constexpr (ALIGN_EPI) { if (wr == 1) PG8_BAR; }
    }
    PG8_WAIT_V(0);
    if constexpr (!ALIGN_EPI) { if (wr == 0) PG8_BAR; }
    PG8_BAR;
    if constexpr (Epi::AFTER_DRAIN) { E.fused(acc, cur, wr, wc, fr, fq, lds, wid, lane); S.done(cur); }
#undef PG8_SA
#undef PG8_SB
#undef PG8_STAGE
#undef PG8_LDA
#undef PG8_LDB
#undef PG8_MMA
#undef PG8_WAIT_V
#undef PG8_WAIT_L
#undef PG8_BAR
#undef PG8_SCHED
}
}
namespace pg8 {
__device__ __forceinline__ u32x4 pack8(const f32x4& v0, const f32x4& v1) { u32x4 w; w.x = cvt_pk_bf16(v0[0], v0[1]); w.y = cvt_pk_bf16(v0[2], v0[3]); w.z = cvt_pk_bf16(v1[0], v1[1]); w.w = cvt_pk_bf16(v1[2], v1[3]); return w; }
__device__ __forceinline__ float sigm(float x) { return __builtin_amdgcn_rcpf(1.0f + __expf(-x)); }
__device__ __forceinline__ f32x4 sigm4(const f32x4& v) { return (f32x4){sigm(v[0]), sigm(v[1]), sigm(v[2]), sigm(v[3])}; }
__device__ __forceinline__ float gelu_t(float x) { const float u = 1.5957691216057308f * (x + 0.044715f * x * x * x); return x * sigm(u); }
__device__ __forceinline__ f32x4 gelu4(const f32x4& v) { return (f32x4){gelu_t(v[0]), gelu_t(v[1]), gelu_t(v[2]), gelu_t(v[3])}; }

struct EpiIn {
    static constexpr bool PERM = true, AFTER_DRAIN = false;
    unsigned char* P; const float* bias;
    __device__ __forceinline__ void operator()(const f32x4 (&acc)[2][2][4][2], const Unit& u, int wr, int wc, int fr, int fq) const {
        const int pn = u.pn, row0 = u.pm * BM + wr * 64 + fr, cl = wc * 32 + 8 * fq;
        f32x4 bv[2][2];
#pragma unroll
        for (int bj = 0; bj < 2; ++bj)
#pragma unroll
            for (int n = 0; n < 2; ++n) bv[bj][n] = *(const f32x4*)(bias + pn * BM + bj * HALF + cl + 4 * n);
        if (pn < 10) {
            bf16_t* base = (bf16_t*)(P + (size_t)(pn >> 1) * (36u << 20));
            const float sc = (pn >= 2 && pn < 4) ? 0.08838834764831845f : 1.0f;
            const int act = pn < 6 ? 0 : pn < 8 ? 1 : 2;
            const int dcol = (pn & 1) * BM + cl;
#pragma unroll
            for (int ai = 0; ai < 2; ++ai)
#pragma unroll
                for (int m = 0; m < 4; ++m) { bf16_t* rowp = base + (size_t)(row0 + ai * HALF + m * 16) * 512 + dcol;
#pragma unroll
                    for (int bj = 0; bj < 2; ++bj) { f32x4 v0 = acc[ai][bj][m][0] + bv[bj][0], v1 = acc[ai][bj][m][1] + bv[bj][1];
                        if (act == 1) { v0 = sigm4(v0); v1 = sigm4(v1); } else if (act == 2) { v0 = gelu4(v0); v1 = gelu4(v1); } else { v0 = v0 * sc; v1 = v1 * sc; }
                        *(u32x4*)(rowp + bj * HALF) = pack8(v0, v1); } }
        } else if (pn < 12) {
            const int dcol = (pn - 10) * HALF + cl;
#pragma unroll
            for (int ai = 0; ai < 2; ++ai)
#pragma unroll
                for (int m = 0; m < 4; ++m) { bf16_t* rowp = (bf16_t*)(P + (size_t)5 * (36u << 20)) + (size_t)(row0 + ai * HALF + m * 16) * 256 + dcol;
                    const f32x4 a0 = acc[ai][0][m][0] + bv[0][0], a1 = acc[ai][0][m][1] + bv[0][1];
                    const f32x4 g0 = sigm4(acc[ai][1][m][0] + bv[1][0]), g1 = sigm4(acc[ai][1][m][1] + bv[1][1]);
                    *(u32x4*)rowp = pack8(a0 * g0, a1 * g1); }
        } else {
            if (wc == 0 && fq < 2) {
#pragma unroll
                for (int ai = 0; ai < 2; ++ai)
#pragma unroll
                    for (int m = 0; m < 4; ++m) { float* rowp = (float*)(P + (size_t)5 * (36u << 20) + (18u << 20)) + (size_t)(row0 + ai * HALF + m * 16) * 16 + 8 * fq;
                        *(f32x4*)rowp = acc[ai][0][m][0] + bv[0][0]; *(f32x4*)(rowp + 4) = acc[ai][0][m][1] + bv[0][1]; }
            }
        }
    }
};

struct EpiGU {
    static constexpr bool PERM = true, AFTER_DRAIN = false;
    bf16_t* H;
    __device__ __forceinline__ void operator()(const f32x4 (&acc)[2][2][4][2], const Unit& u, int wr, int wc, int fr, int fq) const {
        const int row0 = u.pm * BM + wr * 64 + fr, dcol = u.pn * HALF + wc * 32 + 8 * fq;
#pragma unroll
        for (int ai = 0; ai < 2; ++ai)
#pragma unroll
            for (int m = 0; m < 4; ++m) { bf16_t* rowp = H + (size_t)(row0 + ai * HALF + m * 16) * 2816 + dcol;
                const f32x4 g0 = acc[ai][0][m][0], g1 = acc[ai][0][m][1];
                *(u32x4*)rowp = pack8(g0 * sigm4(g0) * acc[ai][1][m][0], g1 * sigm4(g1) * acc[ai][1][m][1]); }
    }
};

struct EpiRes {
    static constexpr bool PERM = false, AFTER_DRAIN = false;
    const float* baseL; float* outL; const float* baseC; float* outC; const float* gate; int nlat;
    __device__ __forceinline__ void operator()(const f32x4 (&acc)[2][2][4][2], const Unit& u, int wr, int wc, int fr, int fq) const {
        const int trow = u.pm * BM; const bool lat = trow < nlat;
        const float* base = lat ? baseL + (size_t)trow * 1024 : baseC + (size_t)(trow - nlat) * 1024;
        float* out = lat ? outL + (size_t)trow * 1024 : outC + (size_t)(trow - nlat) * 1024;
        const float* gv = gate + (size_t)(lat ? (trow >> 11) : 16) * 6144;
        const int r0 = wr * 64 + fr, col0 = u.pn * BM + wc * 32 + 4 * fq;
        f32x4 g[2][2];
#pragma unroll
        for (int bj = 0; bj < 2; ++bj)
#pragma unroll
            for (int n = 0; n < 2; ++n) g[bj][n] = *(const f32x4*)(gv + col0 + bj * HALF + n * 16);
#pragma unroll
        for (int ai = 0; ai < 2; ++ai)
#pragma unroll
            for (int m = 0; m < 4; ++m) { const size_t off = (size_t)(r0 + ai * HALF + m * 16) * 1024 + col0;
#pragma unroll
                for (int bj = 0; bj < 2; ++bj)
#pragma unroll
                    for (int n = 0; n < 2; ++n) { const f32x4 b = *(const f32x4*)(base + off + bj * HALF + n * 16);
                        *(f32x4*)(out + off + bj * HALF + n * 16) = b + g[bj][n] * acc[ai][bj][m][n]; } }
    }
};
}
constexpr int D = 1024, NB = 16, SEQ = 2048, CTXL = 256, DEPTH = 2;
constexpr int ML = NB * SEQ, MC = NB * CTXL, MT = ML + MC;
constexpr int NIN_O = 3088, NIN = 3328, FF = 2816, NGU = 2 * FF;
constexpr int HW = 512;
constexpr int MODW = 6 * D;
constexpr float EPS = 1e-6f;
constexpr int NWAVES = 8, NTHREADS = 512;

constexpr size_t MiB = 1u << 20;
constexpr size_t WS_CTL = 0;
constexpr size_t WS_MOD = 1 * MiB;
constexpr size_t ZERO_BYTES = 2 * MiB;
constexpr size_t WS_BIN = 2 * MiB;
constexpr size_t WS_W = 3 * MiB, W_LAYER = 25 * MiB;
constexpr size_t WO_IN = 0, WO_OUT = 6 * MiB + 512 * 1024, WO_GU = WO_OUT + 2 * MiB, WO_DOWN = WO_GU + 11 * MiB;
constexpr size_t WS_XC = 53 * MiB;
constexpr size_t WS_A = 69 * MiB;
constexpr size_t WS_P = 141 * MiB;
constexpr size_t WS_Q = WS_P, WS_K = WS_Q + 36 * MiB, WS_V = WS_K + 36 * MiB, WS_OG = WS_V + 36 * MiB, WS_Z = WS_OG + 36 * MiB, WS_YC = WS_Z + 36 * MiB, WS_GT = WS_YC + 18 * MiB;
constexpr size_t WS_H = WS_P;
constexpr size_t WS_Y = 342 * MiB;
constexpr size_t WS_CT = WS_A;
constexpr size_t WS_NS = 414 * MiB, WS_MP = 416 * MiB;
constexpr size_t WS_END = 486 * MiB;
static_assert(WS_GT + (size_t)MT * 16 * 4 <= WS_Y && WS_H + (size_t)MT * FF * 2 <= WS_Y && WS_W + 2 * W_LAYER <= WS_XC && WO_DOWN + (size_t)D * FF * 2 <= W_LAYER, "ws map");

constexpr int RING_BYTES = 131072, MISC_OFF = RING_BYTES + 320, LDS_BYTES = 147456;

#define GAS __attribute__((address_space(1)))
#define LAS __attribute__((address_space(3)))
typedef unsigned short bf16;
typedef unsigned v4u __attribute__((ext_vector_type(4)));
typedef unsigned v2u __attribute__((ext_vector_type(2)));
typedef float f32x4 __attribute__((ext_vector_type(4)));
typedef float f32x2 __attribute__((ext_vector_type(2)));
#define LDS_WAIT() asm volatile("s_waitcnt lgkmcnt(0)" ::: "memory")
__device__ __forceinline__ unsigned f2bf(float f) { unsigned u = __builtin_bit_cast(unsigned, f); return (u + 0x7fffu + ((u >> 16) & 1u)) >> 16; }
__device__ __forceinline__ unsigned pk2(float lo, float hi) { return f2bf(lo) | (f2bf(hi) << 16); }
__device__ __forceinline__ float bf2f(unsigned short b) { return __builtin_bit_cast(float, (unsigned)b << 16); }
__device__ __forceinline__ float bflo(unsigned w) { return __builtin_bit_cast(float, w << 16); }
__device__ __forceinline__ float bfhi(unsigned w) { return __builtin_bit_cast(float, w & 0xffff0000u); }
__device__ __forceinline__ float fsigmoid(float x) { return __builtin_amdgcn_rcpf(1.0f + __expf(-x)); }
__device__ __forceinline__ float wave_sum(float v) {
#pragma unroll
    for (int o = 1; o < 64; o <<= 1) v += __shfl_xor(v, o);
    return v;
}
__device__ __forceinline__ int modrow_of(int row) { return row < ML ? (row >> 11) : 16; }
#define XB_TMO      128
#define XB_XCNT(j)  (256  + 64 * (j))
#define XB_XSUB(j)  (1280 + 64 * (j))
#define XB_XGEN(j)  (2304 + 64 * (j))
#define XB_TOP      3328
#define XB_TOPGEN   3392
#define XCD_BAR_WORDS 3456
#define XB_SPIN_CAP (1u << 18)

__device__ __forceinline__ unsigned xb_ld(unsigned* p)              { return __hip_atomic_load(p, __ATOMIC_RELAXED, __HIP_MEMORY_SCOPE_AGENT); }
__device__ __forceinline__ unsigned xb_add(unsigned* p, unsigned v) { return __hip_atomic_fetch_add(p, v, __ATOMIC_RELAXED, __HIP_MEMORY_SCOPE_AGENT); }
__device__ __forceinline__ unsigned xb_xcc_id() { return (unsigned)__builtin_amdgcn_s_getreg((3 << 11) | 20) & 0xFu; }
#define XB_SPIN(cond, bar) do { unsigned _sp = 0; while (cond) { __builtin_amdgcn_s_sleep(1); \
    if ((++_sp & 255u) == 0u) { if (xb_ld(&(bar)[XB_TMO])) break; if (_sp > XB_SPIN_CAP) { atomicAdd(&(bar)[XB_TMO], 1u); break; } } } } while (0)

struct XcdBarrier {
    unsigned* bar; unsigned x;
    volatile LAS unsigned* st;
};

__device__ __forceinline__ XcdBarrier xcd_barrier_post(unsigned* bar, volatile LAS unsigned* st) {
    XcdBarrier b; b.bar = bar; b.x = xb_xcc_id(); b.st = st;
    if (threadIdx.x == 0) (void)xb_add(&bar[XB_XCNT(b.x)], 1u);
    return b;
}
__device__ __forceinline__ void xcd_barrier_complete(unsigned* bar, unsigned x, unsigned& nloc, unsigned& nx) {
    const unsigned G = gridDim.x * gridDim.y * gridDim.z;
    unsigned sum, cnt, mine, sp = 0u;
    for (;;) {
        sum = 0u; cnt = 0u; mine = 0u;
#pragma unroll
        for (unsigned j = 0; j < 16; ++j) { const unsigned c = xb_ld(&bar[XB_XCNT(j)]); sum += c; cnt += (c > 0u) ? 1u : 0u; mine = (j == x) ? c : mine; }
        if (sum == G) break;
        __builtin_amdgcn_s_sleep(1);
        if ((++sp & 255u) == 0u) { if (xb_ld(&bar[XB_TMO])) break; if (sp > XB_SPIN_CAP) { atomicAdd(&bar[XB_TMO], 1u); break; } }
    }
    nloc = mine > 0u ? mine : 1u; nx = cnt > 0u ? cnt : 1u;
}

__device__ __forceinline__ void xcd_barrier(const XcdBarrier& b) {
    asm volatile("s_waitcnt vmcnt(0)" ::: "memory");
    __syncthreads();
    if (threadIdx.x == 0) {
        unsigned* bar = b.bar;
        __builtin_amdgcn_s_waitcnt(0);
        unsigned nloc = b.st[0], nx = b.st[1];
        if (nloc == 0u) { xcd_barrier_complete(bar, b.x, nloc, nx); b.st[0] = nloc; b.st[1] = nx; }
        const unsigned old = xb_add(&bar[XB_XSUB(b.x)], 1u);
        const unsigned gen = old / nloc;
        if (old + 1u == (gen + 1u) * nloc) {
            __builtin_amdgcn_fence(__ATOMIC_RELEASE, "agent");
            asm volatile("s_waitcnt vmcnt(0)" ::: "memory");
            const unsigned og = xb_add(&bar[XB_TOP], 1u);
            const unsigned tg = og / nx;
            if (og + 1u == (tg + 1u) * nx) xb_add(&bar[XB_TOPGEN], 1u);
            else XB_SPIN(xb_ld(&bar[XB_TOPGEN]) == tg, bar);
            __builtin_amdgcn_fence(__ATOMIC_ACQUIRE, "agent");
            xb_add(&bar[XB_XGEN(b.x)], 1u);
            asm volatile("s_waitcnt vmcnt(0)" ::: "memory");
        } else {
            XB_SPIN(xb_ld(&bar[XB_XGEN(b.x)]) == gen, bar);
            __builtin_amdgcn_fence(__ATOMIC_ACQUIRE, "agent");
            asm volatile("s_waitcnt vmcnt(0)" ::: "memory");
        }
    }
    __syncthreads();
}

struct Args { const float* in[23]; float* out; unsigned char* ws; int ph_lo, ph_hi; };
enum { I_X = 0, I_C, I_CTX, I_CCTX, I_WMOD, I_BMOD, I_N1G, I_WIN, I_BIN, I_MG, I_SLG, I_SLB, I_SW, I_SB, I_CW, I_CB, I_CLG, I_CLB, I_WOUT, I_N2G, I_WGU, I_WDOWN, I_FG };

__device__ __forceinline__ int win_src_col(int n) {
    if (n < 2048) return n;
    if (n < 2560) return n + 16;
    if (n < 3072) { const int j = n - 2560, tile = j >> 8, jj = j & 255; return 2576 + (jj >> 7) * 256 + tile * 128 + (jj & 127); }
    if (n < 3088) return 2048 + (n - 3072);
    return -1;
}
__device__ __forceinline__ int wgu_src_col(int n) { const int tile = n >> 8, jj = n & 255; return (jj >> 7) * FF + tile * 128 + (jj & 127); }

__device__ __forceinline__ void transpose_item(const float* W, int K, int Nsrc, bf16* WT, int n0, int srcc0, int nvalid, int k0, LAS float* scr, int lane) {
    const int c = lane & 31;
#pragma unroll 8
    for (int i = 0; i < 32; ++i) { const int kk = 2 * i + (lane >> 5);
        float v = 0.f; if (srcc0 >= 0 && c < nvalid) v = W[(size_t)(k0 + kk) * Nsrc + srcc0 + c];
        scr[kk * 33 + c] = v; }
    LDS_WAIT(); asm volatile("" ::: "memory");
    const int c8 = lane & 7;
#pragma unroll
    for (int j = 0; j < 4; ++j) { const int n = (lane >> 3) + 8 * j; const LAS float* s = scr + (8 * c8) * 33 + n;
        v4u o; o.x = pk2(s[0 * 33], s[1 * 33]); o.y = pk2(s[2 * 33], s[3 * 33]); o.z = pk2(s[4 * 33], s[5 * 33]); o.w = pk2(s[6 * 33], s[7 * 33]);
        *(v4u*)(WT + (size_t)(n0 + n) * K + k0 + 8 * c8) = o; }
    LDS_WAIT(); asm volatile("" ::: "memory");
}

__device__ __forceinline__ void phase_prologue(const Args& a, LAS unsigned char* lds, int G, int tid, int lane, int wave) {
    unsigned char* ws = a.ws;
    LAS float* scr = (LAS float*)(lds + wave * 16384);
    const int gw = blockIdx.x * NWAVES + wave, NGW = G * NWAVES;
    constexpr int I_IN = 16 * (NIN / 32), I_OUT = 16 * 32, I_GU = 16 * (NGU / 32), I_DN = (FF / 64) * 32, I_LAYER = I_IN + I_OUT + I_GU + I_DN;
    for (int it = gw; it < 2 * I_LAYER; it += NGW) {
        const int l = it / I_LAYER; int r = it % I_LAYER;
        unsigned char* wl = ws + WS_W + (size_t)l * W_LAYER;
        if (r < I_IN) { const int kb = r / (NIN / 32), nb = r % (NIN / 32), n0 = nb * 32, sc = win_src_col(n0);
            transpose_item(a.in[I_WIN] + (size_t)l * D * NIN_O, D, NIN_O, (bf16*)(wl + WO_IN), n0, sc, n0 == 3072 ? 16 : 32, kb * 64, scr, lane); continue; }
        r -= I_IN;
        if (r < I_OUT) { const int kb = r / 32, nb = r % 32;
            transpose_item(a.in[I_WOUT] + (size_t)l * D * D, D, D, (bf16*)(wl + WO_OUT), nb * 32, nb * 32, 32, kb * 64, scr, lane); continue; }
        r -= I_OUT;
        if (r < I_GU) { const int kb = r / (NGU / 32), nb = r % (NGU / 32), n0 = nb * 32;
            transpose_item(a.in[I_WGU] + (size_t)l * D * NGU, D, NGU, (bf16*)(wl + WO_GU), n0, wgu_src_col(n0), 32, kb * 64, scr, lane); continue; }
        r -= I_GU;
        { const int kb = r / 32, nb = r % 32;
            transpose_item(a.in[I_WDOWN] + (size_t)l * FF * D, FF, D, (bf16*)(wl + WO_DOWN), nb * 32, nb * 32, 32, kb * 64, scr, lane); }
    }
    for (int e = blockIdx.x * NTHREADS + tid; e < 2 * NIN; e += G * NTHREADS) { const int l = e / NIN, n = e % NIN, s = win_src_col(n);
        ((float*)(ws + WS_BIN))[e] = s >= 0 ? a.in[I_BIN][l * NIN_O + s] : 0.f; }
    __syncthreads();
    LAS float* sl = (LAS float*)lds;
    float* MOD = (float*)(ws + WS_MOD);
    for (int it = blockIdx.x; it < 2 * 12 * 16; it += G) {
        const int l = it / 192, jb = (it % 192) / 16, ks = it % 16;
        for (int e = tid; e < 17 * 64; e += NTHREADS) { const int r = e >> 6, k = e & 63; const float cv = r < 16 ? a.in[I_C][r * D + ks * 64 + k] : a.in[I_CCTX][ks * 64 + k]; sl[e] = cv * fsigmoid(cv); }
        __syncthreads();
        const int j = jb * 512 + tid;
        float acc[17];
#pragma unroll
        for (int r = 0; r < 17; ++r) acc[r] = 0.f;
        const float* wp = a.in[I_WMOD] + (size_t)l * D * MODW + (size_t)(ks * 64) * MODW + j;
#pragma unroll 4
        for (int k = 0; k < 64; ++k) { const float w = wp[(size_t)k * MODW];
#pragma unroll
            for (int r = 0; r < 17; ++r) acc[r] += sl[r * 64 + k] * w; }
        const float bm = ks == 0 ? a.in[I_BMOD][l * MODW + j] : 0.f;
#pragma unroll
        for (int r = 0; r < 17; ++r) atomicAdd(MOD + (size_t)(l * 17 + r) * MODW + j, acc[r] + bm);
        __syncthreads();
    }
}

__device__ __forceinline__ void phase_norm(const float* xl, const float* xc, bf16* A, const float* g, const float* mod, int sh_off, int nrows, int G, int lane, int wave) {
    const int gw = blockIdx.x * NWAVES + wave, NGW = G * NWAVES;
    for (int r = gw; r < nrows; r += NGW) {
        const float* xr = r < ML ? xl + (size_t)r * D : xc + (size_t)(r - ML) * D;
        const float* mr = mod + (size_t)modrow_of(r) * MODW + sh_off;
        f32x4 v[4]; float s = 0.f;
#pragma unroll
        for (int j = 0; j < 4; ++j) { v[j] = ((const f32x4*)xr)[lane + 64 * j]; s += (v[j].x * v[j].x + v[j].y * v[j].y) + (v[j].z * v[j].z + v[j].w * v[j].w); }
        const float rstd = 1.0f / sqrtf(wave_sum(s) * (1.0f / D) + EPS);
        unsigned long long* o8 = (unsigned long long*)(A + (size_t)r * D) + lane;
#pragma unroll
        for (int j = 0; j < 4; ++j) { const int c = (lane + 64 * j) * 4;
            const f32x4 gg = *(const f32x4*)(g + c), sh = *(const f32x4*)(mr + c), sc = *(const f32x4*)(mr + D + c);
            const f32x4 y = v[j] * rstd * gg * (1.0f + sc) + sh;
            o8[64 * j] = (unsigned long long)pk2(y.x, y.y) | ((unsigned long long)pk2(y.z, y.w) << 32); }
    }
}

__device__ __forceinline__ void phase_final(float* x, const float* g, int G, int lane, int wave) {
    const int gw = blockIdx.x * NWAVES + wave, NGW = G * NWAVES;
    for (int r = gw; r < ML; r += NGW) {
        float* xr = x + (size_t)r * D;
        f32x4 v[4]; float s = 0.f;
#pragma unroll
        for (int j = 0; j < 4; ++j) { v[j] = ((const f32x4*)xr)[lane + 64 * j]; s += (v[j].x * v[j].x + v[j].y * v[j].y) + (v[j].z * v[j].z + v[j].w * v[j].w); }
        const float rstd = 1.0f / sqrtf(wave_sum(s) * (1.0f / D) + EPS);
#pragma unroll
        for (int j = 0; j < 4; ++j) { const f32x4 gg = ((const f32x4*)g)[lane + 64 * j]; ((f32x4*)xr)[lane + 64 * j] = v[j] * rstd * gg; }
    }
}

constexpr int TB = 16;
__device__ __forceinline__ void mlstm_scan_item(const bf16* Q, const bf16* K, const bf16* V, const float* GT, float* HS0, float* HS1, int item, bool ctx_out, LAS unsigned char* lds, int tid) {
    const int b = item >> 3, h = (item >> 1) & 3, dir = item & 1;
    const int dv = tid & 127, kq = tid >> 7;
    LAS float* kbuf = (LAS float*)lds;
    LAS float* vbuf = kbuf + TB * 128;
    LAS float* qbuf = vbuf + TB * 128;
    LAS float* ibuf = qbuf + TB * 128;
    LAS float* fbuf = ibuf + TB;
    LAS float* red = fbuf + TB;
    LAS float* redd = red + 2 * 4 * 128;
    float* HS = dir ? HS1 : HS0;
    float C[32], nn[32];
#pragma unroll
    for (int j = 0; j < 32; ++j) { C[j] = 0.f; nn[j] = 0.f; }
    float m = 0.f; int par = 0;
    for (int s0 = 0; s0 < CTXL + SEQ; s0 += TB) {
        const bool isctx = s0 < CTXL; const int len = isctx ? CTXL : SEQ, i0 = isctx ? s0 : s0 - CTXL;
        const int rbase = isctx ? ML + b * CTXL : b * SEQ;
        for (int e = tid; e < TB * 384; e += NTHREADS) { const int tok = e / 384, c = e % 384, which = c >> 7, d = c & 127;
            const int t = dir ? (len - 1 - (i0 + tok)) : (i0 + tok); const size_t off = (size_t)(rbase + t) * HW + h * 128 + d;
            const bf16* src = which == 0 ? K : which == 1 ? V : Q;
            (which == 0 ? kbuf : which == 1 ? vbuf : qbuf)[tok * 128 + d] = bf2f(src[off]); }
        if (tid < TB) { const int t = dir ? (len - 1 - (i0 + tid)) : (i0 + tid); const float* gp = GT + (size_t)(rbase + t) * 16 + dir * 8 + h;
            const float iv = gp[0], fv = gp[4];
            ibuf[tid] = iv; fbuf[tid] = fminf(fv, 0.f) - log1pf(__expf(-fabsf(fv))); }
        __syncthreads();
        const bool wr_out = !isctx || ctx_out;
        for (int tok = 0; tok < TB; ++tok) {
            const float it = ibuf[tok], lf = fbuf[tok];
            const float mn = fmaxf(lf + m, it), aa = __expf(lf + m - mn), bc = __expf(it - mn); m = mn;
            const float vv = vbuf[tok * 128 + dv] * bc;
            float part = 0.f, dpart = 0.f;
            const LAS float* kp = kbuf + tok * 128 + kq * 32; const LAS float* qp = qbuf + tok * 128 + kq * 32;
#pragma unroll
            for (int j = 0; j < 32; ++j) { const float kk = kp[j], qq = qp[j];
                C[j] = aa * C[j] + kk * vv; part += C[j] * qq;
                nn[j] = aa * nn[j] + bc * kk; dpart += nn[j] * qq; }
            red[(par * 4 + kq) * 128 + dv] = part; if (dv == 0) redd[par * 4 + kq] = dpart;
            __syncthreads();
            if (tid < 128 && wr_out) {
                const float num = (red[(par * 4 + 0) * 128 + tid] + red[(par * 4 + 1) * 128 + tid]) + (red[(par * 4 + 2) * 128 + tid] + red[(par * 4 + 3) * 128 + tid]);
                const float den = (redd[par * 4 + 0] + redd[par * 4 + 1]) + (redd[par * 4 + 2] + redd[par * 4 + 3]);
                const int t = dir ? (len - 1 - (i0 + tok)) : (i0 + tok);
                HS[(size_t)(rbase + t) * HW + h * 128 + tid] = num / fmaxf(fabsf(den), __expf(-m));
            }
            par ^= 1;
        }
    }
    __syncthreads();
}

__device__ __forceinline__ void phase_mlstm_post(const float* HS0, const float* HS1, const bf16* OG, const float* mg, bf16* Y, int nrows, int G, int lane, int wave) {
    const int gw = blockIdx.x * NWAVES + wave, NGW = G * NWAVES;
    for (int r = gw; r < nrows; r += NGW) {
        const size_t off = (size_t)r * HW + lane * 8;
        const f32x4 a0 = *(const f32x4*)(HS0 + off), a1 = *(const f32x4*)(HS0 + off + 4), b0 = *(const f32x4*)(HS1 + off), b1 = *(const f32x4*)(HS1 + off + 4);
        const f32x4 h0 = a0 + b0, h1 = a1 + b1;
        float s = (h0.x * h0.x + h0.y * h0.y) + (h0.z * h0.z + h0.w * h0.w) + (h1.x * h1.x + h1.y * h1.y) + (h1.z * h1.z + h1.w * h1.w);
        s += __shfl_xor(s, 1); s += __shfl_xor(s, 2); s += __shfl_xor(s, 4); s += __shfl_xor(s, 8);
        const float rs = 1.0f / sqrtf(s * (1.0f / 128.0f) + EPS);
        const v4u og = *(const v4u*)(OG + off);
        const f32x4 g0 = *(const f32x4*)(mg + lane * 8), g1 = *(const f32x4*)(mg + lane * 8 + 4);
        v4u o;
        o.x = pk2(h0.x * rs * g0.x * bflo(og.x), h0.y * rs * g0.y * bfhi(og.x)); o.y = pk2(h0.z * rs * g0.z * bflo(og.y), h0.w * rs * g0.w * bfhi(og.y));
        o.z = pk2(h1.x * rs * g1.x * bflo(og.z), h1.y * rs * g1.y * bfhi(og.z)); o.w = pk2(h1.z * rs * g1.z * bflo(og.w), h1.w * rs * g1.w * bfhi(og.w));
        *(v4u*)(Y + (size_t)r * D + lane * 8) = o;
    }
}

__device__ __forceinline__ void sgu_item(const bf16* Z, const float* lg, const float* lb, const float* sw, const float* sb, bf16* Y, int chunk, LAS unsigned char* lds, int tid, int lane, int wave) {
    LAS float* vn = (LAS float*)lds;
    const int row0 = chunk * 128;
    for (int t = wave; t < 128; t += NWAVES) {
        const v2u raw = *(const v2u*)(Z + (size_t)(row0 + t) * 512 + 256 + lane * 4);
        const float x0 = bflo(raw.x), x1 = bfhi(raw.x), x2 = bflo(raw.y), x3 = bfhi(raw.y);
        const float mu = wave_sum((x0 + x1) + (x2 + x3)) * (1.0f / 256.0f);
        const float d0 = x0 - mu, d1 = x1 - mu, d2 = x2 - mu, d3 = x3 - mu;
        const float var = wave_sum((d0 * d0 + d1 * d1) + (d2 * d2 + d3 * d3)) * (1.0f / 256.0f);
        const float rs = 1.0f / sqrtf(var + EPS);
        const f32x4 g = *(const f32x4*)(lg + lane * 4), bb = *(const f32x4*)(lb + lane * 4);
        *(LAS f32x4*)(vn + t * 256 + lane * 4) = (f32x4){d0 * rs * g.x + bb.x, d1 * rs * g.y + bb.y, d2 * rs * g.z + bb.z, d3 * rs * g.w + bb.w};
    }
    __syncthreads();
    const int ch = tid & 255, ph = tid >> 8, g = __builtin_amdgcn_readfirstlane(ch >> 6);
    const float* wg = sw + (size_t)g * 128 * 128; const float* bg = sb + g * 128;
    for (int p = ph * 64; p < ph * 64 + 64; ++p) {
        const float* wr = wg + p * 128; float acc = 0.f;
#pragma unroll 8
        for (int q = 0; q < 128; ++q) acc += wr[q] * vn[q * 256 + ch];
        const float u = bf2f(Z[(size_t)(row0 + p) * 512 + ch]);
        Y[(size_t)(row0 + p) * D + 512 + ch] = (bf16)f2bf(u * (acc + bg[p]));
    }
    __syncthreads();
}

__device__ __forceinline__ void conv_rows(const bf16* YC, const float* cw, const float* cb, const float* lg, const float* lb, bf16* Y, int row0, int nrows, int lane, int wave) {
    const int c0 = lane * 4;
    for (int rr = wave; rr < nrows; rr += NWAVES) {
        const int r = row0 + rr;
        f32x4 acc = *(const f32x4*)(cb + c0);
        int base, pos, len, stride;
        if (r < ML) { const int b = r >> 11, t = r & 2047;
            if (lane < 32) { base = (b << 11) + (t & ~63); pos = t & 63; len = 64; stride = 1; }
            else           { base = (b << 11) + (t & 63); pos = t >> 6; len = 32; stride = 64; } }
        else { const int rc = r - ML; base = ML + (rc & ~255); pos = rc & 255; len = 256; stride = 1; }
#pragma unroll 1
        for (int k = 0; k < 31; ++k) { const int p = pos + k - 15;
            if (p >= 0 && p < len) { const v2u raw = *(const v2u*)(YC + (size_t)(base + p * stride) * 256 + c0); const f32x4 w = *(const f32x4*)(cw + k * 256 + c0);
                acc.x += w.x * bflo(raw.x); acc.y += w.y * bfhi(raw.x); acc.z += w.z * bflo(raw.y); acc.w += w.w * bfhi(raw.y); } }
        const float mu = wave_sum((acc.x + acc.y) + (acc.z + acc.w)) * (1.0f / 256.0f);
        const float d0 = acc.x - mu, d1 = acc.y - mu, d2 = acc.z - mu, d3 = acc.w - mu;
        const float var = wave_sum((d0 * d0 + d1 * d1) + (d2 * d2 + d3 * d3)) * (1.0f / 256.0f);
        const float rs = 1.0f / sqrtf(var + EPS);
        const f32x4 g = *(const f32x4*)(lg + c0), bb = *(const f32x4*)(lb + c0);
        float y0 = d0 * rs * g.x + bb.x, y1 = d1 * rs * g.y + bb.y, y2 = d2 * rs * g.z + bb.z, y3 = d3 * rs * g.w + bb.w;
        y0 *= fsigmoid(y0); y1 *= fsigmoid(y1); y2 *= fsigmoid(y2); y3 *= fsigmoid(y3);
        v2u o; o.x = pk2(y0, y1); o.y = pk2(y2, y3);
        *(v2u*)(Y + (size_t)r * D + 768 + c0) = o;
    }
}
typedef short bf16x8_t __attribute__((ext_vector_type(8)));
typedef short s16x4_t __attribute__((ext_vector_type(4)));
typedef short v4i16_t __attribute__((ext_vector_type(4)));
typedef float f32x16 __attribute__((ext_vector_type(16)));
typedef __bf16 bf16x2_t __attribute__((ext_vector_type(2)));
__device__ __forceinline__ unsigned cvtpk(float lo, float hi) { f32x2 v = {lo, hi}; bf16x2_t b = __builtin_convertvector(v, bf16x2_t); return __builtin_bit_cast(unsigned, b); }
__device__ __forceinline__ s16x4_t tr16(const LAS unsigned char* p) { return __builtin_bit_cast(s16x4_t, __builtin_amdgcn_ds_read_tr16_b64_v4i16((LAS v4i16_t*)p)); }
__device__ __forceinline__ bf16x8_t cat8(s16x4_t lo, s16x4_t hi) { return __builtin_shufflevector(lo, hi, 0, 1, 2, 3, 4, 5, 6, 7); }
#define MFMA32(a, b, c) __builtin_amdgcn_mfma_f32_32x32x16_bf16((a), (b), (c), 0, 0, 0)
__device__ __forceinline__ int crow(int reg, int hh) { return (reg & 3) + 8 * (reg >> 2) + 4 * hh; }
__device__ __forceinline__ int chunk_row0(int b, int a) { return a < 2 ? ML + b * CTXL + a * 128 : b * SEQ + (a - 2) * 128; }
__device__ __forceinline__ int chunk_of_step(int j, int dir) { return dir == 0 ? j : (j == 0 ? 1 : (j == 1 ? 0 : 19 - j)); }
__device__ __forceinline__ float log_sigmoid(float x) { return fminf(x, 0.f) - log1pf(__expf(-fabsf(x))); }
__device__ __forceinline__ float lane_get(float x, int src_lane) { return __builtin_bit_cast(float, __builtin_amdgcn_ds_bpermute(src_lane << 2, __builtin_bit_cast(int, x))); }
__device__ __forceinline__ float wave_incl_add(float x, int lane) {
#pragma unroll
    for (int o = 1; o < 64; o <<= 1) { const float y = lane_get(x, lane - o); if (lane >= o) x += y; }
    return x;
}
__device__ __forceinline__ float wave_incl_max(float x, int lane) {
#pragma unroll
    for (int o = 1; o < 64; o <<= 1) { const float y = lane_get(x, lane - o); if (lane >= o) x = fmaxf(x, y); }
    return x;
}
__device__ __forceinline__ float wave_max(float v, int lane) {
#pragma unroll
    for (int o = 1; o < 64; o <<= 1) v = fmaxf(v, lane_get(v, lane ^ o));
    return v;
}
__device__ __forceinline__ v4u scale8(const v4u& w, float s) {
    v4u o; o.x = cvtpk(bflo(w.x) * s, bfhi(w.x) * s); o.y = cvtpk(bflo(w.y) * s, bfhi(w.y) * s); o.z = cvtpk(bflo(w.z) * s, bfhi(w.z) * s); o.w = cvtpk(bflo(w.w) * s, bfhi(w.w) * s); return o;
}
constexpr int MX_OFF = RING_BYTES + 1024;

__device__ __forceinline__ void mlstm_state_item(const bf16* K, const bf16* V, const float* GT, bf16* CT, float* NS, float* MP, int item, bool store_ctx, LAS unsigned char* lds, int tid) {
    asm volatile("" : "+v"(tid));
    const int lane = tid & 63, wave = __builtin_amdgcn_readfirstlane(tid >> 6);
    const int dvh = item & 1, dir = (item >> 1) & 1, h = (item >> 2) & 3, b = item >> 4;
    const int seq = (b * 4 + h) * 2 + dir;
    LAS unsigned char* Kimg = lds;
    LAS unsigned char* Vimg = lds + 65536;
    LAS float* kap = (LAS float*)(lds + 98304);
    LAS float* gb = kap + 2304;
    LAS float* ib = gb + 2304;
    LAS float* cs = ib + 2304;
    for (int e = tid; e < 2304; e += NTHREADS) { const int j = e >> 7, tau = e & 127, a = chunk_of_step(j, dir), t = dir ? 127 - tau : tau;
        const float* gp = GT + (size_t)(chunk_row0(b, a) + t) * 16 + dir * 8 + h; ib[e] = gp[0]; gb[e] = log_sigmoid(gp[4]); }
    __syncthreads();
    for (int j = wave; j < 18; j += NWAVES) {
        const float x0 = gb[j * 128 + 2 * lane], x1 = gb[j * 128 + 2 * lane + 1];
        const float sc = wave_incl_add(x0 + x1, lane);
        const float g0 = ib[j * 128 + 2 * lane] - (sc - x1), g1 = ib[j * 128 + 2 * lane + 1] - sc;
        gb[j * 128 + 2 * lane] = g0; gb[j * 128 + 2 * lane + 1] = g1;
        const float pm = wave_max(fmaxf(g0, g1), lane); const float bl = lane_get(sc, 63);
        if (lane == 0) { cs[j] = bl; cs[32 + j] = pm; }
    }
    __syncthreads();
    if (tid < 18) { float m = 0.f, mp = 0.f, Ml = 0.f;
        for (int j = 0; j <= tid; ++j) { mp = m; Ml = fmaxf(m, cs[32 + j]); m = cs[j] + Ml; }
        cs[64 + tid] = __expf(mp - Ml); cs[96 + tid] = Ml;
        if (dvh == 0) MP[seq * 18 + chunk_of_step(tid, dir)] = mp; }
    __syncthreads();
    for (int e = tid; e < 2304; e += NTHREADS) kap[e] = __expf(gb[e] - cs[96 + (e >> 7)]);
    __syncthreads();

    const int r = lane & 31, hh = lane >> 5, i16 = lane & 15, q = i16 >> 2, p = i16 & 3, blk = (lane >> 4) & 1;
    const int dkt = wave & 3, dvt = wave >> 2;
    f32x16 acc;
#pragma unroll
    for (int i = 0; i < 16; ++i) acc[i] = 0.f;
    float nn = 0.f;
    v4u kreg[4], vreg[2];
    { const int row0 = chunk_row0(b, chunk_of_step(0, dir));
#pragma unroll
        for (int i = 0; i < 4; ++i) { const int pc = tid + NTHREADS * i; kreg[i] = *(const v4u*)(K + (size_t)(row0 + (pc >> 4)) * HW + h * 128 + (pc & 15) * 8); }
#pragma unroll
        for (int i = 0; i < 2; ++i) { const int pc = tid + NTHREADS * i; vreg[i] = *(const v4u*)(V + (size_t)(row0 + (pc >> 3)) * HW + h * 128 + dvh * 64 + (pc & 7) * 8); }
#pragma unroll
        for (int i = 0; i < 4; ++i) { const int pc = tid + NTHREADS * i; *(LAS v4u*)(Kimg + pc * 16) = kreg[i]; }
#pragma unroll
        for (int i = 0; i < 2; ++i) { const int pc = tid + NTHREADS * i, s = pc >> 3; *(LAS v4u*)(Vimg + pc * 16) = scale8(vreg[i], kap[dir ? 127 - s : s]); }
    }
#pragma unroll 1
    for (int j = 0; j < 18; ++j) {
        __syncthreads();
        const int a = chunk_of_step(j, dir);
        if (j + 1 < 18) { const int row0 = chunk_row0(b, chunk_of_step(j + 1, dir));
#pragma unroll
            for (int i = 0; i < 4; ++i) { const int pc = tid + NTHREADS * i; kreg[i] = *(const v4u*)(K + (size_t)(row0 + (pc >> 4)) * HW + h * 128 + (pc & 15) * 8); }
#pragma unroll
            for (int i = 0; i < 2; ++i) { const int pc = tid + NTHREADS * i; vreg[i] = *(const v4u*)(V + (size_t)(row0 + (pc >> 3)) * HW + h * 128 + dvh * 64 + (pc & 7) * 8); } }
        if (a >= 2 || store_ctx) {
            bf16* cp = CT + ((size_t)(seq * 18 + a) * 128 + dvh * 64 + dvt * 32 + r) * 128 + dkt * 32 + 4 * hh;
#pragma unroll
            for (int g = 0; g < 4; ++g) { v2u o; o.x = cvtpk(acc[4 * g], acc[4 * g + 1]); o.y = cvtpk(acc[4 * g + 2], acc[4 * g + 3]); *(v2u*)(cp + 8 * g) = o; }
            if (dvh == 0 && tid < 128) NS[(size_t)(seq * 18 + a) * 128 + tid] = nn;
        }
        const float delta = cs[64 + j];
#pragma unroll
        for (int i = 0; i < 16; ++i) acc[i] *= delta;
        const LAS unsigned char* Kb = Kimg + (j & 1) * 32768; const LAS unsigned char* Vb = Vimg + (j & 1) * 16384;
#pragma unroll
        for (int ks = 0; ks < 8; ++ks) {
            const LAS unsigned char* ka = Kb + (16 * ks + 8 * hh + q) * 256 + 2 * (32 * dkt + 16 * blk + 4 * p);
            const LAS unsigned char* va = Vb + (16 * ks + 8 * hh + q) * 128 + 2 * (32 * dvt + 16 * blk + 4 * p);
            const bf16x8_t A = cat8(tr16(ka), tr16(ka + 4 * 256)), B = cat8(tr16(va), tr16(va + 4 * 128));
            acc = MFMA32(A, B, acc);
        }
        if (dvh == 0 && tid < 128) { float s = 0.f;
#pragma unroll 8
            for (int t = 0; t < 128; ++t) s += kap[j * 128 + (dir ? 127 - t : t)] * bf2f(*(const LAS unsigned short*)(Kb + t * 256 + tid * 2));
            nn = delta * nn + s; }
        if (j + 1 < 18) { LAS unsigned char* Kn = Kimg + ((j + 1) & 1) * 32768; LAS unsigned char* Vn = Vimg + ((j + 1) & 1) * 16384;
#pragma unroll
            for (int i = 0; i < 4; ++i) { const int pc = tid + NTHREADS * i; *(LAS v4u*)(Kn + pc * 16) = kreg[i]; }
#pragma unroll
            for (int i = 0; i < 2; ++i) { const int pc = tid + NTHREADS * i, s = pc >> 3; *(LAS v4u*)(Vn + pc * 16) = scale8(vreg[i], kap[(j + 1) * 128 + (dir ? 127 - s : s)]); } }
    }
    __syncthreads();
}

template <int TB>
__device__ __forceinline__ void mlstm_weights(const f32x16 (&S)[4], bf16x8_t (&pb)[4][2], const LAS float* GA, int t, int hh, int lane, float qnf, float qnb, float& sff, float& sfb) {
    const float Mf = GA[128 + t], Mb = GA[512 + 128 + t];
    float rsf = 0.f, rsb = 0.f;
#pragma unroll
    for (int st = 0; st < 4; ++st) {
#pragma unroll
        for (int g = 0; g < 4; ++g) {
            const int s0 = 32 * st + 8 * g + 4 * hh;
            if (st < TB) { const f32x4 gv = *(const LAS f32x4*)(GA + s0);
#pragma unroll
                for (int e = 0; e < 4; ++e) rsf += S[st][4 * g + e] * __expf(gv[e] - Mf);
            } else if (st > TB) { const f32x4 gv = *(const LAS f32x4*)(GA + 512 + s0);
#pragma unroll
                for (int e = 0; e < 4; ++e) rsb += S[st][4 * g + e] * __expf(gv[e] - Mb);
            } else { const f32x4 gf = *(const LAS f32x4*)(GA + s0), gbv = *(const LAS f32x4*)(GA + 512 + s0);
#pragma unroll
                for (int e = 0; e < 4; ++e) { const float dts = (float)(t - (s0 + e));
                    const float wf = __expf(gf[e] - Mf + fminf(dts, 0.f) * 1e30f), wb = __expf(gbv[e] - Mb - fmaxf(dts, 0.f) * 1e30f);
                    rsf += S[st][4 * g + e] * wf; rsb += S[st][4 * g + e] * wb; }
            }
        }
        __builtin_amdgcn_sched_barrier(0);
    }
    rsf += lane_get(rsf, lane ^ 32); rsb += lane_get(rsb, lane ^ 32);
    const float alf = GA[256 + t], alb = GA[512 + 256 + t];
    const float invf = 1.0f / fmaxf(fabsf(alf * qnf + rsf), GA[384 + t]), invb = 1.0f / fmaxf(fabsf(alb * qnb + rsb), GA[512 + 384 + t]);
    sff = alf * invf; sfb = alb * invb;
    __builtin_amdgcn_sched_barrier(0);
    float Mf2 = Mf, Mb2 = Mb; asm volatile("" : "+v"(Mf2), "+v"(Mb2));
#pragma unroll
    for (int st = 0; st < 4; ++st) {
        float pv[16];
#pragma unroll
        for (int g = 0; g < 4; ++g) {
            const int s0 = 32 * st + 8 * g + 4 * hh;
            if (st < TB) { const f32x4 gv = *(const LAS f32x4*)(GA + s0);
#pragma unroll
                for (int e = 0; e < 4; ++e) pv[4 * g + e] = S[st][4 * g + e] * (__expf(gv[e] - Mf2) * invf);
            } else if (st > TB) { const f32x4 gv = *(const LAS f32x4*)(GA + 512 + s0);
#pragma unroll
                for (int e = 0; e < 4; ++e) pv[4 * g + e] = S[st][4 * g + e] * (__expf(gv[e] - Mb2) * invb);
            } else { const f32x4 gf = *(const LAS f32x4*)(GA + s0), gbv = *(const LAS f32x4*)(GA + 512 + s0);
#pragma unroll
                for (int e = 0; e < 4; ++e) { const float dts = (float)(t - (s0 + e));
                    const float wf = __expf(gf[e] - Mf2 + fminf(dts, 0.f) * 1e30f), wb = __expf(gbv[e] - Mb2 - fmaxf(dts, 0.f) * 1e30f);
                    pv[4 * g + e] = S[st][4 * g + e] * (wf * invf + wb * invb); }
            }
        }
#pragma unroll
        for (int sp = 0; sp < 2; ++sp) { v4u w; w.x = cvtpk(pv[8 * sp], pv[8 * sp + 1]); w.y = cvtpk(pv[8 * sp + 2], pv[8 * sp + 3]); w.z = cvtpk(pv[8 * sp + 4], pv[8 * sp + 5]); w.w = cvtpk(pv[8 * sp + 6], pv[8 * sp + 7]);
            pb[st][sp] = __builtin_bit_cast(bf16x8_t, w); }
        __builtin_amdgcn_sched_barrier(0);
    }
}

__device__ __forceinline__ void mlstm_out_item(const bf16* Q, const bf16* K, const bf16* V, const bf16* OG, const float* GT, const bf16* CT, const float* NS, const float* MP,
                                               const float* mg, bf16* Y, int b, int h, int a, LAS unsigned char* lds, int tid) {
    asm volatile("" : "+v"(tid));
    const int lane = tid & 63, wave = __builtin_amdgcn_readfirstlane(tid >> 6);
    const int row0 = chunk_row0(b, a);
    const int seqf = (b * 4 + h) * 2, seqb = seqf + 1;
    LAS unsigned char* Kimg = lds; LAS unsigned char* Vimg = lds + 32768; LAS unsigned char* Cf = lds + 65536; LAS unsigned char* Cb = lds + 98304;
    LAS float* GA = (LAS float*)(lds + MX_OFF);
    LAS float* NSL = GA + 1024;
    LAS float* SSQ = NSL + 256;
    const int r = lane & 31, hh = lane >> 5, i16 = lane & 15, q = i16 >> 2, p = i16 & 3, blk = (lane >> 4) & 1;
    const int tb = wave & 3, dh = wave >> 2;
    const int t = 32 * tb + r;
    {
        v4u kr[4], vr[4];
#pragma unroll
        for (int i = 0; i < 4; ++i) { const int pc = tid + NTHREADS * i; const size_t go = (size_t)(row0 + (pc >> 4)) * HW + h * 128 + (pc & 15) * 8; kr[i] = *(const v4u*)(K + go); vr[i] = *(const v4u*)(V + go); }
#pragma unroll
        for (int i = 0; i < 4; ++i) { const int pc = tid + NTHREADS * i; *(LAS v4u*)(Kimg + pc * 16) = kr[i]; *(LAS v4u*)(Vimg + pc * 16) = vr[i]; }
    }
    __builtin_amdgcn_sched_barrier(0);
    {
        v4u fr_[4], br_[4];
        const bf16* cfp = CT + (size_t)(seqf * 18 + a) * 16384; const bf16* cbp = CT + (size_t)(seqb * 18 + a) * 16384;
#pragma unroll
        for (int i = 0; i < 4; ++i) { const int pc = tid + NTHREADS * i; fr_[i] = *(const v4u*)(cfp + pc * 8); br_[i] = *(const v4u*)(cbp + pc * 8); }
#pragma unroll
        for (int i = 0; i < 4; ++i) { const int pc = tid + NTHREADS * i; *(LAS v4u*)(Cf + pc * 16) = fr_[i]; *(LAS v4u*)(Cb + pc * 16) = br_[i]; }
    }
    __builtin_amdgcn_sched_barrier(0);
    bf16x8_t qf[8];
#pragma unroll
    for (int ks = 0; ks < 8; ++ks) qf[ks] = *(const bf16x8_t*)(Q + (size_t)(row0 + t) * HW + h * 128 + 16 * ks + 8 * hh);
    if (wave < 2) {
        const int dir = wave; const float mprev = MP[(dir ? seqb : seqf) * 18 + a];
        const int t0 = dir ? 127 - 2 * lane : 2 * lane, t1 = dir ? 126 - 2 * lane : 2 * lane + 1;
        const float* g0p = GT + (size_t)(row0 + t0) * 16 + dir * 8 + h; const float* g1p = GT + (size_t)(row0 + t1) * 16 + dir * 8 + h;
        const float i0 = g0p[0], i1 = g1p[0], x0 = log_sigmoid(g0p[4]), x1 = log_sigmoid(g1p[4]);
        const float sc = wave_incl_add(x0 + x1, lane);
        const float b0 = sc - x1, b1 = sc, g0 = i0 - b0, g1 = i1 - b1;
        const float ip = wave_incl_max(fmaxf(g0, g1), lane);
        float ex = lane_get(ip, lane - 1); if (lane == 0) ex = -INFINITY;
        const float pm0 = fmaxf(ex, g0), pm1 = ip;
        const float M0 = fmaxf(mprev, pm0), M1 = fmaxf(mprev, pm1);
        LAS float* ga = GA + dir * 512;
        ga[t0] = g0; ga[128 + t0] = M0; ga[256 + t0] = __expf(mprev - M0); ga[384 + t0] = __expf(-(b0 + M0));
        ga[t1] = g1; ga[128 + t1] = M1; ga[256 + t1] = __expf(mprev - M1); ga[384 + t1] = __expf(-(b1 + M1));
    } else if (wave < 6) {
        const int e = tid - 128;
        NSL[e] = NS[(size_t)(((e >> 7) ? seqb : seqf) * 18 + a) * 128 + (e & 127)];
    }
    __syncthreads();
    f32x16 S[4];
#pragma unroll
    for (int st = 0; st < 4; ++st)
#pragma unroll
        for (int i = 0; i < 16; ++i) S[st][i] = 0.f;
#pragma unroll
    for (int ks = 0; ks < 8; ++ks) {
#pragma unroll
        for (int st = 0; st < 4; ++st) { const bf16x8_t A = *(const LAS bf16x8_t*)(Kimg + (32 * st + r) * 256 + 2 * (16 * ks + 8 * hh)); S[st] = MFMA32(A, qf[ks], S[st]); }
        __builtin_amdgcn_sched_barrier(0); }
    __builtin_amdgcn_sched_barrier(0);
    float qnf = 0.f, qnb = 0.f;
#pragma unroll
    for (int ks = 0; ks < 8; ++ks)
#pragma unroll
        for (int j = 0; j < 8; ++j) { const float qv = bf2f((unsigned short)qf[ks][j]); const int dk = 16 * ks + 8 * hh + j; qnf += qv * NSL[dk]; qnb += qv * NSL[128 + dk]; }
    qnf += lane_get(qnf, lane ^ 32); qnb += lane_get(qnb, lane ^ 32);
    bf16x8_t pb[4][2];
    float sff, sfb;
    switch (tb) {
        case 0: mlstm_weights<0>(S, pb, GA, t, hh, lane, qnf, qnb, sff, sfb); break;
        case 1: mlstm_weights<1>(S, pb, GA, t, hh, lane, qnf, qnb, sff, sfb); break;
        case 2: mlstm_weights<2>(S, pb, GA, t, hh, lane, qnf, qnb, sff, sfb); break;
        default: mlstm_weights<3>(S, pb, GA, t, hh, lane, qnf, qnb, sff, sfb); break;
    }
    __builtin_amdgcn_sched_barrier(0);
    bf16x8_t qf2[8];
#pragma unroll
    for (int ks = 0; ks < 8; ++ks) qf2[ks] = *(const bf16x8_t*)(Q + (size_t)(row0 + t) * HW + h * 128 + 16 * ks + 8 * hh);
    __builtin_amdgcn_sched_barrier(0);
    f32x16 Hc[2];
#pragma unroll
    for (int d = 0; d < 2; ++d)
#pragma unroll
        for (int i = 0; i < 16; ++i) Hc[d][i] = 0.f;
#pragma unroll
    for (int d = 0; d < 2; ++d) { const int dvt = 2 * dh + d;
#pragma unroll
        for (int st = 0; st < 4; ++st)
#pragma unroll
            for (int sp = 0; sp < 2; ++sp) { const LAS unsigned char* va = Vimg + (32 * st + 16 * sp + 4 * hh + q) * 256 + 2 * (32 * dvt + 16 * blk + 4 * p);
                const bf16x8_t A = cat8(tr16(va), tr16(va + 8 * 256)); Hc[d] = MFMA32(A, pb[st][sp], Hc[d]); if (sp) __builtin_amdgcn_sched_barrier(0); } }
#pragma unroll
    for (int dd = 0; dd < 2; ++dd) {
        const float sfac = dd ? sfb : sff; const LAS unsigned char* Cimg = dd ? Cb : Cf;
        bf16x8_t qs[8];
#pragma unroll
        for (int ks = 0; ks < 8; ++ks) { v4u w;
            w.x = cvtpk(bf2f((unsigned short)qf2[ks][0]) * sfac, bf2f((unsigned short)qf2[ks][1]) * sfac); w.y = cvtpk(bf2f((unsigned short)qf2[ks][2]) * sfac, bf2f((unsigned short)qf2[ks][3]) * sfac);
            w.z = cvtpk(bf2f((unsigned short)qf2[ks][4]) * sfac, bf2f((unsigned short)qf2[ks][5]) * sfac); w.w = cvtpk(bf2f((unsigned short)qf2[ks][6]) * sfac, bf2f((unsigned short)qf2[ks][7]) * sfac);
            qs[ks] = __builtin_bit_cast(bf16x8_t, w); }
#pragma unroll
        for (int d = 0; d < 2; ++d) { const int dvt = 2 * dh + d;
#pragma unroll
            for (int ks = 0; ks < 8; ++ks) { const bf16x8_t A = *(const LAS bf16x8_t*)(Cimg + (32 * dvt + r) * 256 + 2 * (16 * ks + 8 * hh)); Hc[d] = MFMA32(A, qs[ks], Hc[d]); if (ks & 1) __builtin_amdgcn_sched_barrier(0); } }
    }
    __builtin_amdgcn_sched_barrier(0);
    float ss = 0.f;
#pragma unroll
    for (int d = 0; d < 2; ++d)
#pragma unroll
        for (int i = 0; i < 16; ++i) ss += Hc[d][i] * Hc[d][i];
    ss += lane_get(ss, lane ^ 32);
    if (hh == 0) SSQ[dh * 128 + t] = ss;
    __syncthreads();
    const float rr = 1.0f / sqrtf((SSQ[t] + SSQ[128 + t]) * (1.0f / 128.0f) + EPS);
#pragma unroll
    for (int d = 0; d < 2; ++d)
#pragma unroll
        for (int g = 0; g < 4; ++g) { const int dv = 32 * (2 * dh + d) + 8 * g + 4 * hh;
            const v2u og = *(const v2u*)(OG + (size_t)(row0 + t) * HW + h * 128 + dv); const f32x4 gg = *(const f32x4*)(mg + h * 128 + dv);
            v2u o; o.x = cvtpk(Hc[d][4 * g] * rr * gg.x * bflo(og.x), Hc[d][4 * g + 1] * rr * gg.y * bfhi(og.x)); o.y = cvtpk(Hc[d][4 * g + 2] * rr * gg.z * bflo(og.y), Hc[d][4 * g + 3] * rr * gg.w * bfhi(og.y));
            *(v2u*)(Y + (size_t)(row0 + t) * D + h * 128 + dv) = o; }
    __syncthreads();
}
constexpr int N_PHASES = 18;
#ifndef MK_ONE_LAUNCH
#define MK_ONE_LAUNCH 0
#endif
#ifndef PH_MASK
#define PH_MASK 0x3ff
#endif
#ifndef REP_MASK
#define REP_MASK 0
#endif
#define PH_EN(b) (((PH_MASK) >> (b)) & 1)

__global__ void __launch_bounds__(NTHREADS, 2) fwd_kernel(Args args) {
    extern __shared__ __attribute__((aligned(16))) unsigned char lds_raw[];
    LAS unsigned char* lds = (LAS unsigned char*)lds_raw;
    const int G = gridDim.x;
    unsigned char* ws = args.ws;
    volatile LAS unsigned* MISC = (volatile LAS unsigned*)(lds + MISC_OFF);
    for (int u = threadIdx.x; u < (LDS_BYTES - RING_BYTES) / 4; u += NTHREADS) ((LAS unsigned*)(lds + RING_BYTES))[u] = 0u;
    __syncthreads();
    XcdBarrier bar; bar.bar = (unsigned*)(ws + WS_CTL) + 4096; bar.x = 0; bar.st = nullptr;
    const int lo = args.ph_lo, hi = args.ph_hi;
    if (hi - lo > 1) bar = xcd_barrier_post((unsigned*)(ws + WS_CTL) + 4096, MISC + 8);
#define IN(k) (lo <= (k) && (k) < hi)
#define SEAM(k) do { if (IN(k) && IN((k) + 1)) xcd_barrier(bar); } while (0)

#pragma unroll 1
    for (int ph = lo; ph < hi; ++ph) {
#if REP_MASK
#pragma unroll 1
      for (int rep = 0; rep < ((ph >= 1 && ph <= 16 && (((REP_MASK) >> ((ph - 1) & 7)) & 1)) ? 2 : 1); ++rep) {
#else
      {
#endif
        int tid = threadIdx.x; asm volatile("" : "+v"(tid));
        const int lane = tid & 63, wave = __builtin_amdgcn_readfirstlane(tid >> 6);
        if (ph == 0) { if (PH_EN(8)) phase_prologue(args, lds, G, tid, lane, wave); }
        else if (ph == N_PHASES - 1) { if (PH_EN(9)) phase_final(args.out, args.in[I_FG], G, lane, wave); }
        else {
            const int l = (ph - 1) >> 3, k = (ph - 1) & 7;
            {
            const bool last = (l == DEPTH - 1);
            const int mrest = last ? ML : MT;
            const float* modl = (const float*)(ws + WS_MOD) + (size_t)l * 17 * MODW;
            const unsigned char* wl = ws + WS_W + (size_t)l * W_LAYER;
            if (k == 0 && PH_EN(0)) {
                phase_norm(l == 0 ? args.in[I_X] : args.out, l == 0 ? args.in[I_CTX] : (const float*)(ws + WS_XC), (bf16*)(ws + WS_A), args.in[I_N1G] + l * D, modl, 0, MT, G, lane, wave);
            } else if (k == 1 && PH_EN(1)) {
                pg8::Gemm g{(const bf16*)(ws + WS_A), (const bf16*)(wl + WO_IN), MT, NIN, D}; pg8::StaticOrder S; S.init(MT, NIN, G, (int)blockIdx.x);
                pg8::EpiIn E{ws + WS_P, (const float*)(ws + WS_BIN) + l * NIN};
                pg8::gemm_phase<pg8::EpiIn, pg8::StaticOrder, true, true>(lds, g, S, E, tid);
            } else if (k == 2 && PH_EN(2)) {
                for (int it = blockIdx.x; it < 256; it += G)
                    mlstm_state_item((const bf16*)(ws + WS_K), (const bf16*)(ws + WS_V), (const float*)(ws + WS_GT), (bf16*)(ws + WS_CT), (float*)(ws + WS_NS), (float*)(ws + WS_MP), it, !last, lds, tid);
                const int nch = mrest / 128;
                for (int it = blockIdx.x; it < nch; it += G) {
                    sgu_item((const bf16*)(ws + WS_Z), args.in[I_SLG] + l * 256, args.in[I_SLB] + l * 256, args.in[I_SW] + (size_t)l * 4 * 128 * 128, args.in[I_SB] + l * 4 * 128, (bf16*)(ws + WS_Y), it, lds, tid, lane, wave);
                    conv_rows((const bf16*)(ws + WS_YC), args.in[I_CW] + l * 31 * 256, args.in[I_CB] + l * 256, args.in[I_CLG] + l * 256, args.in[I_CLB] + l * 256, (bf16*)(ws + WS_Y), it * 128, 128, lane, wave);
                }
            } else if (k == 3 && PH_EN(3)) {
                const int abase = last ? 2 : 0, na = 18 - abase;
                for (int it = blockIdx.x; it < 64 * na; it += G) { const int bh = it / na, a = abase + it % na;
                    mlstm_out_item((const bf16*)(ws + WS_Q), (const bf16*)(ws + WS_K), (const bf16*)(ws + WS_V), (const bf16*)(ws + WS_OG), (const float*)(ws + WS_GT), (const bf16*)(ws + WS_CT), (const float*)(ws + WS_NS), (const float*)(ws + WS_MP),
                                   args.in[I_MG] + l * HW, (bf16*)(ws + WS_Y), bh >> 2, bh & 3, a, lds, tid); }
            } else if (k == 4 && PH_EN(4)) {
                pg8::Gemm g{(const bf16*)(ws + WS_Y), (const bf16*)(wl + WO_OUT), mrest, D, D}; pg8::StaticOrder S; S.init(mrest, D, G, (int)blockIdx.x);
                pg8::EpiRes E{l == 0 ? args.in[I_X] : args.out, args.out, l == 0 ? args.in[I_CTX] : (const float*)(ws + WS_XC), (float*)(ws + WS_XC), modl + 2 * D, ML};
                pg8::gemm_phase<pg8::EpiRes, pg8::StaticOrder, true, true>(lds, g, S, E, tid);
            } else if (k == 5 && PH_EN(5)) {
                phase_norm(args.out, (const float*)(ws + WS_XC), (bf16*)(ws + WS_A), args.in[I_N2G] + l * D, modl, 3 * D, mrest, G, lane, wave);
            } else if (k == 6 && PH_EN(6)) {
                pg8::Gemm g{(const bf16*)(ws + WS_A), (const bf16*)(wl + WO_GU), mrest, NGU, D}; pg8::StaticOrder S; S.init(mrest, NGU, G, (int)blockIdx.x);
                pg8::EpiGU E{(bf16*)(ws + WS_H)};
                pg8::gemm_phase<pg8::EpiGU, pg8::StaticOrder, true, true>(lds, g, S, E, tid);
            } else if (PH_EN(7)) {
                pg8::Gemm g{(const bf16*)(ws + WS_H), (const bf16*)(wl + WO_DOWN), mrest, D, FF}; pg8::StaticOrder S; S.init(mrest, D, G, (int)blockIdx.x);
                pg8::EpiRes E{args.out, args.out, (const float*)(ws + WS_XC), (float*)(ws + WS_XC), modl + 5 * D, ML};
                pg8::gemm_phase<pg8::EpiRes, pg8::StaticOrder, true, true>(lds, g, S, E, tid);
            }
            }
        }
      }
        if (ph + 1 < hi) xcd_barrier(bar);
    }
#undef IN
#undef SEAM
}

extern "C" void kernel_launch(void* const* d_in, const int* in_sizes, int n_in, void* d_out, int out_size, void* d_ws, size_t ws_size, hipStream_t stream) {
    static int grid = 0;
    if (grid == 0) {
        if (n_in != 23 || in_sizes[0] != ML * D || out_size != ML * D || ws_size < WS_END) {
            fprintf(stderr, "kernel_launch: unexpected problem (n_in %d, in0 %d, out %d, ws %zu < %zu); nothing launched\n", n_in, n_in > 0 ? in_sizes[0] : -1, out_size, ws_size, (size_t)WS_END); grid = -1; return; }
        int dev = 0, cus = 0, per_cu = 0;
        if (hipGetDevice(&dev) != hipSuccess || hipDeviceGetAttribute(&cus, hipDeviceAttributeMultiprocessorCount, dev) != hipSuccess) { grid = -1; return; }
        if (hipFuncSetAttribute((const void*)fwd_kernel, hipFuncAttributeMaxDynamicSharedMemorySize, LDS_BYTES) != hipSuccess) { fprintf(stderr, "kernel_launch: hipFuncSetAttribute failed\n"); grid = -1; return; }
        if (hipOccupancyMaxActiveBlocksPerMultiprocessor(&per_cu, (const void*)fwd_kernel, NTHREADS, LDS_BYTES) != hipSuccess || per_cu < 1) {
            fprintf(stderr, "kernel_launch: occupancy query reports %d blocks per CU\n", per_cu); per_cu = 1; }
        (void)hipGetLastError();
        grid = cus;
    }
    if (grid < 0) return;
    if (hipMemsetAsync((char*)d_ws + WS_CTL, 0, ZERO_BYTES, stream) != hipSuccess) { fprintf(stderr, "kernel_launch: memset failed\n"); return; }
    Args a{};
    for (int i = 0; i < 23; ++i) a.in[i] = (const float*)d_in[i];
    a.out = (float*)d_out; a.ws = (unsigned char*)d_ws;
#if MK_ONE_LAUNCH
    a.ph_lo = 0; a.ph_hi = N_PHASES;
    hipLaunchKernelGGL(fwd_kernel, dim3(grid), dim3(NTHREADS), LDS_BYTES, stream, a);
#else
    for (int p = 0; p < N_PHASES; ++p) { a.ph_lo = p; a.ph_hi = p + 1; hipLaunchKernelGGL(fwd_kernel, dim3(grid), dim3(NTHREADS), LDS_BYTES, stream, a); }
#endif
    const hipError_t le = hipPeekAtLastError();
    if (le != hipSuccess) fprintf(stderr, "kernel_launch: launch failed: %s\n", hipGetErrorName(le));
}
```

```cpp
#include <hip/hip_runtime.h>
#include <cstdio>
#include <cstdint>
#ifndef MK_ONE_LAUNCH
#define MK_ONE_LAUNCH 1
#endif
namespace pg8 {
#define PG8_LAS __attribute__((address_space(3)))
typedef unsigned short bf16_t;
typedef short bf16x8 __attribute__((ext_vector_type(8)));
typedef float f32x4 __attribute__((ext_vector_type(4)));
typedef unsigned u32x4 __attribute__((ext_vector_type(4)));
constexpr int BM = 256, BK = 64, HALF = 128, HTB = HALF * BK * 2  , STAGE_BYTES = 8 * HTB, NXCD = 8, WGM = 8;

__host__ __device__ __forceinline__ int lds_byte(int r, int c) { const int st = (r >> 4) * 2 + (c >> 5), rr = r & 15, cc = c & 31, ob = rr * 64 + cc * 2; return st * 1024 + (ob ^ (((ob >> 9) & 1) << 5)); }
__host__ __device__ __forceinline__ void stage_rc(int b, int& R, int& C) { const int st = b / 1024, sb = b % 1024, swz = sb ^ (((sb >> 9) & 1) << 5); R = (st >> 1) * 16 + swz / 64; C = (st & 1) * 32 + (swz % 64) / 2; }
__host__ __device__ __forceinline__ int perm32(int rho) { const int n = rho >> 4, i = rho & 15; return 8 * (i >> 2) + 4 * n + (i & 3); }

struct Unit { int pm, pn; };
struct Gemm { const bf16_t* A; const bf16_t* Bt; int M, N, K; };

struct StaticOrder {
    int nM, nN, nwg, G, c;
    __host__ __device__ void init(int M, int N, int G_, int c_) { nM = M / BM; nN = N / BM; nwg = nM * nN; G = G_; c = c_; }
    __host__ __device__ bool next(int i, Unit& u) const {
        const long L = (long)i * G + c; if (L >= nwg) return false;
        int wgid = (int)L; { const int q = nwg / NXCD, r = nwg % NXCD, xcd = wgid % NXCD, off = wgid / NXCD; wgid = (xcd < r ? xcd * (q + 1) : r * (q + 1) + (xcd - r) * q) + off; }
        const int nig = WGM * nN, gid = wgid / nig, fm = gid * WGM, gsz = (nM - fm) < WGM ? (nM - fm) : WGM;
        u.pm = fm + ((wgid % nig) % gsz); u.pn = (wgid % nig) / gsz; return true;
    }
    __device__ __forceinline__ void a_ready(const Unit&) const {}
    __device__ __forceinline__ void done(const Unit&) const {}
};

__device__ __forceinline__ unsigned cvt_pk_bf16(float lo, float hi) { unsigned r; asm volatile("v_cvt_pk_bf16_f32 %0, %1, %2" : "=v"(r) : "v"(lo), "v"(hi)); return r; }
template <class Epi, class Sched, bool ALIGN_EPI = false, bool SP2 = false>
__device__ __forceinline__ void gemm_phase(PG8_LAS unsigned char* lds, const Gemm g, const Sched& S, const Epi& E, const int tid) {
    const int wid = __builtin_amdgcn_readfirstlane(tid >> 6), lane = tid & 63, wr = wid >> 2, wc = wid & 3, fr = lane & 15, fq = lane >> 4;
    const int K = g.K, nt = K / BK;
    unsigned voffA[2], voffB[2];
#pragma unroll
    for (int i = 0; i < 2; ++i) { int R, C; stage_rc(tid * 16 + i * 8192, R, C); const int Rb = Epi::PERM ? ((R & ~31) + perm32(R & 31)) : R;
        voffA[i] = (unsigned)(R * K + C) * 2u; voffB[i] = (unsigned)(Rb * K + C) * 2u; }
    const size_t kstep = (size_t)(BK * 2);
    const size_t hstep = (size_t)HALF * K * 2;
    const size_t tstep = 2 * hstep;
    const unsigned ldsw = (unsigned)wid * 1024u;
    const int aoff = lds_byte(wr * 64 + fr, fq * 8), boff = lds_byte(wc * 32 + fr, fq * 8);
#define PG8_SA(b, h) (((b) * 2 + (h)) * HTB)
#define PG8_SB(b, h) ((4 + (b) * 2 + (h)) * HTB)
#define PG8_STAGE(bufoff, gbase, voff) do { _Pragma("unroll") for (int _i = 0; _i < 2; ++_i) \
        __builtin_amdgcn_global_load_lds((const unsigned*)((const char*)(gbase) + (voff)[_i]), (PG8_LAS unsigned*)(lds + (bufoff) + ldsw + _i * 8192), 16, 0, 0); } while (0)
#define PG8_LDA(dst, b, h) do { _Pragma("unroll") for (int m = 0; m < 4; ++m) _Pragma("unroll") for (int k = 0; k < 2; ++k) dst[m][k] = *(const PG8_LAS bf16x8*)(lds + PG8_SA(b, h) + aoff + m * 2048 + k * 1024); } while (0)
#define PG8_LDB(dst, b, h) do { _Pragma("unroll") for (int n = 0; n < 2; ++n) _Pragma("unroll") for (int k = 0; k < 2; ++k) dst[n][k] = *(const PG8_LAS bf16x8*)(lds + PG8_SB(b, h) + boff + n * 2048 + k * 1024); } while (0)
#define PG8_MMA(ai, bj, At, Bt) do { __builtin_amdgcn_s_setprio(1); _Pragma("unroll") for (int m = 0; m < 4; ++m) _Pragma("unroll") for (int n = 0; n < 2; ++n) _Pragma("unroll") for (int k = 0; k < 2; ++k) \
        acc[ai][bj][m][n] = __builtin_amdgcn_mfma_f32_16x16x32_bf16(Bt[n][k], At[m][k], acc[ai][bj][m][n], 0, 0, 0); __builtin_amdgcn_s_setprio(0); } while (0)
#define PG8_WAIT_V(n) asm volatile("s_waitcnt vmcnt(" #n ")" ::: "memory")
#define PG8_WAIT_L(n) asm volatile("s_waitcnt lgkmcnt(" #n ")" ::: "memory")
#define PG8_BAR __builtin_amdgcn_s_barrier()
#define PG8_SCHED __builtin_amdgcn_sched_barrier(0)
    Unit cur, nxt; int ui = 0;
    if (!S.next(0, cur)) return;
    f32x4 acc[2][2][4][2];
#pragma unroll
    for (int a = 0; a < 2; ++a)
#pragma unroll
        for (int b = 0; b < 2; ++b)
#pragma unroll
            for (int m = 0; m < 4; ++m)
#pragma unroll
                for (int n = 0; n < 2; ++n) acc[a][b][m][n] = (f32x4){0.f, 0.f, 0.f, 0.f};
    bf16x8 At[4][2], B0[2][2], B1[2][2];
    const char* cA = (const char*)g.A + (size_t)cur.pm * tstep; const char* cB = (const char*)g.Bt + (size_t)cur.pn * tstep;
    S.a_ready(cur);
    if constexpr (SP2) {
        PG8_STAGE(PG8_SB(0, 0), cB, voffB); PG8_STAGE(PG8_SB(0, 1), cB + hstep, voffB); PG8_STAGE(PG8_SA(0, 0), cA, voffA); PG8_STAGE(PG8_SA(0, 1), cA + hstep, voffA);
        if (wr == 1) PG8_BAR;
        PG8_WAIT_V(2); PG8_BAR;
        PG8_STAGE(PG8_SB(1, 0), cB + kstep, voffB); PG8_STAGE(PG8_SA(1, 0), cA + kstep, voffA); PG8_STAGE(PG8_SB(1, 1), cB + hstep + kstep, voffB);
        PG8_WAIT_V(6); PG8_BAR;
    } else {
        PG8_STAGE(PG8_SB(0, 0), cB, voffB); PG8_STAGE(PG8_SA(0, 0), cA, voffA); PG8_STAGE(PG8_SB(0, 1), cB + hstep, voffB); PG8_STAGE(PG8_SA(0, 1), cA + hstep, voffA);
        if (wr == 1) PG8_BAR;
        PG8_WAIT_V(4); PG8_BAR;
        PG8_STAGE(PG8_SB(1, 0), cB + kstep, voffB); PG8_STAGE(PG8_SA(1, 0), cA + kstep, voffA); PG8_STAGE(PG8_SB(1, 1), cB + hstep + kstep, voffB);
        PG8_WAIT_V(6); PG8_BAR;
    }
    for (;;) {
        const bool has_next = S.next(ui + 1, nxt);
        const char* nA = has_next ? (const char*)g.A + (size_t)nxt.pm * tstep : cA; const char* nB = has_next ? (const char*)g.Bt + (size_t)nxt.pn * tstep : cB;
        for (int t = 0; t < nt; t += 2) {
            const bool last = (t == nt - 2);
            const char* a1 = cA + (size_t)(t + 1) * kstep;
            const char* a2 = last ? nA : cA + (size_t)(t + 2) * kstep; const char* b2 = last ? nB : cB + (size_t)(t + 2) * kstep;
            const char* a3 = a2 + kstep; const char* b3 = b2 + kstep;
            if (last && has_next) S.a_ready(nxt);
            if constexpr (SP2) {
            PG8_LDB(B0, 0, 0); PG8_LDB(B1, 0, 1); PG8_SCHED; PG8_LDA(At, 0, 0); PG8_STAGE(PG8_SA(1, 1), a1 + hstep, voffA);
            PG8_WAIT_V(8); PG8_WAIT_L(0); PG8_BAR; PG8_MMA(0, 0, At, B0); PG8_MMA(0, 1, At, B1); PG8_BAR; PG8_SCHED;
            PG8_LDA(At, 0, 1); PG8_STAGE(PG8_SB(0, 0), b2, voffB); PG8_STAGE(PG8_SB(0, 1), b2 + hstep, voffB); PG8_STAGE(PG8_SA(0, 0), a2, voffA);
            PG8_WAIT_V(8); PG8_WAIT_L(0); PG8_BAR; PG8_MMA(1, 0, At, B0); PG8_MMA(1, 1, At, B1); PG8_BAR; PG8_SCHED;
            PG8_LDB(B0, 1, 0); PG8_LDB(B1, 1, 1); PG8_SCHED; PG8_LDA(At, 1, 0); PG8_STAGE(PG8_SA(0, 1), a2 + hstep, voffA);
            PG8_WAIT_V(8); PG8_WAIT_L(0); PG8_BAR; PG8_MMA(0, 0, At, B0); PG8_MMA(0, 1, At, B1); PG8_BAR; PG8_SCHED;
            PG8_LDA(At, 1, 1); PG8_STAGE(PG8_SB(1, 0), b3, voffB); PG8_STAGE(PG8_SB(1, 1), b3 + hstep, voffB); PG8_STAGE(PG8_SA(1, 0), a3, voffA);
            PG8_WAIT_V(8); PG8_WAIT_L(0); PG8_BAR; PG8_MMA(1, 0, At, B0); PG8_MMA(1, 1, At, B1); PG8_BAR; PG8_SCHED;
            } else {
            PG8_LDB(B0, 0, 0); PG8_SCHED; PG8_LDA(At, 0, 0); PG8_STAGE(PG8_SA(1, 1), a1 + hstep, voffA);
            PG8_WAIT_L(8); PG8_BAR; PG8_WAIT_L(0); PG8_MMA(0, 0, At, B0); PG8_BAR; PG8_SCHED;
            PG8_LDB(B1, 0, 1); PG8_STAGE(PG8_SB(0, 0), b2, voffB);
            PG8_BAR; PG8_WAIT_L(0); PG8_MMA(0, 1, At, B1); PG8_BAR;
            PG8_LDA(At, 0, 1); PG8_STAGE(PG8_SA(0, 0), a2, voffA);
            PG8_BAR; PG8_WAIT_L(0); PG8_MMA(1, 0, At, B0); PG8_BAR; PG8_SCHED;
            PG8_STAGE(PG8_SB(0, 1), b2 + hstep, voffB);
            PG8_WAIT_V(6); PG8_BAR; PG8_MMA(1, 1, At, B1); PG8_BAR;
            PG8_LDB(B0, 1, 0); PG8_SCHED; PG8_LDA(At, 1, 0); PG8_STAGE(PG8_SA(0, 1), a2 + hstep, voffA);
            PG8_WAIT_L(8); PG8_BAR; PG8_WAIT_L(0); PG8_MMA(0, 0, At, B0); PG8_BAR; PG8_SCHED;
            PG8_LDB(B1, 1, 1); PG8_STAGE(PG8_SB(1, 0), b3, voffB);
            PG8_BAR; PG8_WAIT_L(0); PG8_MMA(0, 1, At, B1); PG8_BAR;
            PG8_LDA(At, 1, 1); PG8_STAGE(PG8_SA(1, 0), a3, voffA);
            PG8_BAR; PG8_WAIT_L(0); PG8_MMA(1, 0, At, B0); PG8_BAR; PG8_SCHED;
            PG8_STAGE(PG8_SB(1, 1), b3 + hstep, voffB);
            PG8_WAIT_V(6); PG8_BAR; PG8_MMA(1, 1, At, B1); PG8_BAR;
            }
        }
        if constexpr (ALIGN_EPI) { if (wr == 0) PG8_BAR; }
        if constexpr (!Epi::AFTER_DRAIN) { E(acc, cur, wr, wc, fr, fq); S.done(cur); }
        if (!has_next) break;
#pragma unroll
        for (int a = 0; a < 2; ++a)
#pragma unroll
            for (int b = 0; b < 2; ++b)
#pragma unroll
                for (int m = 0; m < 4; ++m)
#pragma unroll
                    for (int n = 0; n < 2; ++n) acc[a][b][m][n] = (f32x4){0.f, 0.f, 0.f, 0.f};
        cur = nxt; cA = nA; cB = nB; ++ui;
        if constexpr (ALIGN_EPI) { if (wr == 1) PG8_BAR; }
    }
    PG8_WAIT_V(0);
    if constexpr (!ALIGN_EPI) { if (wr == 0) PG8_BAR; }
    PG8_BAR;
    if constexpr (Epi::AFTER_DRAIN) { E.fused(acc, cur, wr, wc, fr, fq, lds, wid, lane); S.done(cur); }
#undef PG8_SA
#undef PG8_SB
#undef PG8_STAGE
#undef PG8_LDA
#undef PG8_LDB
#undef PG8_MMA
#undef PG8_WAIT_V
#undef PG8_WAIT_L
#undef PG8_BAR
#undef PG8_SCHED
}
}
namespace pg8 {
__device__ __forceinline__ u32x4 pack8(const f32x4& v0, const f32x4& v1) { u32x4 w; w.x = cvt_pk_bf16(v0[0], v0[1]); w.y = cvt_pk_bf16(v0[2], v0[3]); w.z = cvt_pk_bf16(v1[0], v1[1]); w.w = cvt_pk_bf16(v1[2], v1[3]); return w; }
__device__ __forceinline__ float sigm(float x) { return __builtin_amdgcn_rcpf(1.0f + __expf(-x)); }
__device__ __forceinline__ f32x4 sigm4(const f32x4& v) { return (f32x4){sigm(v[0]), sigm(v[1]), sigm(v[2]), sigm(v[3])}; }
__device__ __forceinline__ float gelu_t(float x) { const float u = 1.5957691216057308f * (x + 0.044715f * x * x * x); return x * sigm(u); }
__device__ __forceinline__ f32x4 gelu4(const f32x4& v) { return (f32x4){gelu_t(v[0]), gelu_t(v[1]), gelu_t(v[2]), gelu_t(v[3])}; }

struct EpiIn {
    static constexpr bool PERM = true, AFTER_DRAIN = false;
    unsigned char* P; const float* bias;
    __device__ __forceinline__ void operator()(const f32x4 (&acc)[2][2][4][2], const Unit& u, int wr, int wc, int fr, int fq) const {
        const int pn = u.pn, row0 = u.pm * BM + wr * 64 + fr, cl = wc * 32 + 8 * fq;
        f32x4 bv[2][2];
#pragma unroll
        for (int bj = 0; bj < 2; ++bj)
#pragma unroll
            for (int n = 0; n < 2; ++n) bv[bj][n] = *(const f32x4*)(bias + pn * BM + bj * HALF + cl + 4 * n);
        if (pn < 10) {
            bf16_t* base = (bf16_t*)(P + (size_t)(pn >> 1) * (36u << 20));
            const float sc = (pn >= 2 && pn < 4) ? 0.08838834764831845f : 1.0f;
            const int act = pn < 6 ? 0 : pn < 8 ? 1 : 2;
            const int dcol = (pn & 1) * BM + cl;
#pragma unroll
            for (int ai = 0; ai < 2; ++ai)
#pragma unroll
                for (int m = 0; m < 4; ++m) { bf16_t* rowp = base + (size_t)(row0 + ai * HALF + m * 16) * 512 + dcol;
#pragma unroll
                    for (int bj = 0; bj < 2; ++bj) { f32x4 v0 = acc[ai][bj][m][0] + bv[bj][0], v1 = acc[ai][bj][m][1] + bv[bj][1];
                        if (act == 1) { v0 = sigm4(v0); v1 = sigm4(v1); } else if (act == 2) { v0 = gelu4(v0); v1 = gelu4(v1); } else { v0 = v0 * sc; v1 = v1 * sc; }
                        *(u32x4*)(rowp + bj * HALF) = pack8(v0, v1); } }
        } else if (pn < 12) {
            const int dcol = (pn - 10) * HALF + cl;
#pragma unroll
            for (int ai = 0; ai < 2; ++ai)
#pragma unroll
                for (int m = 0; m < 4; ++m) { bf16_t* rowp = (bf16_t*)(P + (size_t)5 * (36u << 20)) + (size_t)(row0 + ai * HALF + m * 16) * 256 + dcol;
                    const f32x4 a0 = acc[ai][0][m][0] + bv[0][0], a1 = acc[ai][0][m][1] + bv[0][1];
                    const f32x4 g0 = sigm4(acc[ai][1][m][0] + bv[1][0]), g1 = sigm4(acc[ai][1][m][1] + bv[1][1]);
                    *(u32x4*)rowp = pack8(a0 * g0, a1 * g1); }
        } else {
            if (wc == 0 && fq < 2) {
#pragma unroll
                for (int ai = 0; ai < 2; ++ai)
#pragma unroll
                    for (int m = 0; m < 4; ++m) { float* rowp = (float*)(P + (size_t)5 * (36u << 20) + (18u << 20)) + (size_t)(row0 + ai * HALF + m * 16) * 16 + 8 * fq;
                        *(f32x4*)rowp = acc[ai][0][m][0] + bv[0][0]; *(f32x4*)(rowp + 4) = acc[ai][0][m][1] + bv[0][1]; }
            }
        }
    }
};

struct EpiGU {
    static constexpr bool PERM = true, AFTER_DRAIN = false;
    bf16_t* H;
    __device__ __forceinline__ void operator()(const f32x4 (&acc)[2][2][4][2], const Unit& u, int wr, int wc, int fr, int fq) const {
        const int row0 = u.pm * BM + wr * 64 + fr, dcol = u.pn * HALF + wc * 32 + 8 * fq;
#pragma unroll
        for (int ai = 0; ai < 2; ++ai)
#pragma unroll
            for (int m = 0; m < 4; ++m) { bf16_t* rowp = H + (size_t)(row0 + ai * HALF + m * 16) * 2816 + dcol;
                const f32x4 g0 = acc[ai][0][m][0], g1 = acc[ai][0][m][1];
                *(u32x4*)rowp = pack8(g0 * sigm4(g0) * acc[ai][1][m][0], g1 * sigm4(g1) * acc[ai][1][m][1]); }
    }
};

struct EpiRes {
    static constexpr bool PERM = false, AFTER_DRAIN = false;
    const float* baseL; float* outL; const float* baseC; float* outC; const float* gate; int nlat;
    __device__ __forceinline__ void operator()(const f32x4 (&acc)[2][2][4][2], const Unit& u, int wr, int wc, int fr, int fq) const {
        const int trow = u.pm * BM; const bool lat = trow < nlat;
        const float* base = lat ? baseL + (size_t)trow * 1024 : baseC + (size_t)(trow - nlat) * 1024;
        float* out = lat ? outL + (size_t)trow * 1024 : outC + (size_t)(trow - nlat) * 1024;
        const float* gv = gate + (size_t)(lat ? (trow >> 11) : 16) * 6144;
        const int r0 = wr * 64 + fr, col0 = u.pn * BM + wc * 32 + 4 * fq;
        f32x4 g[2][2];
#pragma unroll
        for (int bj = 0; bj < 2; ++bj)
#pragma unroll
            for (int n = 0; n < 2; ++n) g[bj][n] = *(const f32x4*)(gv + col0 + bj * HALF + n * 16);
#pragma unroll
        for (int ai = 0; ai < 2; ++ai)
#pragma unroll
            for (int m = 0; m < 4; ++m) { const size_t off = (size_t)(r0 + ai * HALF + m * 16) * 1024 + col0;
#pragma unroll
                for (int bj = 0; bj < 2; ++bj)
#pragma unroll
                    for (int n = 0; n < 2; ++n) { const f32x4 b = *(const f32x4*)(base + off + bj * HALF + n * 16);
                        *(f32x4*)(out + off + bj * HALF + n * 16) = b + g[bj][n] * acc[ai][bj][m][n]; } }
    }
};
}
constexpr int D = 1024, NB = 16, SEQ = 2048, CTXL = 256, DEPTH = 2;
constexpr int ML = NB * SEQ, MC = NB * CTXL, MT = ML + MC;
constexpr int NIN_O = 3088, NIN = 3328, FF = 2816, NGU = 2 * FF;
constexpr int HW = 512;
constexpr int MODW = 6 * D;
constexpr float EPS = 1e-6f;
constexpr int NWAVES = 8, NTHREADS = 512;

constexpr size_t MiB = 1u << 20;
constexpr size_t WS_CTL = 0;
constexpr size_t WS_MOD = 1 * MiB;
constexpr size_t ZERO_BYTES = 2 * MiB;
constexpr size_t WS_BIN = 2 * MiB;
constexpr size_t WS_W = 3 * MiB, W_LAYER = 25 * MiB;
constexpr size_t WO_IN = 0, WO_OUT = 6 * MiB + 512 * 1024, WO_GU = WO_OUT + 2 * MiB, WO_DOWN = WO_GU + 11 * MiB;
constexpr size_t WS_XC = 53 * MiB;
constexpr size_t WS_A = 69 * MiB;
constexpr size_t WS_P = 141 * MiB;
constexpr size_t WS_Q = WS_P, WS_K = WS_Q + 36 * MiB, WS_V = WS_K + 36 * MiB, WS_OG = WS_V + 36 * MiB, WS_Z = WS_OG + 36 * MiB, WS_YC = WS_Z + 36 * MiB, WS_GT = WS_YC + 18 * MiB;
constexpr size_t WS_H = WS_P;
constexpr size_t WS_Y = 342 * MiB;
constexpr size_t WS_CT = WS_A;
constexpr size_t WS_NS = 414 * MiB, WS_MP = 416 * MiB;
constexpr size_t WS_SWB = 2 * MiB + 65536;
constexpr size_t WS_CV = 418 * MiB;
constexpr size_t WS_END = 486 * MiB;
static_assert(WS_GT + (size_t)MT * 16 * 4 <= WS_Y && WS_H + (size_t)MT * FF * 2 <= WS_Y && WS_W + 2 * W_LAYER <= WS_XC && WO_DOWN + (size_t)D * FF * 2 <= W_LAYER, "ws map");

constexpr int RING_BYTES = 131072, MISC_OFF = RING_BYTES + 320, LDS_BYTES = 147456;

#define GAS __attribute__((address_space(1)))
#define LAS __attribute__((address_space(3)))
typedef unsigned short bf16;
typedef unsigned v4u __attribute__((ext_vector_type(4)));
typedef unsigned v2u __attribute__((ext_vector_type(2)));
typedef float f32x4 __attribute__((ext_vector_type(4)));
typedef float f32x2 __attribute__((ext_vector_type(2)));
#define LDS_WAIT() asm volatile("s_waitcnt lgkmcnt(0)" ::: "memory")
__device__ __forceinline__ unsigned f2bf(float f) { unsigned u = __builtin_bit_cast(unsigned, f); return (u + 0x7fffu + ((u >> 16) & 1u)) >> 16; }
__device__ __forceinline__ unsigned pk2(float lo, float hi) { return f2bf(lo) | (f2bf(hi) << 16); }
__device__ __forceinline__ float bf2f(unsigned short b) { return __builtin_bit_cast(float, (unsigned)b << 16); }
__device__ __forceinline__ float bflo(unsigned w) { return __builtin_bit_cast(float, w << 16); }
__device__ __forceinline__ float bfhi(unsigned w) { return __builtin_bit_cast(float, w & 0xffff0000u); }
__device__ __forceinline__ float fsigmoid(float x) { return __builtin_amdgcn_rcpf(1.0f + __expf(-x)); }
__device__ __forceinline__ float wave_sum(float v) {
#pragma unroll
    for (int o = 1; o < 64; o <<= 1) v += __shfl_xor(v, o);
    return v;
}
__device__ __forceinline__ int modrow_of(int row) { return row < ML ? (row >> 11) : 16; }
#define XB_TMO      128
#define XB_XCNT(j)  (256  + 64 * (j))
#define XB_XSUB(j)  (1280 + 64 * (j))
#define XB_XGEN(j)  (2304 + 64 * (j))
#define XB_TOP      3328
#define XB_TOPGEN   3392
#define XCD_BAR_WORDS 3456
#define XB_SPIN_CAP (1u << 18)

__device__ __forceinline__ unsigned xb_ld(unsigned* p)              { return __hip_atomic_load(p, __ATOMIC_RELAXED, __HIP_MEMORY_SCOPE_AGENT); }
__device__ __forceinline__ unsigned xb_add(unsigned* p, unsigned v) { return __hip_atomic_fetch_add(p, v, __ATOMIC_RELAXED, __HIP_MEMORY_SCOPE_AGENT); }
__device__ __forceinline__ unsigned xb_xcc_id() { return (unsigned)__builtin_amdgcn_s_getreg((3 << 11) | 20) & 0xFu; }
#define XB_SPIN(cond, bar) do { unsigned _sp = 0; while (cond) { __builtin_amdgcn_s_sleep(1); \
    if ((++_sp & 255u) == 0u) { if (xb_ld(&(bar)[XB_TMO])) break; if (_sp > XB_SPIN_CAP) { atomicAdd(&(bar)[XB_TMO], 1u); break; } } } } while (0)

struct XcdBarrier {
    unsigned* bar; unsigned x;
    volatile LAS unsigned* st;
};

__device__ __forceinline__ XcdBarrier xcd_barrier_post(unsigned* bar, volatile LAS unsigned* st) {
    XcdBarrier b; b.bar = bar; b.x = xb_xcc_id(); b.st = st;
    if (threadIdx.x == 0) (void)xb_add(&bar[XB_XCNT(b.x)], 1u);
    return b;
}
__device__ __forceinline__ void xcd_barrier_complete(unsigned* bar, unsigned x, unsigned& nloc, unsigned& nx) {
    const unsigned G = gridDim.x * gridDim.y * gridDim.z;
    unsigned sum, cnt, mine, sp = 0u;
    for (;;) {
        sum = 0u; cnt = 0u; mine = 0u;
#pragma unroll
        for (unsigned j = 0; j < 16; ++j) { const unsigned c = xb_ld(&bar[XB_XCNT(j)]); sum += c; cnt += (c > 0u) ? 1u : 0u; mine = (j == x) ? c : mine; }
        if (sum == G) break;
        __builtin_amdgcn_s_sleep(1);
        if ((++sp & 255u) == 0u) { if (xb_ld(&bar[XB_TMO])) break; if (sp > XB_SPIN_CAP) { atomicAdd(&bar[XB_TMO], 1u); break; } }
    }
    nloc = mine > 0u ? mine : 1u; nx = cnt > 0u ? cnt : 1u;
}

__device__ __forceinline__ void xcd_barrier(const XcdBarrier& b) {
    asm volatile("s_waitcnt vmcnt(0)" ::: "memory");
    __syncthreads();
    if (threadIdx.x == 0) {
        unsigned* bar = b.bar;
        __builtin_amdgcn_s_waitcnt(0);
        unsigned nloc = b.st[0], nx = b.st[1];
        if (nloc == 0u) { xcd_barrier_complete(bar, b.x, nloc, nx); b.st[0] = nloc; b.st[1] = nx; }
        const unsigned old = xb_add(&bar[XB_XSUB(b.x)], 1u);
        const unsigned gen = old / nloc;
        if (old + 1u == (gen + 1u) * nloc) {
            __builtin_amdgcn_fence(__ATOMIC_RELEASE, "agent");
            asm volatile("s_waitcnt vmcnt(0)" ::: "memory");
            const unsigned og = xb_add(&bar[XB_TOP], 1u);
            const unsigned tg = og / nx;
            if (og + 1u == (tg + 1u) * nx) xb_add(&bar[XB_TOPGEN], 1u);
            else XB_SPIN(xb_ld(&bar[XB_TOPGEN]) == tg, bar);
            __builtin_amdgcn_fence(__ATOMIC_ACQUIRE, "agent");
            xb_add(&bar[XB_XGEN(b.x)], 1u);
            asm volatile("s_waitcnt vmcnt(0)" ::: "memory");
        } else {
            XB_SPIN(xb_ld(&bar[XB_XGEN(b.x)]) == gen, bar);
            __builtin_amdgcn_fence(__ATOMIC_ACQUIRE, "agent");
            asm volatile("s_waitcnt vmcnt(0)" ::: "memory");
        }
    }
    __syncthreads();
}

struct Args { const float* in[23]; float* out; unsigned char* ws; int ph_lo, ph_hi; };
enum { I_X = 0, I_C, I_CTX, I_CCTX, I_WMOD, I_BMOD, I_N1G, I_WIN, I_BIN, I_MG, I_SLG, I_SLB, I_SW, I_SB, I_CW, I_CB, I_CLG, I_CLB, I_WOUT, I_N2G, I_WGU, I_WDOWN, I_FG };

__device__ __forceinline__ int win_src_col(int n) {
    if (n < 2048) return n;
    if (n < 2560) return n + 16;
    if (n < 3072) { const int j = n - 2560, tile = j >> 8, jj = j & 255; return 2576 + (jj >> 7) * 256 + tile * 128 + (jj & 127); }
    if (n < 3088) return 2048 + (n - 3072);
    return -1;
}
__device__ __forceinline__ int wgu_src_col(int n) { const int tile = n >> 8, jj = n & 255; return (jj >> 7) * FF + tile * 128 + (jj & 127); }

__device__ __forceinline__ void transpose_item(const float* W, int K, int Nsrc, bf16* WT, int n0, int srcc0, int nvalid, int k0, LAS float* scr, int lane) {
    const int c = lane & 31;
#pragma unroll 8
    for (int i = 0; i < 32; ++i) { const int kk = 2 * i + (lane >> 5);
        float v = 0.f; if (srcc0 >= 0 && c < nvalid) v = W[(size_t)(k0 + kk) * Nsrc + srcc0 + c];
        scr[kk * 33 + c] = v; }
    LDS_WAIT(); asm volatile("" ::: "memory");
    const int c8 = lane & 7;
#pragma unroll
    for (int j = 0; j < 4; ++j) { const int n = (lane >> 3) + 8 * j; const LAS float* s = scr + (8 * c8) * 33 + n;
        v4u o; o.x = pk2(s[0 * 33], s[1 * 33]); o.y = pk2(s[2 * 33], s[3 * 33]); o.z = pk2(s[4 * 33], s[5 * 33]); o.w = pk2(s[6 * 33], s[7 * 33]);
        *(v4u*)(WT + (size_t)(n0 + n) * K + k0 + 8 * c8) = o; }
    LDS_WAIT(); asm volatile("" ::: "memory");
}

__device__ __forceinline__ void phase_prologue(const Args& a, LAS unsigned char* lds, int G, int tid, int lane, int wave) {
    unsigned char* ws = a.ws;
    LAS float* scr = (LAS float*)(lds + wave * 16384);
    const int gw = blockIdx.x * NWAVES + wave, NGW = G * NWAVES;
    constexpr int I_IN = 16 * (NIN / 32), I_OUT = 16 * 32, I_GU = 16 * (NGU / 32), I_DN = (FF / 64) * 32, I_LAYER = I_IN + I_OUT + I_GU + I_DN;
    for (int it = gw; it < 2 * I_LAYER; it += NGW) {
        const int l = it / I_LAYER; int r = it % I_LAYER;
        unsigned char* wl = ws + WS_W + (size_t)l * W_LAYER;
        if (r < I_IN) { const int kb = r / (NIN / 32), nb = r % (NIN / 32), n0 = nb * 32, sc = win_src_col(n0);
            transpose_item(a.in[I_WIN] + (size_t)l * D * NIN_O, D, NIN_O, (bf16*)(wl + WO_IN), n0, sc, n0 == 3072 ? 16 : 32, kb * 64, scr, lane); continue; }
        r -= I_IN;
        if (r < I_OUT) { const int kb = r / 32, nb = r % 32;
            transpose_item(a.in[I_WOUT] + (size_t)l * D * D, D, D, (bf16*)(wl + WO_OUT), nb * 32, nb * 32, 32, kb * 64, scr, lane); continue; }
        r -= I_OUT;
        if (r < I_GU) { const int kb = r / (NGU / 32), nb = r % (NGU / 32), n0 = nb * 32;
            transpose_item(a.in[I_WGU] + (size_t)l * D * NGU, D, NGU, (bf16*)(wl + WO_GU), n0, wgu_src_col(n0), 32, kb * 64, scr, lane); continue; }
        r -= I_GU;
        { const int kb = r / 32, nb = r % 32;
            transpose_item(a.in[I_WDOWN] + (size_t)l * FF * D, FF, D, (bf16*)(wl + WO_DOWN), nb * 32, nb * 32, 32, kb * 64, scr, lane); }
    }
    for (int e = blockIdx.x * NTHREADS + tid; e < 2 * NIN; e += G * NTHREADS) { const int l = e / NIN, n = e % NIN, s = win_src_col(n);
        ((float*)(ws + WS_BIN))[e] = s >= 0 ? a.in[I_BIN][l * NIN_O + s] : 0.f; }
    for (int e = blockIdx.x * NTHREADS + tid; e < 2 * 4 * 128 * 128; e += G * NTHREADS) ((bf16*)(ws + WS_SWB))[e] = (bf16)f2bf(a.in[I_SW][e]);
    __syncthreads();
    LAS float* sl = (LAS float*)lds;
    float* MOD = (float*)(ws + WS_MOD);
    for (int it = blockIdx.x; it < 2 * 12 * 16; it += G) {
        const int l = it / 192, jb = (it % 192) / 16, ks = it % 16;
        for (int e = tid; e < 17 * 64; e += NTHREADS) { const int r = e >> 6, k = e & 63; const float cv = r < 16 ? a.in[I_C][r * D + ks * 64 + k] : a.in[I_CCTX][ks * 64 + k]; sl[e] = cv * fsigmoid(cv); }
        __syncthreads();
        const int j = jb * 512 + tid;
        float acc[17];
#pragma unroll
        for (int r = 0; r < 17; ++r) acc[r] = 0.f;
        const float* wp = a.in[I_WMOD] + (size_t)l * D * MODW + (size_t)(ks * 64) * MODW + j;
#pragma unroll 4
        for (int k = 0; k < 64; ++k) { const float w = wp[(size_t)k * MODW];
#pragma unroll
            for (int r = 0; r < 17; ++r) acc[r] += sl[r * 64 + k] * w; }
        const float bm = ks == 0 ? a.in[I_BMOD][l * MODW + j] : 0.f;
#pragma unroll
        for (int r = 0; r < 17; ++r) atomicAdd(MOD + (size_t)(l * 17 + r) * MODW + j, acc[r] + bm);
        __syncthreads();
    }
}

__device__ __forceinline__ void phase_norm(const float* xl, const float* xc, bf16* A, const float* g, const float* mod, int sh_off, int nrows, int G, int lane, int wave) {
    const int gw = blockIdx.x * NWAVES + wave, NGW = G * NWAVES;
    for (int r = gw; r < nrows; r += NGW) {
        const float* xr = r < ML ? xl + (size_t)r * D : xc + (size_t)(r - ML) * D;
        const float* mr = mod + (size_t)modrow_of(r) * MODW + sh_off;
        f32x4 v[4]; float s = 0.f;
#pragma unroll
        for (int j = 0; j < 4; ++j) { v[j] = ((const f32x4*)xr)[lane + 64 * j]; s += (v[j].x * v[j].x + v[j].y * v[j].y) + (v[j].z * v[j].z + v[j].w * v[j].w); }
        const float rstd = 1.0f / sqrtf(wave_sum(s) * (1.0f / D) + EPS);
        unsigned long long* o8 = (unsigned long long*)(A + (size_t)r * D) + lane;
#pragma unroll
        for (int j = 0; j < 4; ++j) { const int c = (lane + 64 * j) * 4;
            const f32x4 gg = *(const f32x4*)(g + c), sh = *(const f32x4*)(mr + c), sc = *(const f32x4*)(mr + D + c);
            const f32x4 y = v[j] * rstd * gg * (1.0f + sc) + sh;
            o8[64 * j] = (unsigned long long)pk2(y.x, y.y) | ((unsigned long long)pk2(y.z, y.w) << 32); }
    }
}

__device__ __forceinline__ void phase_final(float* x, const float* g, int G, int lane, int wave) {
    const int gw = blockIdx.x * NWAVES + wave, NGW = G * NWAVES;
    for (int r = gw; r < ML; r += NGW) {
        float* xr = x + (size_t)r * D;
        f32x4 v[4]; float s = 0.f;
#pragma unroll
        for (int j = 0; j < 4; ++j) { v[j] = ((const f32x4*)xr)[lane + 64 * j]; s += (v[j].x * v[j].x + v[j].y * v[j].y) + (v[j].z * v[j].z + v[j].w * v[j].w); }
        const float rstd = 1.0f / sqrtf(wave_sum(s) * (1.0f / D) + EPS);
#pragma unroll
        for (int j = 0; j < 4; ++j) { const f32x4 gg = ((const f32x4*)g)[lane + 64 * j]; ((f32x4*)xr)[lane + 64 * j] = v[j] * rstd * gg; }
    }
}

constexpr int TB = 16;
__device__ __forceinline__ void mlstm_scan_item(const bf16* Q, const bf16* K, const bf16* V, const float* GT, float* HS0, float* HS1, int item, bool ctx_out, LAS unsigned char* lds, int tid) {
    const int b = item >> 3, h = (item >> 1) & 3, dir = item & 1;
    const int dv = tid & 127, kq = tid >> 7;
    LAS float* kbuf = (LAS float*)lds;
    LAS float* vbuf = kbuf + TB * 128;
    LAS float* qbuf = vbuf + TB * 128;
    LAS float* ibuf = qbuf + TB * 128;
    LAS float* fbuf = ibuf + TB;
    LAS float* red = fbuf + TB;
    LAS float* redd = red + 2 * 4 * 128;
    float* HS = dir ? HS1 : HS0;
    float C[32], nn[32];
#pragma unroll
    for (int j = 0; j < 32; ++j) { C[j] = 0.f; nn[j] = 0.f; }
    float m = 0.f; int par = 0;
    for (int s0 = 0; s0 < CTXL + SEQ; s0 += TB) {
        const bool isctx = s0 < CTXL; const int len = isctx ? CTXL : SEQ, i0 = isctx ? s0 : s0 - CTXL;
        const int rbase = isctx ? ML + b * CTXL : b * SEQ;
        for (int e = tid; e < TB * 384; e += NTHREADS) { const int tok = e / 384, c = e % 384, which = c >> 7, d = c & 127;
            const int t = dir ? (len - 1 - (i0 + tok)) : (i0 + tok); const size_t off = (size_t)(rbase + t) * HW + h * 128 + d;
            const bf16* src = which == 0 ? K : which == 1 ? V : Q;
            (which == 0 ? kbuf : which == 1 ? vbuf : qbuf)[tok * 128 + d] = bf2f(src[off]); }
        if (tid < TB) { const int t = dir ? (len - 1 - (i0 + tid)) : (i0 + tid); const float* gp = GT + (size_t)(rbase + t) * 16 + dir * 8 + h;
            const float iv = gp[0], fv = gp[4];
            ibuf[tid] = iv; fbuf[tid] = fminf(fv, 0.f) - log1pf(__expf(-fabsf(fv))); }
        __syncthreads();
        const bool wr_out = !isctx || ctx_out;
        for (int tok = 0; tok < TB; ++tok) {
            const float it = ibuf[tok], lf = fbuf[tok];
            const float mn = fmaxf(lf + m, it), aa = __expf(lf + m - mn), bc = __expf(it - mn); m = mn;
            const float vv = vbuf[tok * 128 + dv] * bc;
            float part = 0.f, dpart = 0.f;
            const LAS float* kp = kbuf + tok * 128 + kq * 32; const LAS float* qp = qbuf + tok * 128 + kq * 32;
#pragma unroll
            for (int j = 0; j < 32; ++j) { const float kk = kp[j], qq = qp[j];
                C[j] = aa * C[j] + kk * vv; part += C[j] * qq;
                nn[j] = aa * nn[j] + bc * kk; dpart += nn[j] * qq; }
            red[(par * 4 + kq) * 128 + dv] = part; if (dv == 0) redd[par * 4 + kq] = dpart;
            __syncthreads();
            if (tid < 128 && wr_out) {
                const float num = (red[(par * 4 + 0) * 128 + tid] + red[(par * 4 + 1) * 128 + tid]) + (red[(par * 4 + 2) * 128 + tid] + red[(par * 4 + 3) * 128 + tid]);
                const float den = (redd[par * 4 + 0] + redd[par * 4 + 1]) + (redd[par * 4 + 2] + redd[par * 4 + 3]);
                const int t = dir ? (len - 1 - (i0 + tok)) : (i0 + tok);
                HS[(size_t)(rbase + t) * HW + h * 128 + tid] = num / fmaxf(fabsf(den), __expf(-m));
            }
            par ^= 1;
        }
    }
    __syncthreads();
}

__device__ __forceinline__ void phase_mlstm_post(const float* HS0, const float* HS1, const bf16* OG, const float* mg, bf16* Y, int nrows, int G, int lane, int wave) {
    const int gw = blockIdx.x * NWAVES + wave, NGW = G * NWAVES;
    for (int r = gw; r < nrows; r += NGW) {
        const size_t off = (size_t)r * HW + lane * 8;
        const f32x4 a0 = *(const f32x4*)(HS0 + off), a1 = *(const f32x4*)(HS0 + off + 4), b0 = *(const f32x4*)(HS1 + off), b1 = *(const f32x4*)(HS1 + off + 4);
        const f32x4 h0 = a0 + b0, h1 = a1 + b1;
        float s = (h0.x * h0.x + h0.y * h0.y) + (h0.z * h0.z + h0.w * h0.w) + (h1.x * h1.x + h1.y * h1.y) + (h1.z * h1.z + h1.w * h1.w);
        s += __shfl_xor(s, 1); s += __shfl_xor(s, 2); s += __shfl_xor(s, 4); s += __shfl_xor(s, 8);
        const float rs = 1.0f / sqrtf(s * (1.0f / 128.0f) + EPS);
        const v4u og = *(const v4u*)(OG + off);
        const f32x4 g0 = *(const f32x4*)(mg + lane * 8), g1 = *(const f32x4*)(mg + lane * 8 + 4);
        v4u o;
        o.x = pk2(h0.x * rs * g0.x * bflo(og.x), h0.y * rs * g0.y * bfhi(og.x)); o.y = pk2(h0.z * rs * g0.z * bflo(og.y), h0.w * rs * g0.w * bfhi(og.y));
        o.z = pk2(h1.x * rs * g1.x * bflo(og.z), h1.y * rs * g1.y * bfhi(og.z)); o.w = pk2(h1.z * rs * g1.z * bflo(og.w), h1.w * rs * g1.w * bfhi(og.w));
        *(v4u*)(Y + (size_t)r * D + lane * 8) = o;
    }
}

__device__ __forceinline__ void sgu_item(const bf16* Z, const float* lg, const float* lb, const float* sw, const float* sb, bf16* Y, int chunk, LAS unsigned char* lds, int tid, int lane, int wave) {
    LAS float* vn = (LAS float*)lds;
    const int row0 = chunk * 128;
    for (int t = wave; t < 128; t += NWAVES) {
        const v2u raw = *(const v2u*)(Z + (size_t)(row0 + t) * 512 + 256 + lane * 4);
        const float x0 = bflo(raw.x), x1 = bfhi(raw.x), x2 = bflo(raw.y), x3 = bfhi(raw.y);
        const float mu = wave_sum((x0 + x1) + (x2 + x3)) * (1.0f / 256.0f);
        const float d0 = x0 - mu, d1 = x1 - mu, d2 = x2 - mu, d3 = x3 - mu;
        const float var = wave_sum((d0 * d0 + d1 * d1) + (d2 * d2 + d3 * d3)) * (1.0f / 256.0f);
        const float rs = 1.0f / sqrtf(var + EPS);
        const f32x4 g = *(const f32x4*)(lg + lane * 4), bb = *(const f32x4*)(lb + lane * 4);
        *(LAS f32x4*)(vn + t * 256 + lane * 4) = (f32x4){d0 * rs * g.x + bb.x, d1 * rs * g.y + bb.y, d2 * rs * g.z + bb.z, d3 * rs * g.w + bb.w};
    }
    __syncthreads();
    const int ch = tid & 255, ph = tid >> 8, g = __builtin_amdgcn_readfirstlane(ch >> 6);
    const float* wg = sw + (size_t)g * 128 * 128; const float* bg = sb + g * 128;
    for (int p = ph * 64; p < ph * 64 + 64; ++p) {
        const float* wr = wg + p * 128; float acc = 0.f;
#pragma unroll 8
        for (int q = 0; q < 128; ++q) acc += wr[q] * vn[q * 256 + ch];
        const float u = bf2f(Z[(size_t)(row0 + p) * 512 + ch]);
        Y[(size_t)(row0 + p) * D + 512 + ch] = (bf16)f2bf(u * (acc + bg[p]));
    }
    __syncthreads();
}

__device__ __forceinline__ void conv_rows(const bf16* YC, const float* cw, const float* cb, const float* lg, const float* lb, bf16* Y, int row0, int nrows, int lane, int wave) {
    const int c0 = lane * 4;
    for (int rr = wave; rr < nrows; rr += NWAVES) {
        const int r = row0 + rr;
        f32x4 acc = *(const f32x4*)(cb + c0);
        int base, pos, len, stride;
        if (r < ML) { const int b = r >> 11, t = r & 2047;
            if (lane < 32) { base = (b << 11) + (t & ~63); pos = t & 63; len = 64; stride = 1; }
            else           { base = (b << 11) + (t & 63); pos = t >> 6; len = 32; stride = 64; } }
        else { const int rc = r - ML; base = ML + (rc & ~255); pos = rc & 255; len = 256; stride = 1; }
#pragma unroll 1
        for (int k = 0; k < 31; ++k) { const int p = pos + k - 15;
            if (p >= 0 && p < len) { const v2u raw = *(const v2u*)(YC + (size_t)(base + p * stride) * 256 + c0); const f32x4 w = *(const f32x4*)(cw + k * 256 + c0);
                acc.x += w.x * bflo(raw.x); acc.y += w.y * bfhi(raw.x); acc.z += w.z * bflo(raw.y); acc.w += w.w * bfhi(raw.y); } }
        const float mu = wave_sum((acc.x + acc.y) + (acc.z + acc.w)) * (1.0f / 256.0f);
        const float d0 = acc.x - mu, d1 = acc.y - mu, d2 = acc.z - mu, d3 = acc.w - mu;
        const float var = wave_sum((d0 * d0 + d1 * d1) + (d2 * d2 + d3 * d3)) * (1.0f / 256.0f);
        const float rs = 1.0f / sqrtf(var + EPS);
        const f32x4 g = *(const f32x4*)(lg + c0), bb = *(const f32x4*)(lb + c0);
        float y0 = d0 * rs * g.x + bb.x, y1 = d1 * rs * g.y + bb.y, y2 = d2 * rs * g.z + bb.z, y3 = d3 * rs * g.w + bb.w;
        y0 *= fsigmoid(y0); y1 *= fsigmoid(y1); y2 *= fsigmoid(y2); y3 *= fsigmoid(y3);
        v2u o; o.x = pk2(y0, y1); o.y = pk2(y2, y3);
        *(v2u*)(Y + (size_t)r * D + 768 + c0) = o;
    }
}
typedef short bf16x8_t __attribute__((ext_vector_type(8)));
typedef short s16x4_t __attribute__((ext_vector_type(4)));
typedef short v4i16_t __attribute__((ext_vector_type(4)));
typedef float f32x16 __attribute__((ext_vector_type(16)));
typedef __bf16 bf16x2_t __attribute__((ext_vector_type(2)));
__device__ __forceinline__ unsigned cvtpk(float lo, float hi) { f32x2 v = {lo, hi}; bf16x2_t b = __builtin_convertvector(v, bf16x2_t); return __builtin_bit_cast(unsigned, b); }
__device__ __forceinline__ s16x4_t tr16(const LAS unsigned char* p) { return __builtin_bit_cast(s16x4_t, __builtin_amdgcn_ds_read_tr16_b64_v4i16((LAS v4i16_t*)p)); }
__device__ __forceinline__ bf16x8_t cat8(s16x4_t lo, s16x4_t hi) { return __builtin_shufflevector(lo, hi, 0, 1, 2, 3, 4, 5, 6, 7); }
#define MFMA32(a, b, c) __builtin_amdgcn_mfma_f32_32x32x16_bf16((a), (b), (c), 0, 0, 0)
__device__ __forceinline__ int crow(int reg, int hh) { return (reg & 3) + 8 * (reg >> 2) + 4 * hh; }
__device__ __forceinline__ int chunk_row0(int b, int a) { return a < 2 ? ML + b * CTXL + a * 128 : b * SEQ + (a - 2) * 128; }
__device__ __forceinline__ int chunk_of_step(int j, int dir) { return dir == 0 ? j : (j == 0 ? 1 : (j == 1 ? 0 : 19 - j)); }
__device__ __forceinline__ float log_sigmoid(float x) { return fminf(x, 0.f) - log1pf(__expf(-fabsf(x))); }
__device__ __forceinline__ float lane_get(float x, int src_lane) { return __builtin_bit_cast(float, __builtin_amdgcn_ds_bpermute(src_lane << 2, __builtin_bit_cast(int, x))); }
__device__ __forceinline__ float wave_incl_add(float x, int lane) {
#pragma unroll
    for (int o = 1; o < 64; o <<= 1) { const float y = lane_get(x, lane - o); if (lane >= o) x += y; }
    return x;
}
__device__ __forceinline__ float wave_incl_max(float x, int lane) {
#pragma unroll
    for (int o = 1; o < 64; o <<= 1) { const float y = lane_get(x, lane - o); if (lane >= o) x = fmaxf(x, y); }
    return x;
}
__device__ __forceinline__ float wave_max(float v, int lane) {
#pragma unroll
    for (int o = 1; o < 64; o <<= 1) v = fmaxf(v, lane_get(v, lane ^ o));
    return v;
}
__device__ __forceinline__ v4u scale8(const v4u& w, float s) {
    v4u o; o.x = cvtpk(bflo(w.x) * s, bfhi(w.x) * s); o.y = cvtpk(bflo(w.y) * s, bfhi(w.y) * s); o.z = cvtpk(bflo(w.z) * s, bfhi(w.z) * s); o.w = cvtpk(bflo(w.w) * s, bfhi(w.w) * s); return o;
}
constexpr int MX_OFF = RING_BYTES + 1024;

__device__ __forceinline__ void mlstm_state_item(const bf16* K, const bf16* V, const float* GT, bf16* CT, float* NS, float* MP, int item, bool store_ctx, LAS unsigned char* lds, int tid) {
    asm volatile("" : "+v"(tid));
    const int lane = tid & 63, wave = __builtin_amdgcn_readfirstlane(tid >> 6);
    const int dvh = item & 1, dir = (item >> 1) & 1, h = (item >> 2) & 3, b = item >> 4;
    const int seq = (b * 4 + h) * 2 + dir;
    LAS unsigned char* Kimg = lds;
    LAS unsigned char* Vimg = lds + 65536;
    LAS float* kap = (LAS float*)(lds + 98304);
    LAS float* gb = kap + 2304;
    LAS float* ib = gb + 2304;
    LAS float* cs = ib + 2304;
    for (int e = tid; e < 2304; e += NTHREADS) { const int j = e >> 7, tau = e & 127, a = chunk_of_step(j, dir), t = dir ? 127 - tau : tau;
        const float* gp = GT + (size_t)(chunk_row0(b, a) + t) * 16 + dir * 8 + h; ib[e] = gp[0]; gb[e] = log_sigmoid(gp[4]); }
    __syncthreads();
    for (int j = wave; j < 18; j += NWAVES) {
        const float x0 = gb[j * 128 + 2 * lane], x1 = gb[j * 128 + 2 * lane + 1];
        const float sc = wave_incl_add(x0 + x1, lane);
        const float g0 = ib[j * 128 + 2 * lane] - (sc - x1), g1 = ib[j * 128 + 2 * lane + 1] - sc;
        gb[j * 128 + 2 * lane] = g0; gb[j * 128 + 2 * lane + 1] = g1;
        const float pm = wave_max(fmaxf(g0, g1), lane); const float bl = lane_get(sc, 63);
        if (lane == 0) { cs[j] = bl; cs[32 + j] = pm; }
    }
    __syncthreads();
    if (tid < 18) { float m = 0.f, mp = 0.f, Ml = 0.f;
        for (int j = 0; j <= tid; ++j) { mp = m; Ml = fmaxf(m, cs[32 + j]); m = cs[j] + Ml; }
        cs[64 + tid] = __expf(mp - Ml); cs[96 + tid] = Ml;
        if (dvh == 0) MP[seq * 18 + chunk_of_step(tid, dir)] = mp; }
    __syncthreads();
    for (int e = tid; e < 2304; e += NTHREADS) kap[e] = __expf(gb[e] - cs[96 + (e >> 7)]);
    __syncthreads();

    const int r = lane & 31, hh = lane >> 5, i16 = lane & 15, q = i16 >> 2, p = i16 & 3, blk = (lane >> 4) & 1;
    const int dkt = wave & 3, dvt = wave >> 2;
    f32x16 acc;
#pragma unroll
    for (int i = 0; i < 16; ++i) acc[i] = 0.f;
    float nn = 0.f;
    v4u kreg[4], vreg[2];
    { const int row0 = chunk_row0(b, chunk_of_step(0, dir));
#pragma unroll
        for (int i = 0; i < 4; ++i) { const int pc = tid + NTHREADS * i; kreg[i] = *(const v4u*)(K + (size_t)(row0 + (pc >> 4)) * HW + h * 128 + (pc & 15) * 8); }
#pragma unroll
        for (int i = 0; i < 2; ++i) { const int pc = tid + NTHREADS * i; vreg[i] = *(const v4u*)(V + (size_t)(row0 + (pc >> 3)) * HW + h * 128 + dvh * 64 + (pc & 7) * 8); }
#pragma unroll
        for (int i = 0; i < 4; ++i) { const int pc = tid + NTHREADS * i; *(LAS v4u*)(Kimg + pc * 16) = kreg[i]; }
#pragma unroll
        for (int i = 0; i < 2; ++i) { const int pc = tid + NTHREADS * i, s = pc >> 3; *(LAS v4u*)(Vimg + pc * 16) = scale8(vreg[i], kap[dir ? 127 - s : s]); }
    }
#pragma unroll 1
    for (int j = 0; j < 18; ++j) {
        __syncthreads();
        const int a = chunk_of_step(j, dir);
        if (j + 1 < 18) { const int row0 = chunk_row0(b, chunk_of_step(j + 1, dir));
#pragma unroll
            for (int i = 0; i < 4; ++i) { const int pc = tid + NTHREADS * i; kreg[i] = *(const v4u*)(K + (size_t)(row0 + (pc >> 4)) * HW + h * 128 + (pc & 15) * 8); }
#pragma unroll
            for (int i = 0; i < 2; ++i) { const int pc = tid + NTHREADS * i; vreg[i] = *(const v4u*)(V + (size_t)(row0 + (pc >> 3)) * HW + h * 128 + dvh * 64 + (pc & 7) * 8); } }
        if (a >= 2 || store_ctx) {
            bf16* cp = CT + ((size_t)(seq * 18 + a) * 128 + dvh * 64 + dvt * 32 + r) * 128 + dkt * 32 + 4 * hh;
#pragma unroll
            for (int g = 0; g < 4; ++g) { v2u o; o.x = cvtpk(acc[4 * g], acc[4 * g + 1]); o.y = cvtpk(acc[4 * g + 2], acc[4 * g + 3]); *(v2u*)(cp + 8 * g) = o; }
            if (dvh == 0 && tid < 128) NS[(size_t)(seq * 18 + a) * 128 + tid] = nn;
        }
        const float delta = cs[64 + j];
#pragma unroll
        for (int i = 0; i < 16; ++i) acc[i] *= delta;
        const LAS unsigned char* Kb = Kimg + (j & 1) * 32768; const LAS unsigned char* Vb = Vimg + (j & 1) * 16384;
#pragma unroll
        for (int ks = 0; ks < 8; ++ks) {
            const LAS unsigned char* ka = Kb + (16 * ks + 8 * hh + q) * 256 + 2 * (32 * dkt + 16 * blk + 4 * p);
            const LAS unsigned char* va = Vb + (16 * ks + 8 * hh + q) * 128 + 2 * (32 * dvt + 16 * blk + 4 * p);
            const bf16x8_t A = cat8(tr16(ka), tr16(ka + 4 * 256)), B = cat8(tr16(va), tr16(va + 4 * 128));
            acc = MFMA32(A, B, acc);
        }
        if (dvh == 0 && tid < 128) { float s = 0.f;
#pragma unroll 8
            for (int t = 0; t < 128; ++t) s += kap[j * 128 + (dir ? 127 - t : t)] * bf2f(*(const LAS unsigned short*)(Kb + t * 256 + tid * 2));
            nn = delta * nn + s; }
        if (j + 1 < 18) { LAS unsigned char* Kn = Kimg + ((j + 1) & 1) * 32768; LAS unsigned char* Vn = Vimg + ((j + 1) & 1) * 16384;
#pragma unroll
            for (int i = 0; i < 4; ++i) { const int pc = tid + NTHREADS * i; *(LAS v4u*)(Kn + pc * 16) = kreg[i]; }
#pragma unroll
            for (int i = 0; i < 2; ++i) { const int pc = tid + NTHREADS * i, s = pc >> 3; *(LAS v4u*)(Vn + pc * 16) = scale8(vreg[i], kap[(j + 1) * 128 + (dir ? 127 - s : s)]); } }
    }
    __syncthreads();
}

template <int TB>
__device__ __forceinline__ void mlstm_weights(const f32x16 (&S)[4], bf16x8_t (&pb)[4][2], const LAS float* GA, int t, int hh, int lane, float qnf, float qnb, float& sff, float& sfb) {
    const float Mf = GA[128 + t], Mb = GA[512 + 128 + t];
    float rsf = 0.f, rsb = 0.f;
#pragma unroll
    for (int st = 0; st < 4; ++st) {
#pragma unroll
        for (int g = 0; g < 4; ++g) {
            const int s0 = 32 * st + 8 * g + 4 * hh;
            if (st < TB) { const f32x4 gv = *(const LAS f32x4*)(GA + s0);
#pragma unroll
                for (int e = 0; e < 4; ++e) rsf += S[st][4 * g + e] * __expf(gv[e] - Mf);
            } else if (st > TB) { const f32x4 gv = *(const LAS f32x4*)(GA + 512 + s0);
#pragma unroll
                for (int e = 0; e < 4; ++e) rsb += S[st][4 * g + e] * __expf(gv[e] - Mb);
            } else { const f32x4 gf = *(const LAS f32x4*)(GA + s0), gbv = *(const LAS f32x4*)(GA + 512 + s0);
#pragma unroll
                for (int e = 0; e < 4; ++e) { const float dts = (float)(t - (s0 + e));
                    const float wf = __expf(gf[e] - Mf + fminf(dts, 0.f) * 1e30f), wb = __expf(gbv[e] - Mb - fmaxf(dts, 0.f) * 1e30f);
                    rsf += S[st][4 * g + e] * wf; rsb += S[st][4 * g + e] * wb; }
            }
        }
        __builtin_amdgcn_sched_barrier(0);
    }
    rsf += lane_get(rsf, lane ^ 32); rsb += lane_get(rsb, lane ^ 32);
    const float alf = GA[256 + t], alb = GA[512 + 256 + t];
    const float invf = 1.0f / fmaxf(fabsf(alf * qnf + rsf), GA[384 + t]), invb = 1.0f / fmaxf(fabsf(alb * qnb + rsb), GA[512 + 384 + t]);
    sff = alf * invf; sfb = alb * invb;
    __builtin_amdgcn_sched_barrier(0);
    float Mf2 = Mf, Mb2 = Mb; asm volatile("" : "+v"(Mf2), "+v"(Mb2));
#pragma unroll
    for (int st = 0; st < 4; ++st) {
        float pv[16];
#pragma unroll
        for (int g = 0; g < 4; ++g) {
            const int s0 = 32 * st + 8 * g + 4 * hh;
            if (st < TB) { const f32x4 gv = *(const LAS f32x4*)(GA + s0);
#pragma unroll
                for (int e = 0; e < 4; ++e) pv[4 * g + e] = S[st][4 * g + e] * (__expf(gv[e] - Mf2) * invf);
            } else if (st > TB) { const f32x4 gv = *(const LAS f32x4*)(GA + 512 + s0);
#pragma unroll
                for (int e = 0; e < 4; ++e) pv[4 * g + e] = S[st][4 * g + e] * (__expf(gv[e] - Mb2) * invb);
            } else { const f32x4 gf = *(const LAS f32x4*)(GA + s0), gbv = *(const LAS f32x4*)(GA + 512 + s0);
#pragma unroll
                for (int e = 0; e < 4; ++e) { const float dts = (float)(t - (s0 + e));
                    const float wf = __expf(gf[e] - Mf2 + fminf(dts, 0.f) * 1e30f), wb = __expf(gbv[e] - Mb2 - fmaxf(dts, 0.f) * 1e30f);
                    pv[4 * g + e] = S[st][4 * g + e] * (wf * invf + wb * invb); }
            }
        }
#pragma unroll
        for (int sp = 0; sp < 2; ++sp) { v4u w; w.x = cvtpk(pv[8 * sp], pv[8 * sp + 1]); w.y = cvtpk(pv[8 * sp + 2], pv[8 * sp + 3]); w.z = cvtpk(pv[8 * sp + 4], pv[8 * sp + 5]); w.w = cvtpk(pv[8 * sp + 6], pv[8 * sp + 7]);
            pb[st][sp] = __builtin_bit_cast(bf16x8_t, w); }
        __builtin_amdgcn_sched_barrier(0);
    }
}

__device__ __forceinline__ void mlstm_out_item(const bf16* Q, const bf16* K, const bf16* V, const bf16* OG, const float* GT, const bf16* CT, const float* NS, const float* MP,
                                               const float* mg, bf16* Y, int b, int h, int a, LAS unsigned char* lds, int tid) {
    asm volatile("" : "+v"(tid));
    const int lane = tid & 63, wave = __builtin_amdgcn_readfirstlane(tid >> 6);
    const int row0 = chunk_row0(b, a);
    const int seqf = (b * 4 + h) * 2, seqb = seqf + 1;
    LAS unsigned char* Kimg = lds; LAS unsigned char* Vimg = lds + 32768; LAS unsigned char* Cf = lds + 65536; LAS unsigned char* Cb = lds + 98304;
    LAS float* GA = (LAS float*)(lds + MX_OFF);
    LAS float* NSL = GA + 1024;
    LAS float* SSQ = NSL + 256;
    const int r = lane & 31, hh = lane >> 5, i16 = lane & 15, q = i16 >> 2, p = i16 & 3, blk = (lane >> 4) & 1;
    const int tb = wave & 3, dh = wave >> 2;
    const int t = 32 * tb + r;
    {
        v4u kr[4], vr[4];
#pragma unroll
        for (int i = 0; i < 4; ++i) { const int pc = tid + NTHREADS * i; const size_t go = (size_t)(row0 + (pc >> 4)) * HW + h * 128 + (pc & 15) * 8; kr[i] = *(const v4u*)(K + go); vr[i] = *(const v4u*)(V + go); }
#pragma unroll
        for (int i = 0; i < 4; ++i) { const int pc = tid + NTHREADS * i; *(LAS v4u*)(Kimg + pc * 16) = kr[i]; *(LAS v4u*)(Vimg + pc * 16) = vr[i]; }
    }
    __builtin_amdgcn_sched_barrier(0);
    {
        v4u fr_[4], br_[4];
        const bf16* cfp = CT + (size_t)(seqf * 18 + a) * 16384; const bf16* cbp = CT + (size_t)(seqb * 18 + a) * 16384;
#pragma unroll
        for (int i = 0; i < 4; ++i) { const int pc = tid + NTHREADS * i; fr_[i] = *(const v4u*)(cfp + pc * 8); br_[i] = *(const v4u*)(cbp + pc * 8); }
#pragma unroll
        for (int i = 0; i < 4; ++i) { const int pc = tid + NTHREADS * i; *(LAS v4u*)(Cf + pc * 16) = fr_[i]; *(LAS v4u*)(Cb + pc * 16) = br_[i]; }
    }
    __builtin_amdgcn_sched_barrier(0);
    bf16x8_t qf[8];
#pragma unroll
    for (int ks = 0; ks < 8; ++ks) qf[ks] = *(const bf16x8_t*)(Q + (size_t)(row0 + t) * HW + h * 128 + 16 * ks + 8 * hh);
    if (wave < 2) {
        const int dir = wave; const float mprev = MP[(dir ? seqb : seqf) * 18 + a];
        const int t0 = dir ? 127 - 2 * lane : 2 * lane, t1 = dir ? 126 - 2 * lane : 2 * lane + 1;
        const float* g0p = GT + (size_t)(row0 + t0) * 16 + dir * 8 + h; const float* g1p = GT + (size_t)(row0 + t1) * 16 + dir * 8 + h;
        const float i0 = g0p[0], i1 = g1p[0], x0 = log_sigmoid(g0p[4]), x1 = log_sigmoid(g1p[4]);
        const float sc = wave_incl_add(x0 + x1, lane);
        const float b0 = sc - x1, b1 = sc, g0 = i0 - b0, g1 = i1 - b1;
        const float ip = wave_incl_max(fmaxf(g0, g1), lane);
        float ex = lane_get(ip, lane - 1); if (lane == 0) ex = -INFINITY;
        const float pm0 = fmaxf(ex, g0), pm1 = ip;
        const float M0 = fmaxf(mprev, pm0), M1 = fmaxf(mprev, pm1);
        LAS float* ga = GA + dir * 512;
        ga[t0] = g0; ga[128 + t0] = M0; ga[256 + t0] = __expf(mprev - M0); ga[384 + t0] = __expf(-(b0 + M0));
        ga[t1] = g1; ga[128 + t1] = M1; ga[256 + t1] = __expf(mprev - M1); ga[384 + t1] = __expf(-(b1 + M1));
    } else if (wave < 6) {
        const int e = tid - 128;
        NSL[e] = NS[(size_t)(((e >> 7) ? seqb : seqf) * 18 + a) * 128 + (e & 127)];
    }
    __syncthreads();
    f32x16 S[4];
#pragma unroll
    for (int st = 0; st < 4; ++st)
#pragma unroll
        for (int i = 0; i < 16; ++i) S[st][i] = 0.f;
#pragma unroll
    for (int ks = 0; ks < 8; ++ks) {
#pragma unroll
        for (int st = 0; st < 4; ++st) { const bf16x8_t A = *(const LAS bf16x8_t*)(Kimg + (32 * st + r) * 256 + 2 * (16 * ks + 8 * hh)); S[st] = MFMA32(A, qf[ks], S[st]); }
        __builtin_amdgcn_sched_barrier(0); }
    __builtin_amdgcn_sched_barrier(0);
    float qnf = 0.f, qnb = 0.f;
#pragma unroll
    for (int ks = 0; ks < 8; ++ks)
#pragma unroll
        for (int j = 0; j < 8; ++j) { const float qv = bf2f((unsigned short)qf[ks][j]); const int dk = 16 * ks + 8 * hh + j; qnf += qv * NSL[dk]; qnb += qv * NSL[128 + dk]; }
    qnf += lane_get(qnf, lane ^ 32); qnb += lane_get(qnb, lane ^ 32);
    bf16x8_t pb[4][2];
    float sff, sfb;
    switch (tb) {
        case 0: mlstm_weights<0>(S, pb, GA, t, hh, lane, qnf, qnb, sff, sfb); break;
        case 1: mlstm_weights<1>(S, pb, GA, t, hh, lane, qnf, qnb, sff, sfb); break;
        case 2: mlstm_weights<2>(S, pb, GA, t, hh, lane, qnf, qnb, sff, sfb); break;
        default: mlstm_weights<3>(S, pb, GA, t, hh, lane, qnf, qnb, sff, sfb); break;
    }
    __builtin_amdgcn_sched_barrier(0);
    bf16x8_t qf2[8];
#pragma unroll
    for (int ks = 0; ks < 8; ++ks) qf2[ks] = *(const bf16x8_t*)(Q + (size_t)(row0 + t) * HW + h * 128 + 16 * ks + 8 * hh);
    __builtin_amdgcn_sched_barrier(0);
    f32x16 Hc[2];
#pragma unroll
    for (int d = 0; d < 2; ++d)
#pragma unroll
        for (int i = 0; i < 16; ++i) Hc[d][i] = 0.f;
#pragma unroll
    for (int d = 0; d < 2; ++d) { const int dvt = 2 * dh + d;
#pragma unroll
        for (int st = 0; st < 4; ++st)
#pragma unroll
            for (int sp = 0; sp < 2; ++sp) { const LAS unsigned char* va = Vimg + (32 * st + 16 * sp + 4 * hh + q) * 256 + 2 * (32 * dvt + 16 * blk + 4 * p);
                const bf16x8_t A = cat8(tr16(va), tr16(va + 8 * 256)); Hc[d] = MFMA32(A, pb[st][sp], Hc[d]); if (sp) __builtin_amdgcn_sched_barrier(0); } }
#pragma unroll
    for (int dd = 0; dd < 2; ++dd) {
        const float sfac = dd ? sfb : sff; const LAS unsigned char* Cimg = dd ? Cb : Cf;
        bf16x8_t qs[8];
#pragma unroll
        for (int ks = 0; ks < 8; ++ks) { v4u w;
            w.x = cvtpk(bf2f((unsigned short)qf2[ks][0]) * sfac, bf2f((unsigned short)qf2[ks][1]) * sfac); w.y = cvtpk(bf2f((unsigned short)qf2[ks][2]) * sfac, bf2f((unsigned short)qf2[ks][3]) * sfac);
            w.z = cvtpk(bf2f((unsigned short)qf2[ks][4]) * sfac, bf2f((unsigned short)qf2[ks][5]) * sfac); w.w = cvtpk(bf2f((unsigned short)qf2[ks][6]) * sfac, bf2f((unsigned short)qf2[ks][7]) * sfac);
            qs[ks] = __builtin_bit_cast(bf16x8_t, w); }
#pragma unroll
        for (int d = 0; d < 2; ++d) { const int dvt = 2 * dh + d;
#pragma unroll
            for (int ks = 0; ks < 8; ++ks) { const bf16x8_t A = *(const LAS bf16x8_t*)(Cimg + (32 * dvt + r) * 256 + 2 * (16 * ks + 8 * hh)); Hc[d] = MFMA32(A, qs[ks], Hc[d]); if (ks & 1) __builtin_amdgcn_sched_barrier(0); } }
    }
    __builtin_amdgcn_sched_barrier(0);
    float ss = 0.f;
#pragma unroll
    for (int d = 0; d < 2; ++d)
#pragma unroll
        for (int i = 0; i < 16; ++i) ss += Hc[d][i] * Hc[d][i];
    ss += lane_get(ss, lane ^ 32);
    if (hh == 0) SSQ[dh * 128 + t] = ss;
    __syncthreads();
    const float rr = 1.0f / sqrtf((SSQ[t] + SSQ[128 + t]) * (1.0f / 128.0f) + EPS);
#pragma unroll
    for (int d = 0; d < 2; ++d)
#pragma unroll
        for (int g = 0; g < 4; ++g) { const int dv = 32 * (2 * dh + d) + 8 * g + 4 * hh;
            const v2u og = *(const v2u*)(OG + (size_t)(row0 + t) * HW + h * 128 + dv); const f32x4 gg = *(const f32x4*)(mg + h * 128 + dv);
            v2u o; o.x = cvtpk(Hc[d][4 * g] * rr * gg.x * bflo(og.x), Hc[d][4 * g + 1] * rr * gg.y * bfhi(og.x)); o.y = cvtpk(Hc[d][4 * g + 2] * rr * gg.z * bflo(og.y), Hc[d][4 * g + 3] * rr * gg.w * bfhi(og.y));
            *(v2u*)(Y + (size_t)(row0 + t) * D + h * 128 + dv) = o; }
    __syncthreads();
}
__device__ __forceinline__ void sgu_item_mfma(const bf16* Z, const float* lg, const float* lb, const bf16* swb, const float* sb, bf16* Y, int chunk, LAS unsigned char* lds, int tid) {
    asm volatile("" : "+v"(tid));
    const int lane = tid & 63, wave = __builtin_amdgcn_readfirstlane(tid >> 6);
    const int row0 = chunk * 128;
    LAS unsigned char* VN = lds;
    {
        const f32x4 g = *(const f32x4*)(lg + lane * 4), bb = *(const f32x4*)(lb + lane * 4);
#pragma unroll 4
        for (int tt = 0; tt < 16; ++tt) { const int t = wave * 16 + tt;
            const v2u raw = *(const v2u*)(Z + (size_t)(row0 + t) * 512 + 256 + lane * 4);
            const float x0 = bflo(raw.x), x1 = bfhi(raw.x), x2 = bflo(raw.y), x3 = bfhi(raw.y);
            float s = (x0 + x1) + (x2 + x3);
#pragma unroll
            for (int o = 1; o < 64; o <<= 1) s += lane_get(s, lane ^ o);
            const float mu = s * (1.0f / 256.0f);
            const float d0 = x0 - mu, d1 = x1 - mu, d2 = x2 - mu, d3 = x3 - mu;
            float vs = (d0 * d0 + d1 * d1) + (d2 * d2 + d3 * d3);
#pragma unroll
            for (int o = 1; o < 64; o <<= 1) vs += lane_get(vs, lane ^ o);
            const float rs = 1.0f / sqrtf(vs * (1.0f / 256.0f) + EPS);
            v2u o; o.x = cvtpk(d0 * rs * g.x + bb.x, d1 * rs * g.y + bb.y); o.y = cvtpk(d2 * rs * g.z + bb.z, d3 * rs * g.w + bb.w);
            *(LAS v2u*)(VN + t * 512 + lane * 8) = o; }
    }
    __syncthreads();
    const int r = lane & 31, hh = lane >> 5, i16 = lane & 15, q = i16 >> 2, p = i16 & 3, blk = (lane >> 4) & 1;
    const int g = wave >> 1, ct = wave & 1;
    bf16x8_t af[8];
#pragma unroll
    for (int ks = 0; ks < 8; ++ks) { const LAS unsigned char* va = VN + (16 * ks + 8 * hh + q) * 512 + 2 * (64 * g + 32 * ct + 16 * blk + 4 * p); af[ks] = cat8(tr16(va), tr16(va + 4 * 512)); }
    const bf16* wg = swb + (size_t)g * 128 * 128;
#pragma unroll 1
    for (int pt = 0; pt < 4; ++pt) {
        f32x16 acc;
#pragma unroll
        for (int i = 0; i < 16; ++i) acc[i] = 0.f;
        bf16x8_t bfr[8];
#pragma unroll
        for (int ks = 0; ks < 8; ++ks) bfr[ks] = *(const bf16x8_t*)(wg + (size_t)(32 * pt + r) * 128 + 16 * ks + 8 * hh);
#pragma unroll
        for (int ks = 0; ks < 8; ++ks) acc = MFMA32(af[ks], bfr[ks], acc);
        const int tok = row0 + 32 * pt + r;
        const float bs = sb[g * 128 + 32 * pt + r];
#pragma unroll
        for (int gq = 0; gq < 4; ++gq) { const int ch = 64 * g + 32 * ct + 8 * gq + 4 * hh;
            const v2u u = *(const v2u*)(Z + (size_t)tok * 512 + ch);
            v2u o; o.x = cvtpk(bflo(u.x) * (acc[4 * gq] + bs), bfhi(u.x) * (acc[4 * gq + 1] + bs)); o.y = cvtpk(bflo(u.y) * (acc[4 * gq + 2] + bs), bfhi(u.y) * (acc[4 * gq + 3] + bs));
            *(v2u*)(Y + (size_t)tok * D + 512 + ch) = o; }
    }
    __syncthreads();
}

__device__ __forceinline__ void conv_item(const bf16* YC, const float* cw, const float* cb, float* CV, int item, LAS unsigned char* lds, int tid) {
    asm volatile("" : "+v"(tid));
    int base0, base1, stride, len, p00, p01, ch0;
    if (item < 512) { const int b = item >> 5, gr = item & 31; base0 = base1 = b * SEQ + gr * 64; stride = 1; len = 64; p00 = 0; p01 = 32; ch0 = 0; }
    else if (item < 1024) { const int it = item - 512, b = it >> 5, cp = it & 31; base0 = b * SEQ + 2 * cp; base1 = base0 + 1; stride = 64; len = 32; p00 = 0; p01 = 0; ch0 = 128; }
    else { const int it = item - 1024, b = it >> 3, half = (it >> 2) & 1, qt = it & 3; base0 = base1 = ML + b * CTXL; stride = 1; len = 256; p00 = 64 * qt; p01 = 64 * qt + 32; ch0 = 128 * half; }
    LAS unsigned* IN = (LAS unsigned*)lds;
    for (int e = tid; e < 2 * 62 * 16; e += NTHREADS) {
        const int sg = e / (62 * 16), rem = e % (62 * 16), pp = rem >> 4, c16 = rem & 15;
        const int pos = (sg ? p01 : p00) + pp - 15;
        v4u v = {0u, 0u, 0u, 0u};
        if (pos >= 0 && pos < len) v = *(const v4u*)(YC + (size_t)((sg ? base1 : base0) + pos * stride) * 256 + ch0 + c16 * 8);
        *(LAS v4u*)(IN + (sg * 62 + pp) * 64 + c16 * 4) = v;
    }
    __syncthreads();
    const int c2 = tid & 63, sg = (tid >> 6) & 1, tq = tid >> 7;
    const int ch = ch0 + 2 * c2;
    float a0[8], a1[8];
    const f32x2 bias = *(const f32x2*)(cb + ch);
#pragma unroll
    for (int i = 0; i < 8; ++i) { a0[i] = bias.x; a1[i] = bias.y; }
    const LAS unsigned* ip = IN + (sg * 62 + 8 * tq) * 64 + c2;
#pragma unroll
    for (int j = 0; j < 38; ++j) {
        const unsigned w = ip[j * 64]; const float x0 = bflo(w), x1 = bfhi(w);
#pragma unroll
        for (int i = 0; i < 8; ++i) { const int k = j - i; if (k >= 0 && k < 31) { const f32x2 wk = *(const f32x2*)(cw + k * 256 + ch); a0[i] += wk.x * x0; a1[i] += wk.y * x1; } }
    }
    const int pbase = (sg ? p01 : p00) + 8 * tq; const int rbase = sg ? base1 : base0;
#pragma unroll
    for (int i = 0; i < 8; ++i) *(f32x2*)(CV + (size_t)(rbase + (pbase + i) * stride) * 256 + ch) = (f32x2){a0[i], a1[i]};
    __syncthreads();
}

__device__ __forceinline__ void conv_finalize(const float* CV, const float* lg, const float* lb, bf16* Y, int nrows, int G, int tid) {
    asm volatile("" : "+v"(tid));
    const int lane = tid & 63, wave = __builtin_amdgcn_readfirstlane(tid >> 6);
    const int gw = blockIdx.x * NWAVES + wave, NGW = G * NWAVES;
    const f32x4 g = *(const f32x4*)(lg + lane * 4), bb = *(const f32x4*)(lb + lane * 4);
    for (int r = gw; r < nrows; r += NGW) {
        const f32x4 x = *(const f32x4*)(CV + (size_t)r * 256 + lane * 4);
        float s = (x.x + x.y) + (x.z + x.w);
#pragma unroll
        for (int o = 1; o < 64; o <<= 1) s += lane_get(s, lane ^ o);
        const float mu = s * (1.0f / 256.0f);
        const float d0 = x.x - mu, d1 = x.y - mu, d2 = x.z - mu, d3 = x.w - mu;
        float vs = (d0 * d0 + d1 * d1) + (d2 * d2 + d3 * d3);
#pragma unroll
        for (int o = 1; o < 64; o <<= 1) vs += lane_get(vs, lane ^ o);
        const float rs = 1.0f / sqrtf(vs * (1.0f / 256.0f) + EPS);
        float y0 = d0 * rs * g.x + bb.x, y1 = d1 * rs * g.y + bb.y, y2 = d2 * rs * g.z + bb.z, y3 = d3 * rs * g.w + bb.w;
        y0 *= fsigmoid(y0); y1 *= fsigmoid(y1); y2 *= fsigmoid(y2); y3 *= fsigmoid(y3);
        v2u o; o.x = cvtpk(y0, y1); o.y = cvtpk(y2, y3);
        *(v2u*)(Y + (size_t)r * D + 768 + lane * 4) = o;
    }
}
constexpr int N_PHASES = 18;
#ifndef MK_ONE_LAUNCH
#define MK_ONE_LAUNCH 0
#endif
#ifndef PH_MASK
#define PH_MASK 0x3ff
#endif
#ifndef REP_MASK
#define REP_MASK 0
#endif
#define PH_EN(b) (((PH_MASK) >> (b)) & 1)

__global__ void __launch_bounds__(NTHREADS, 2) fwd_kernel(Args args) {
    extern __shared__ __attribute__((aligned(16))) unsigned char lds_raw[];
    LAS unsigned char* lds = (LAS unsigned char*)lds_raw;
    const int G = gridDim.x;
    unsigned char* ws = args.ws;
    volatile LAS unsigned* MISC = (volatile LAS unsigned*)(lds + MISC_OFF);
    for (int u = threadIdx.x; u < (LDS_BYTES - RING_BYTES) / 4; u += NTHREADS) ((LAS unsigned*)(lds + RING_BYTES))[u] = 0u;
    __syncthreads();
    XcdBarrier bar; bar.bar = (unsigned*)(ws + WS_CTL) + 4096; bar.x = 0; bar.st = nullptr;
    const int lo = args.ph_lo, hi = args.ph_hi;
    if (hi - lo > 1) bar = xcd_barrier_post((unsigned*)(ws + WS_CTL) + 4096, MISC + 8);
#define IN(k) (lo <= (k) && (k) < hi)
#define SEAM(k) do { if (IN(k) && IN((k) + 1)) xcd_barrier(bar); } while (0)

#pragma unroll 1
    for (int ph = lo; ph < hi; ++ph) {
#if REP_MASK
#pragma unroll 1
      for (int rep = 0; rep < ((ph >= 1 && ph <= 16 && (((REP_MASK) >> ((ph - 1) & 7)) & 1)) ? 2 : 1); ++rep) {
#else
      {
#endif
        int tid = threadIdx.x; asm volatile("" : "+v"(tid));
        const int lane = tid & 63, wave = __builtin_amdgcn_readfirstlane(tid >> 6);
        if (ph == 0) { if (PH_EN(8)) phase_prologue(args, lds, G, tid, lane, wave); }
        else if (ph == N_PHASES - 1) { if (PH_EN(9)) phase_final(args.out, args.in[I_FG], G, lane, wave); }
        else {
            const int l = (ph - 1) >> 3, k = (ph - 1) & 7;
            {
            const bool last = (l == DEPTH - 1);
            const int mrest = last ? ML : MT;
            const float* modl = (const float*)(ws + WS_MOD) + (size_t)l * 17 * MODW;
            const unsigned char* wl = ws + WS_W + (size_t)l * W_LAYER;
            if (k == 0 && PH_EN(0)) {
                phase_norm(l == 0 ? args.in[I_X] : args.out, l == 0 ? args.in[I_CTX] : (const float*)(ws + WS_XC), (bf16*)(ws + WS_A), args.in[I_N1G] + l * D, modl, 0, MT, G, lane, wave);
            } else if (k == 1 && PH_EN(1)) {
                pg8::Gemm g{(const bf16*)(ws + WS_A), (const bf16*)(wl + WO_IN), MT, NIN, D}; pg8::StaticOrder S; S.init(MT, NIN, G, (int)blockIdx.x);
                pg8::EpiIn E{ws + WS_P, (const float*)(ws + WS_BIN) + l * NIN};
                pg8::gemm_phase<pg8::EpiIn, pg8::StaticOrder, true, true>(lds, g, S, E, tid);
            } else if (k == 2 && PH_EN(2)) {
                for (int it = blockIdx.x; it < 256; it += G)
                    mlstm_state_item((const bf16*)(ws + WS_K), (const bf16*)(ws + WS_V), (const float*)(ws + WS_GT), (bf16*)(ws + WS_CT), (float*)(ws + WS_NS), (float*)(ws + WS_MP), it, !last, lds, tid);
                const int nch = mrest / 128;
                for (int it = blockIdx.x; it < nch; it += G)
                    sgu_item_mfma((const bf16*)(ws + WS_Z), args.in[I_SLG] + l * 256, args.in[I_SLB] + l * 256, (const bf16*)(ws + WS_SWB) + (size_t)l * 4 * 128 * 128, args.in[I_SB] + l * 4 * 128, (bf16*)(ws + WS_Y), it, lds, tid);
                const int ncv = last ? 1024 : 1152;
                for (int it = blockIdx.x; it < ncv; it += G)
                    conv_item((const bf16*)(ws + WS_YC), args.in[I_CW] + l * 31 * 256, args.in[I_CB] + l * 256, (float*)(ws + WS_CV), it, lds, tid);
            } else if (k == 3 && PH_EN(3)) {
                const int abase = last ? 2 : 0, na = 18 - abase;
                for (int it = blockIdx.x; it < 64 * na; it += G) { const int bh = it / na, a = abase + it % na;
                    mlstm_out_item((const bf16*)(ws + WS_Q), (const bf16*)(ws + WS_K), (const bf16*)(ws + WS_V), (const bf16*)(ws + WS_OG), (const float*)(ws + WS_GT), (const bf16*)(ws + WS_CT), (const float*)(ws + WS_NS), (const float*)(ws + WS_MP),
                                   args.in[I_MG] + l * HW, (bf16*)(ws + WS_Y), bh >> 2, bh & 3, a, lds, tid); }
                conv_finalize((const float*)(ws + WS_CV), args.in[I_CLG] + l * 256, args.in[I_CLB] + l * 256, (bf16*)(ws + WS_Y), mrest, G, tid);
            } else if (k == 4 && PH_EN(4)) {
                pg8::Gemm g{(const bf16*)(ws + WS_Y), (const bf16*)(wl + WO_OUT), mrest, D, D}; pg8::StaticOrder S; S.init(mrest, D, G, (int)blockIdx.x);
                pg8::EpiRes E{l == 0 ? args.in[I_X] : args.out, args.out, l == 0 ? args.in[I_CTX] : (const float*)(ws + WS_XC), (float*)(ws + WS_XC), modl + 2 * D, ML};
                pg8::gemm_phase<pg8::EpiRes, pg8::StaticOrder, true, true>(lds, g, S, E, tid);
            } else if (k == 5 && PH_EN(5)) {
                phase_norm(args.out, (const float*)(ws + WS_XC), (bf16*)(ws + WS_A), args.in[I_N2G] + l * D, modl, 3 * D, mrest, G, lane, wave);
            } else if (k == 6 && PH_EN(6)) {
                pg8::Gemm g{(const bf16*)(ws + WS_A), (const bf16*)(wl + WO_GU), mrest, NGU, D}; pg8::StaticOrder S; S.init(mrest, NGU, G, (int)blockIdx.x);
                pg8::EpiGU E{(bf16*)(ws + WS_H)};
                pg8::gemm_phase<pg8::EpiGU, pg8::StaticOrder, true, true>(lds, g, S, E, tid);
            } else if (PH_EN(7)) {
                pg8::Gemm g{(const bf16*)(ws + WS_H), (const bf16*)(wl + WO_DOWN), mrest, D, FF}; pg8::StaticOrder S; S.init(mrest, D, G, (int)blockIdx.x);
                pg8::EpiRes E{args.out, args.out, (const float*)(ws + WS_XC), (float*)(ws + WS_XC), modl + 5 * D, ML};
                pg8::gemm_phase<pg8::EpiRes, pg8::StaticOrder, true, true>(lds, g, S, E, tid);
            }
            }
        }
      }
        if (ph + 1 < hi) xcd_barrier(bar);
    }
#undef IN
#undef SEAM
}

extern "C" void kernel_launch(void* const* d_in, const int* in_sizes, int n_in, void* d_out, int out_size, void* d_ws, size_t ws_size, hipStream_t stream) {
    static int grid = 0;
    if (grid == 0) {
        if (n_in != 23 || in_sizes[0] != ML * D || out_size != ML * D || ws_size < WS_END) {
            fprintf(stderr, "kernel_launch: unexpected problem (n_in %d, in0 %d, out %d, ws %zu < %zu); nothing launched\n", n_in, n_in > 0 ? in_sizes[0] : -1, out_size, ws_size, (size_t)WS_END); grid = -1; return; }
        int dev = 0, cus = 0, per_cu = 0;
        if (hipGetDevice(&dev) != hipSuccess || hipDeviceGetAttribute(&cus, hipDeviceAttributeMultiprocessorCount, dev) != hipSuccess) { grid = -1; return; }
        if (hipFuncSetAttribute((const void*)fwd_kernel, hipFuncAttributeMaxDynamicSharedMemorySize, LDS_BYTES) != hipSuccess) { fprintf(stderr, "kernel_launch: hipFuncSetAttribute failed\n"); grid = -1; return; }
        if (hipOccupancyMaxActiveBlocksPerMultiprocessor(&per_cu, (const void*)fwd_kernel, NTHREADS, LDS_BYTES) != hipSuccess || per_cu < 1) {
            fprintf(stderr, "kernel_launch: occupancy query reports %d blocks per CU\n", per_cu); per_cu = 1; }
        (void)hipGetLastError();
        grid = cus;
    }
    if (grid < 0) return;
    if (hipMemsetAsync((char*)d_ws + WS_CTL, 0, ZERO_BYTES, stream) != hipSuccess) { fprintf(stderr, "kernel_launch: memset failed\n"); return; }
    Args a{};
    for (int i = 0; i < 23; ++i) a.in[i] = (const float*)d_in[i];
    a.out = (float*)d_out; a.ws = (unsigned char*)d_ws;
#if MK_ONE_LAUNCH
    a.ph_lo = 0; a.ph_hi = N_PHASES;
    hipLaunchKernelGGL(fwd_kernel, dim3(grid), dim3(NTHREADS), LDS_BYTES, stream, a);
#else
    for (int p = 0; p < N_PHASES; ++p) { a.ph_lo = p; a.ph_hi = p + 1; hipLaunchKernelGGL(fwd_kernel, dim3(grid), dim3(NTHREADS), LDS_BYTES, stream, a); }
#endif
    const hipError_t le = hipPeekAtLastError();
    if (le != hipSuccess) fprintf(stderr, "kernel_launch: launch failed: %s\n", hipGetErrorName(le));
}
```

```cpp
#include <hip/hip_runtime.h>
#include <cstdio>
#include <cstdint>
#ifndef MK_ONE_LAUNCH
#define MK_ONE_LAUNCH 1
#endif
namespace pg8 {
#define PG8_LAS __attribute__((address_space(3)))
typedef unsigned short bf16_t;
typedef short bf16x8 __attribute__((ext_vector_type(8)));
typedef float f32x4 __attribute__((ext_vector_type(4)));
typedef unsigned u32x4 __attribute__((ext_vector_type(4)));
constexpr int BM = 256, BK = 64, HALF = 128, HTB = HALF * BK * 2  , STAGE_BYTES = 8 * HTB, NXCD = 8, WGM = 8;

__host__ __device__ __forceinline__ int lds_byte(int r, int c) { const int st = (r >> 4) * 2 + (c >> 5), rr = r & 15, cc = c & 31, ob = rr * 64 + cc * 2; return st * 1024 + (ob ^ (((ob >> 9) & 1) << 5)); }
__host__ __device__ __forceinline__ void stage_rc(int b, int& R, int& C) { const int st = b / 1024, sb = b % 1024, swz = sb ^ (((sb >> 9) & 1) << 5); R = (st >> 1) * 16 + swz / 64; C = (st & 1) * 32 + (swz % 64) / 2; }
__host__ __device__ __forceinline__ int perm32(int rho) { const int n = rho >> 4, i = rho & 15; return 8 * (i >> 2) + 4 * n + (i & 3); }

struct Unit { int pm, pn; };
struct Gemm { const bf16_t* A; const bf16_t* Bt; int M, N, K; };

struct StaticOrder {
    int nM, nN, nwg, G, c;
    __host__ __device__ void init(int M, int N, int G_, int c_) { nM = M / BM; nN = N / BM; nwg = nM * nN; G = G_; c = c_; }
    __host__ __device__ bool next(int i, Unit& u) const {
        const long L = (long)i * G + c; if (L >= nwg) return false;
        int wgid = (int)L; { const int q = nwg / NXCD, r = nwg % NXCD, xcd = wgid % NXCD, off = wgid / NXCD; wgid = (xcd < r ? xcd * (q + 1) : r * (q + 1) + (xcd - r) * q) + off; }
        const int nig = WGM * nN, gid = wgid / nig, fm = gid * WGM, gsz = (nM - fm) < WGM ? (nM - fm) : WGM;
        u.pm = fm + ((wgid % nig) % gsz); u.pn = (wgid % nig) / gsz; return true;
    }
    __device__ __forceinline__ void a_ready(const Unit&) const {}
    __device__ __forceinline__ void done(const Unit&) const {}
};

__device__ __forceinline__ unsigned cvt_pk_bf16(float lo, float hi) { unsigned r; asm volatile("v_cvt_pk_bf16_f32 %0, %1, %2" : "=v"(r) : "v"(lo), "v"(hi)); return r; }
template <class Epi, class Sched, bool ALIGN_EPI = false, bool SP2 = false>
__device__ __forceinline__ void gemm_phase(PG8_LAS unsigned char* lds, const Gemm g, const Sched& S, const Epi& E, const int tid) {
    const int wid = __builtin_amdgcn_readfirstlane(tid >> 6), lane = tid & 63, wr = wid >> 2, wc = wid & 3, fr = lane & 15, fq = lane >> 4;
    const int K = g.K, nt = K / BK;
    unsigned voffA[2], voffB[2];
#pragma unroll
    for (int i = 0; i < 2; ++i) { int R, C; stage_rc(tid * 16 + i * 8192, R, C); const int Rb = Epi::PERM ? ((R & ~31) + perm32(R & 31)) : R;
        voffA[i] = (unsigned)(R * K + C) * 2u; voffB[i] = (unsigned)(Rb * K + C) * 2u; }
    const size_t kstep = (size_t)(BK * 2);
    const size_t hstep = (size_t)HALF * K * 2;
    const size_t tstep = 2 * hstep;
    const unsigned ldsw = (unsigned)wid * 1024u;
    const int aoff = lds_byte(wr * 64 + fr, fq * 8), boff = lds_byte(wc * 32 + fr, fq * 8);
#define PG8_SA(b, h) (((b) * 2 + (h)) * HTB)
#define PG8_SB(b, h) ((4 + (b) * 2 + (h)) * HTB)
#define PG8_STAGE(bufoff, gbase, voff) do { _Pragma("unroll") for (int _i = 0; _i < 2; ++_i) \
        __builtin_amdgcn_global_load_lds((const unsigned*)((const char*)(gbase) + (voff)[_i]), (PG8_LAS unsigned*)(lds + (bufoff) + ldsw + _i * 8192), 16, 0, 0); } while (0)
#define PG8_LDA(dst, b, h) do { _Pragma("unroll") for (int m = 0; m < 4; ++m) _Pragma("unroll") for (int k = 0; k < 2; ++k) dst[m][k] = *(const PG8_LAS bf16x8*)(lds + PG8_SA(b, h) + aoff + m * 2048 + k * 1024); } while (0)
#define PG8_LDB(dst, b, h) do { _Pragma("unroll") for (int n = 0; n < 2; ++n) _Pragma("unroll") for (int k = 0; k < 2; ++k) dst[n][k] = *(const PG8_LAS bf16x8*)(lds + PG8_SB(b, h) + boff + n * 2048 + k * 1024); } while (0)
#define PG8_MMA(ai, bj, At, Bt) do { __builtin_amdgcn_s_setprio(1); _Pragma("unroll") for (int m = 0; m < 4; ++m) _Pragma("unroll") for (int n = 0; n < 2; ++n) _Pragma("unroll") for (int k = 0; k < 2; ++k) \
        acc[ai][bj][m][n] = __builtin_amdgcn_mfma_f32_16x16x32_bf16(Bt[n][k], At[m][k], acc[ai][bj][m][n], 0, 0, 0); __builtin_amdgcn_s_setprio(0); } while (0)
#define PG8_WAIT_V(n) asm volatile("s_waitcnt vmcnt(" #n ")" ::: "memory")
#define PG8_WAIT_L(n) asm volatile("s_waitcnt lgkmcnt(" #n ")" ::: "memory")
#define PG8_BAR __builtin_amdgcn_s_barrier()
#define PG8_SCHED __builtin_amdgcn_sched_barrier(0)
    Unit cur, nxt; int ui = 0;
    if (!S.next(0, cur)) return;
    f32x4 acc[2][2][4][2];
#pragma unroll
    for (int a = 0; a < 2; ++a)
#pragma unroll
        for (int b = 0; b < 2; ++b)
#pragma unroll
            for (int m = 0; m < 4; ++m)
#pragma unroll
                for (int n = 0; n < 2; ++n) acc[a][b][m][n] = (f32x4){0.f, 0.f, 0.f, 0.f};
    bf16x8 At[4][2], B0[2][2], B1[2][2];
    const char* cA = (const char*)g.A + (size_t)cur.pm * tstep; const char* cB = (const char*)g.Bt + (size_t)cur.pn * tstep;
    S.a_ready(cur);
    if constexpr (SP2) {
        PG8_STAGE(PG8_SB(0, 0), cB, voffB); PG8_STAGE(PG8_SB(0, 1), cB + hstep, voffB); PG8_STAGE(PG8_SA(0, 0), cA, voffA); PG8_STAGE(PG8_SA(0, 1), cA + hstep, voffA);
        if (wr == 1) PG8_BAR;
        PG8_WAIT_V(2); PG8_BAR;
        PG8_STAGE(PG8_SB(1, 0), cB + kstep, voffB); PG8_STAGE(PG8_SA(1, 0), cA + kstep, voffA); PG8_STAGE(PG8_SB(1, 1), cB + hstep + kstep, voffB);
        PG8_WAIT_V(6); PG8_BAR;
    } else {
        PG8_STAGE(PG8_SB(0, 0), cB, voffB); PG8_STAGE(PG8_SA(0, 0), cA, voffA); PG8_STAGE(PG8_SB(0, 1), cB + hstep, voffB); PG8_STAGE(PG8_SA(0, 1), cA + hstep, voffA);
        if (wr == 1) PG8_BAR;
        PG8_WAIT_V(4); PG8_BAR;
        PG8_STAGE(PG8_SB(1, 0), cB + kstep, voffB); PG8_STAGE(PG8_SA(1, 0), cA + kstep, voffA); PG8_STAGE(PG8_SB(1, 1), cB + hstep + kstep, voffB);
        PG8_WAIT_V(6); PG8_BAR;
    }
    for (;;) {
        const bool has_next = S.next(ui + 1, nxt);
        const char* nA = has_next ? (const char*)g.A + (size_t)nxt.pm * tstep : cA; const char* nB = has_next ? (const char*)g.Bt + (size_t)nxt.pn * tstep : cB;
        for (int t = 0; t < nt; t += 2) {
            const bool last = (t == nt - 2);
            const char* a1 = cA + (size_t)(t + 1) * kstep;
            const char* a2 = last ? nA : cA + (size_t)(t + 2) * kstep; const char* b2 = last ? nB : cB + (size_t)(t + 2) * kstep;
            const char* a3 = a2 + kstep; const char* b3 = b2 + kstep;
            if (last && has_next) S.a_ready(nxt);
            if constexpr (SP2) {
            PG8_LDB(B0, 0, 0); PG8_LDB(B1, 0, 1); PG8_SCHED; PG8_LDA(At, 0, 0); PG8_STAGE(PG8_SA(1, 1), a1 + hstep, voffA);
            PG8_WAIT_V(8); PG8_WAIT_L(0); PG8_BAR; PG8_MMA(0, 0, At, B0); PG8_MMA(0, 1, At, B1); PG8_BAR; PG8_SCHED;
            PG8_LDA(At, 0, 1); PG8_STAGE(PG8_SB(0, 0), b2, voffB); PG8_STAGE(PG8_SB(0, 1), b2 + hstep, voffB); PG8_STAGE(PG8_SA(0, 0), a2, voffA);
            PG8_WAIT_V(8); PG8_WAIT_L(0); PG8_BAR; PG8_MMA(1, 0, At, B0); PG8_MMA(1, 1, At, B1); PG8_BAR; PG8_SCHED;
            PG8_LDB(B0, 1, 0); PG8_LDB(B1, 1, 1); PG8_SCHED; PG8_LDA(At, 1, 0); PG8_STAGE(PG8_SA(0, 1), a2 + hstep, voffA);
            PG8_WAIT_V(8); PG8_WAIT_L(0); PG8_BAR; PG8_MMA(0, 0, At, B0); PG8_MMA(0, 1, At, B1); PG8_BAR; PG8_SCHED;
            PG8_LDA(At, 1, 1); PG8_STAGE(PG8_SB(1, 0), b3, voffB); PG8_STAGE(PG8_SB(1, 1), b3 + hstep, voffB); PG8_STAGE(PG8_SA(1, 0), a3, voffA);
            PG8_WAIT_V(8); PG8_WAIT_L(0); PG8_BAR; PG8_MMA(1, 0, At, B0); PG8_MMA(1, 1, At, B1); PG8_BAR; PG8_SCHED;
            } else {
            PG8_LDB(B0, 0, 0); PG8_SCHED; PG8_LDA(At, 0, 0); PG8_STAGE(PG8_SA(1, 1), a1 + hstep, voffA);
            PG8_WAIT_L(8); PG8_BAR; PG8_WAIT_L(0); PG8_MMA(0, 0, At, B0); PG8_BAR; PG8_SCHED;
            PG8_LDB(B1, 0, 1); PG8_STAGE(PG8_SB(0, 0), b2, voffB);
            PG8_BAR; PG8_WAIT_L(0); PG8_MMA(0, 1, At, B1); PG8_BAR;
            PG8_LDA(At, 0, 1); PG8_STAGE(PG8_SA(0, 0), a2, voffA);
            PG8_BAR; PG8_WAIT_L(0); PG8_MMA(1, 0, At, B0); PG8_BAR; PG8_SCHED;
            PG8_STAGE(PG8_SB(0, 1), b2 + hstep, voffB);
            PG8_WAIT_V(6); PG8_BAR; PG8_MMA(1, 1, At, B1); PG8_BAR;
            PG8_LDB(B0, 1, 0); PG8_SCHED; PG8_LDA(At, 1, 0); PG8_STAGE(PG8_SA(0, 1), a2 + hstep, voffA);
            PG8_WAIT_L(8); PG8_BAR; PG8_WAIT_L(0); PG8_MMA(0, 0, At, B0); PG8_BAR; PG8_SCHED;
            PG8_LDB(B1, 1, 1); PG8_STAGE(PG8_SB(1, 0), b3, voffB);
            PG8_BAR; PG8_WAIT_L(0); PG8_MMA(0, 1, At, B1); PG8_BAR;
            PG8_LDA(At, 1, 1); PG8_STAGE(PG8_SA(1, 0), a3, voffA);
            PG8_BAR; PG8_WAIT_L(0); PG8_MMA(1, 0, At, B0); PG8_BAR; PG8_SCHED;
            PG8_STAGE(PG8_SB(1, 1), b3 + hstep, voffB);
            PG8_WAIT_V(6); PG8_BAR; PG8_MMA(1, 1, At, B1); PG8_BAR;
            }
        }
        if constexpr (ALIGN_EPI) { if (wr == 0) PG8_BAR; }
        if constexpr (!Epi::AFTER_DRAIN) { E(acc, cur, wr, wc, fr, fq); S.done(cur); }
        if (!has_next) break;
#pragma unroll
        for (int a = 0; a < 2; ++a)
#pragma unroll
            for (int b = 0; b < 2; ++b)
#pragma unroll
                for (int m = 0; m < 4; ++m)
#pragma unroll
                    for (int n = 0; n < 2; ++n) acc[a][b][m][n] = (f32x4){0.f, 0.f, 0.f, 0.f};
        cur = nxt; cA = nA; cB = nB; ++ui;
        if constexpr (ALIGN_EPI) { if (wr == 1) PG8_BAR; }
    }
    PG8_WAIT_V(0);
    if constexpr (!ALIGN_EPI) { if (wr == 0) PG8_BAR; }
    PG8_BAR;
    if constexpr (Epi::AFTER_DRAIN) { E.fused(acc, cur, wr, wc, fr, fq, lds, wid, lane); S.done(cur); }
#undef PG8_SA
#undef PG8_SB
#undef PG8_STAGE
#undef PG8_LDA
#undef PG8_LDB
#undef PG8_MMA
#undef PG8_WAIT_V
#undef PG8_WAIT_L
#undef PG8_BAR
#undef PG8_SCHED
}
}
namespace pg8 {
__device__ __forceinline__ u32x4 pack8(const f32x4& v0, const f32x4& v1) { u32x4 w; w.x = cvt_pk_bf16(v0[0], v0[1]); w.y = cvt_pk_bf16(v0[2], v0[3]); w.z = cvt_pk_bf16(v1[0], v1[1]); w.w = cvt_pk_bf16(v1[2], v1[3]); return w; }
__device__ __forceinline__ float sigm(float x) { return __builtin_amdgcn_rcpf(1.0f + __expf(-x)); }
__device__ __forceinline__ f32x4 sigm4(const f32x4& v) { return (f32x4){sigm(v[0]), sigm(v[1]), sigm(v[2]), sigm(v[3])}; }
__device__ __forceinline__ float gelu_t(float x) { const float u = 1.5957691216057308f * (x + 0.044715f * x * x * x); return x * sigm(u); }
__device__ __forceinline__ f32x4 gelu4(const f32x4& v) { return (f32x4){gelu_t(v[0]), gelu_t(v[1]), gelu_t(v[2]), gelu_t(v[3])}; }

struct EpiIn {
    static constexpr bool PERM = true, AFTER_DRAIN = false;
    unsigned char* P; const float* bias;
    __device__ __forceinline__ void operator()(const f32x4 (&acc)[2][2][4][2], const Unit& u, int wr, int wc, int fr, int fq) const {
        const int pn = u.pn, row0 = u.pm * BM + wr * 64 + fr, cl = wc * 32 + 8 * fq;
        f32x4 bv[2][2];
#pragma unroll
        for (int bj = 0; bj < 2; ++bj)
#pragma unroll
            for (int n = 0; n < 2; ++n) bv[bj][n] = *(const f32x4*)(bias + pn * BM + bj * HALF + cl + 4 * n);
        if (pn < 10) {
            bf16_t* base = (bf16_t*)(P + (size_t)(pn >> 1) * (36u << 20));
            const float sc = (pn >= 2 && pn < 4) ? 0.08838834764831845f : 1.0f;
            const int act = pn < 6 ? 0 : pn < 8 ? 1 : 2;
            const int dcol = (pn & 1) * BM + cl;
#pragma unroll
            for (int ai = 0; ai < 2; ++ai)
#pragma unroll
                for (int m = 0; m < 4; ++m) { bf16_t* rowp = base + (size_t)(row0 + ai * HALF + m * 16) * 512 + dcol;
#pragma unroll
                    for (int bj = 0; bj < 2; ++bj) { f32x4 v0 = acc[ai][bj][m][0] + bv[bj][0], v1 = acc[ai][bj][m][1] + bv[bj][1];
                        if (act == 1) { v0 = sigm4(v0); v1 = sigm4(v1); } else if (act == 2) { v0 = gelu4(v0); v1 = gelu4(v1); } else { v0 = v0 * sc; v1 = v1 * sc; }
                        *(u32x4*)(rowp + bj * HALF) = pack8(v0, v1); } }
        } else if (pn < 12) {
            const int dcol = (pn - 10) * HALF + cl;
#pragma unroll
            for (int ai = 0; ai < 2; ++ai)
#pragma unroll
                for (int m = 0; m < 4; ++m) { bf16_t* rowp = (bf16_t*)(P + (size_t)5 * (36u << 20)) + (size_t)(row0 + ai * HALF + m * 16) * 256 + dcol;
                    const f32x4 a0 = acc[ai][0][m][0] + bv[0][0], a1 = acc[ai][0][m][1] + bv[0][1];
                    const f32x4 g0 = sigm4(acc[ai][1][m][0] + bv[1][0]), g1 = sigm4(acc[ai][1][m][1] + bv[1][1]);
                    *(u32x4*)rowp = pack8(a0 * g0, a1 * g1); }
        } else {
            if (wc == 0 && fq < 2) {
#pragma unroll
                for (int ai = 0; ai < 2; ++ai)
#pragma unroll
                    for (int m = 0; m < 4; ++m) { float* rowp = (float*)(P + (size_t)5 * (36u << 20) + (18u << 20)) + (size_t)(row0 + ai * HALF + m * 16) * 16 + 8 * fq;
                        *(f32x4*)rowp = acc[ai][0][m][0] + bv[0][0]; *(f32x4*)(rowp + 4) = acc[ai][0][m][1] + bv[0][1]; }
            }
        }
    }
};

struct EpiGU {
    static constexpr bool PERM = true, AFTER_DRAIN = false;
    bf16_t* H;
    __device__ __forceinline__ void operator()(const f32x4 (&acc)[2][2][4][2], const Unit& u, int wr, int wc, int fr, int fq) const {
        const int row0 = u.pm * BM + wr * 64 + fr, dcol = u.pn * HALF + wc * 32 + 8 * fq;
#pragma unroll
        for (int ai = 0; ai < 2; ++ai)
#pragma unroll
            for (int m = 0; m < 4; ++m) { bf16_t* rowp = H + (size_t)(row0 + ai * HALF + m * 16) * 2816 + dcol;
                const f32x4 g0 = acc[ai][0][m][0], g1 = acc[ai][0][m][1];
                *(u32x4*)rowp = pack8(g0 * sigm4(g0) * acc[ai][1][m][0], g1 * sigm4(g1) * acc[ai][1][m][1]); }
    }
};

struct EpiRes {
    static constexpr bool PERM = false, AFTER_DRAIN = false;
    const float* baseL; float* outL; const float* baseC; float* outC; const float* gate; int nlat;
    __device__ __forceinline__ void operator()(const f32x4 (&acc)[2][2][4][2], const Unit& u, int wr, int wc, int fr, int fq) const {
        const int trow = u.pm * BM; const bool lat = trow < nlat;
        const float* base = lat ? baseL + (size_t)trow * 1024 : baseC + (size_t)(trow - nlat) * 1024;
        float* out = lat ? outL + (size_t)trow * 1024 : outC + (size_t)(trow - nlat) * 1024;
        const float* gv = gate + (size_t)(lat ? (trow >> 11) : 16) * 6144;
        const int r0 = wr * 64 + fr, col0 = u.pn * BM + wc * 32 + 4 * fq;
        f32x4 g[2][2];
#pragma unroll
        for (int bj = 0; bj < 2; ++bj)
#pragma unroll
            for (int n = 0; n < 2; ++n) g[bj][n] = *(const f32x4*)(gv + col0 + bj * HALF + n * 16);
#pragma unroll
        for (int ai = 0; ai < 2; ++ai)
#pragma unroll
            for (int m = 0; m < 4; ++m) { const size_t off = (size_t)(r0 + ai * HALF + m * 16) * 1024 + col0;
#pragma unroll
                for (int bj = 0; bj < 2; ++bj)
#pragma unroll
                    for (int n = 0; n < 2; ++n) { const f32x4 b = *(const f32x4*)(base + off + bj * HALF + n * 16);
                        *(f32x4*)(out + off + bj * HALF + n * 16) = b + g[bj][n] * acc[ai][bj][m][n]; } }
    }
};
}
constexpr int D = 1024, NB = 16, SEQ = 2048, CTXL = 256, DEPTH = 2;
constexpr int ML = NB * SEQ, MC = NB * CTXL, MT = ML + MC;
constexpr int NIN_O = 3088, NIN = 3328, FF = 2816, NGU = 2 * FF;
constexpr int HW = 512;
constexpr int MODW = 6 * D;
constexpr float EPS = 1e-6f;
constexpr int NWAVES = 8, NTHREADS = 512;

constexpr size_t MiB = 1u << 20;
constexpr size_t WS_CTL = 0;
constexpr size_t WS_MOD = 1 * MiB;
constexpr size_t ZERO_BYTES = 2 * MiB;
constexpr size_t WS_BIN = 2 * MiB;
constexpr size_t WS_W = 3 * MiB, W_LAYER = 25 * MiB;
constexpr size_t WO_IN = 0, WO_OUT = 6 * MiB + 512 * 1024, WO_GU = WO_OUT + 2 * MiB, WO_DOWN = WO_GU + 11 * MiB;
constexpr size_t WS_XC = 53 * MiB;
constexpr size_t WS_A = 69 * MiB;
constexpr size_t WS_P = 141 * MiB;
constexpr size_t WS_Q = WS_P, WS_K = WS_Q + 36 * MiB, WS_V = WS_K + 36 * MiB, WS_OG = WS_V + 36 * MiB, WS_Z = WS_OG + 36 * MiB, WS_YC = WS_Z + 36 * MiB, WS_GT = WS_YC + 18 * MiB;
constexpr size_t WS_H = WS_P;
constexpr size_t WS_Y = 342 * MiB;
constexpr size_t WS_CT = WS_A;
constexpr size_t WS_NS = 454 * MiB, WS_TAB = 460 * MiB;
constexpr size_t WS_SWB = 2 * MiB + 65536;
constexpr size_t WS_CV = 418 * MiB;
constexpr size_t WS_END = 486 * MiB;
static_assert(WS_GT + (size_t)MT * 16 * 4 <= WS_Y && WS_H + (size_t)MT * FF * 2 <= WS_Y && WS_W + 2 * W_LAYER <= WS_XC && WO_DOWN + (size_t)D * FF * 2 <= W_LAYER, "ws map");

constexpr int RING_BYTES = 131072, MISC_OFF = RING_BYTES + 320, LDS_BYTES = 147456;

#define GAS __attribute__((address_space(1)))
#define LAS __attribute__((address_space(3)))
typedef unsigned short bf16;
typedef unsigned v4u __attribute__((ext_vector_type(4)));
typedef unsigned v2u __attribute__((ext_vector_type(2)));
typedef float f32x4 __attribute__((ext_vector_type(4)));
typedef float f32x2 __attribute__((ext_vector_type(2)));
#define LDS_WAIT() asm volatile("s_waitcnt lgkmcnt(0)" ::: "memory")
__device__ __forceinline__ unsigned f2bf(float f) { unsigned u = __builtin_bit_cast(unsigned, f); return (u + 0x7fffu + ((u >> 16) & 1u)) >> 16; }
__device__ __forceinline__ unsigned pk2(float lo, float hi) { return f2bf(lo) | (f2bf(hi) << 16); }
__device__ __forceinline__ float bf2f(unsigned short b) { return __builtin_bit_cast(float, (unsigned)b << 16); }
__device__ __forceinline__ float bflo(unsigned w) { return __builtin_bit_cast(float, w << 16); }
__device__ __forceinline__ float bfhi(unsigned w) { return __builtin_bit_cast(float, w & 0xffff0000u); }
__device__ __forceinline__ float fsigmoid(float x) { return __builtin_amdgcn_rcpf(1.0f + __expf(-x)); }
__device__ __forceinline__ float wave_sum(float v) {
#pragma unroll
    for (int o = 1; o < 64; o <<= 1) v += __shfl_xor(v, o);
    return v;
}
__device__ __forceinline__ int modrow_of(int row) { return row < ML ? (row >> 11) : 16; }
#define XB_TMO      128
#define XB_XCNT(j)  (256  + 64 * (j))
#define XB_XSUB(j)  (1280 + 64 * (j))
#define XB_XGEN(j)  (2304 + 64 * (j))
#define XB_TOP      3328
#define XB_TOPGEN   3392
#define XCD_BAR_WORDS 3456
#define XB_SPIN_CAP (1u << 18)

__device__ __forceinline__ unsigned xb_ld(unsigned* p)              { return __hip_atomic_load(p, __ATOMIC_RELAXED, __HIP_MEMORY_SCOPE_AGENT); }
__device__ __forceinline__ unsigned xb_add(unsigned* p, unsigned v) { return __hip_atomic_fetch_add(p, v, __ATOMIC_RELAXED, __HIP_MEMORY_SCOPE_AGENT); }
__device__ __forceinline__ unsigned xb_xcc_id() { return (unsigned)__builtin_amdgcn_s_getreg((3 << 11) | 20) & 0xFu; }
#define XB_SPIN(cond, bar) do { unsigned _sp = 0; while (cond) { __builtin_amdgcn_s_sleep(1); \
    if ((++_sp & 255u) == 0u) { if (xb_ld(&(bar)[XB_TMO])) break; if (_sp > XB_SPIN_CAP) { atomicAdd(&(bar)[XB_TMO], 1u); break; } } } } while (0)

struct XcdBarrier {
    unsigned* bar; unsigned x;
    volatile LAS unsigned* st;
};

__device__ __forceinline__ XcdBarrier xcd_barrier_post(unsigned* bar, volatile LAS unsigned* st) {
    XcdBarrier b; b.bar = bar; b.x = xb_xcc_id(); b.st = st;
    if (threadIdx.x == 0) (void)xb_add(&bar[XB_XCNT(b.x)], 1u);
    return b;
}
__device__ __forceinline__ void xcd_barrier_complete(unsigned* bar, unsigned x, unsigned& nloc, unsigned& nx) {
    const unsigned G = gridDim.x * gridDim.y * gridDim.z;
    unsigned sum, cnt, mine, sp = 0u;
    for (;;) {
        sum = 0u; cnt = 0u; mine = 0u;
#pragma unroll
        for (unsigned j = 0; j < 16; ++j) { const unsigned c = xb_ld(&bar[XB_XCNT(j)]); sum += c; cnt += (c > 0u) ? 1u : 0u; mine = (j == x) ? c : mine; }
        if (sum == G) break;
        __builtin_amdgcn_s_sleep(1);
        if ((++sp & 255u) == 0u) { if (xb_ld(&bar[XB_TMO])) break; if (sp > XB_SPIN_CAP) { atomicAdd(&bar[XB_TMO], 1u); break; } }
    }
    nloc = mine > 0u ? mine : 1u; nx = cnt > 0u ? cnt : 1u;
}

__device__ __forceinline__ void xcd_barrier(const XcdBarrier& b) {
    asm volatile("s_waitcnt vmcnt(0)" ::: "memory");
    __syncthreads();
    if (threadIdx.x == 0) {
        unsigned* bar = b.bar;
        __builtin_amdgcn_s_waitcnt(0);
        unsigned nloc = b.st[0], nx = b.st[1];
        if (nloc == 0u) { xcd_barrier_complete(bar, b.x, nloc, nx); b.st[0] = nloc; b.st[1] = nx; }
        const unsigned old = xb_add(&bar[XB_XSUB(b.x)], 1u);
        const unsigned gen = old / nloc;
        if (old + 1u == (gen + 1u) * nloc) {
            __builtin_amdgcn_fence(__ATOMIC_RELEASE, "agent");
            asm volatile("s_waitcnt vmcnt(0)" ::: "memory");
            const unsigned og = xb_add(&bar[XB_TOP], 1u);
            const unsigned tg = og / nx;
            if (og + 1u == (tg + 1u) * nx) xb_add(&bar[XB_TOPGEN], 1u);
            else XB_SPIN(xb_ld(&bar[XB_TOPGEN]) == tg, bar);
            __builtin_amdgcn_fence(__ATOMIC_ACQUIRE, "agent");
            xb_add(&bar[XB_XGEN(b.x)], 1u);
            asm volatile("s_waitcnt vmcnt(0)" ::: "memory");
        } else {
            XB_SPIN(xb_ld(&bar[XB_XGEN(b.x)]) == gen, bar);
            __builtin_amdgcn_fence(__ATOMIC_ACQUIRE, "agent");
            asm volatile("s_waitcnt vmcnt(0)" ::: "memory");
        }
    }
    __syncthreads();
}

struct Args { const float* in[23]; float* out; unsigned char* ws; int ph_lo, ph_hi; };
enum { I_X = 0, I_C, I_CTX, I_CCTX, I_WMOD, I_BMOD, I_N1G, I_WIN, I_BIN, I_MG, I_SLG, I_SLB, I_SW, I_SB, I_CW, I_CB, I_CLG, I_CLB, I_WOUT, I_N2G, I_WGU, I_WDOWN, I_FG };

__device__ __forceinline__ int win_src_col(int n) {
    if (n < 2048) return n;
    if (n < 2560) return n + 16;
    if (n < 3072) { const int j = n - 2560, tile = j >> 8, jj = j & 255; return 2576 + (jj >> 7) * 256 + tile * 128 + (jj & 127); }
    if (n < 3088) return 2048 + (n - 3072);
    return -1;
}
__device__ __forceinline__ int wgu_src_col(int n) { const int tile = n >> 8, jj = n & 255; return (jj >> 7) * FF + tile * 128 + (jj & 127); }

__device__ __forceinline__ void transpose_item(const float* W, int K, int Nsrc, bf16* WT, int n0, int srcc0, int nvalid, int k0, LAS float* scr, int lane) {
    const int c = lane & 31;
#pragma unroll 8
    for (int i = 0; i < 32; ++i) { const int kk = 2 * i + (lane >> 5);
        float v = 0.f; if (srcc0 >= 0 && c < nvalid) v = W[(size_t)(k0 + kk) * Nsrc + srcc0 + c];
        scr[kk * 33 + c] = v; }
    LDS_WAIT(); asm volatile("" ::: "memory");
    const int c8 = lane & 7;
#pragma unroll
    for (int j = 0; j < 4; ++j) { const int n = (lane >> 3) + 8 * j; const LAS float* s = scr + (8 * c8) * 33 + n;
        v4u o; o.x = pk2(s[0 * 33], s[1 * 33]); o.y = pk2(s[2 * 33], s[3 * 33]); o.z = pk2(s[4 * 33], s[5 * 33]); o.w = pk2(s[6 * 33], s[7 * 33]);
        *(v4u*)(WT + (size_t)(n0 + n) * K + k0 + 8 * c8) = o; }
    LDS_WAIT(); asm volatile("" ::: "memory");
}

__device__ __forceinline__ void phase_prologue(const Args& a, LAS unsigned char* lds, int G, int tid, int lane, int wave) {
    unsigned char* ws = a.ws;
    LAS float* scr = (LAS float*)(lds + wave * 16384);
    const int gw = blockIdx.x * NWAVES + wave, NGW = G * NWAVES;
    constexpr int I_IN = 16 * (NIN / 32), I_OUT = 16 * 32, I_GU = 16 * (NGU / 32), I_DN = (FF / 64) * 32, I_LAYER = I_IN + I_OUT + I_GU + I_DN;
    for (int it = gw; it < 2 * I_LAYER; it += NGW) {
        const int l = it / I_LAYER; int r = it % I_LAYER;
        unsigned char* wl = ws + WS_W + (size_t)l * W_LAYER;
        if (r < I_IN) { const int kb = r / (NIN / 32), nb = r % (NIN / 32), n0 = nb * 32, sc = win_src_col(n0);
            transpose_item(a.in[I_WIN] + (size_t)l * D * NIN_O, D, NIN_O, (bf16*)(wl + WO_IN), n0, sc, n0 == 3072 ? 16 : 32, kb * 64, scr, lane); continue; }
        r -= I_IN;
        if (r < I_OUT) { const int kb = r / 32, nb = r % 32;
            transpose_item(a.in[I_WOUT] + (size_t)l * D * D, D, D, (bf16*)(wl + WO_OUT), nb * 32, nb * 32, 32, kb * 64, scr, lane); continue; }
        r -= I_OUT;
        if (r < I_GU) { const int kb = r / (NGU / 32), nb = r % (NGU / 32), n0 = nb * 32;
            transpose_item(a.in[I_WGU] + (size_t)l * D * NGU, D, NGU, (bf16*)(wl + WO_GU), n0, wgu_src_col(n0), 32, kb * 64, scr, lane); continue; }
        r -= I_GU;
        { const int kb = r / 32, nb = r % 32;
            transpose_item(a.in[I_WDOWN] + (size_t)l * FF * D, FF, D, (bf16*)(wl + WO_DOWN), nb * 32, nb * 32, 32, kb * 64, scr, lane); }
    }
    for (int e = blockIdx.x * NTHREADS + tid; e < 2 * NIN; e += G * NTHREADS) { const int l = e / NIN, n = e % NIN, s = win_src_col(n);
        ((float*)(ws + WS_BIN))[e] = s >= 0 ? a.in[I_BIN][l * NIN_O + s] : 0.f; }
    for (int e = blockIdx.x * NTHREADS + tid; e < 2 * 4 * 128 * 128; e += G * NTHREADS) ((bf16*)(ws + WS_SWB))[e] = (bf16)f2bf(a.in[I_SW][e]);
    __syncthreads();
    LAS float* sl = (LAS float*)lds;
    float* MOD = (float*)(ws + WS_MOD);
    for (int it = blockIdx.x; it < 2 * 12 * 16; it += G) {
        const int l = it / 192, jb = (it % 192) / 16, ks = it % 16;
        for (int e = tid; e < 17 * 64; e += NTHREADS) { const int r = e >> 6, k = e & 63; const float cv = r < 16 ? a.in[I_C][r * D + ks * 64 + k] : a.in[I_CCTX][ks * 64 + k]; sl[e] = cv * fsigmoid(cv); }
        __syncthreads();
        const int j = jb * 512 + tid;
        float acc[17];
#pragma unroll
        for (int r = 0; r < 17; ++r) acc[r] = 0.f;
        const float* wp = a.in[I_WMOD] + (size_t)l * D * MODW + (size_t)(ks * 64) * MODW + j;
#pragma unroll 4
        for (int k = 0; k < 64; ++k) { const float w = wp[(size_t)k * MODW];
#pragma unroll
            for (int r = 0; r < 17; ++r) acc[r] += sl[r * 64 + k] * w; }
        const float bm = ks == 0 ? a.in[I_BMOD][l * MODW + j] : 0.f;
#pragma unroll
        for (int r = 0; r < 17; ++r) atomicAdd(MOD + (size_t)(l * 17 + r) * MODW + j, acc[r] + bm);
        __syncthreads();
    }
}

__device__ __forceinline__ void phase_norm(const float* xl, const float* xc, bf16* A, const float* g, const float* mod, int sh_off, int nrows, int G, int lane, int wave) {
    const int gw = blockIdx.x * NWAVES + wave, NGW = G * NWAVES;
    for (int r = gw; r < nrows; r += NGW) {
        const float* xr = r < ML ? xl + (size_t)r * D : xc + (size_t)(r - ML) * D;
        const float* mr = mod + (size_t)modrow_of(r) * MODW + sh_off;
        f32x4 v[4]; float s = 0.f;
#pragma unroll
        for (int j = 0; j < 4; ++j) { v[j] = ((const f32x4*)xr)[lane + 64 * j]; s += (v[j].x * v[j].x + v[j].y * v[j].y) + (v[j].z * v[j].z + v[j].w * v[j].w); }
        const float rstd = 1.0f / sqrtf(wave_sum(s) * (1.0f / D) + EPS);
        unsigned long long* o8 = (unsigned long long*)(A + (size_t)r * D) + lane;
#pragma unroll
        for (int j = 0; j < 4; ++j) { const int c = (lane + 64 * j) * 4;
            const f32x4 gg = *(const f32x4*)(g + c), sh = *(const f32x4*)(mr + c), sc = *(const f32x4*)(mr + D + c);
            const f32x4 y = v[j] * rstd * gg * (1.0f + sc) + sh;
            o8[64 * j] = (unsigned long long)pk2(y.x, y.y) | ((unsigned long long)pk2(y.z, y.w) << 32); }
    }
}

__device__ __forceinline__ void phase_final(float* x, const float* g, int G, int lane, int wave) {
    const int gw = blockIdx.x * NWAVES + wave, NGW = G * NWAVES;
    for (int r = gw; r < ML; r += NGW) {
        float* xr = x + (size_t)r * D;
        f32x4 v[4]; float s = 0.f;
#pragma unroll
        for (int j = 0; j < 4; ++j) { v[j] = ((const f32x4*)xr)[lane + 64 * j]; s += (v[j].x * v[j].x + v[j].y * v[j].y) + (v[j].z * v[j].z + v[j].w * v[j].w); }
        const float rstd = 1.0f / sqrtf(wave_sum(s) * (1.0f / D) + EPS);
#pragma unroll
        for (int j = 0; j < 4; ++j) { const f32x4 gg = ((const f32x4*)g)[lane + 64 * j]; ((f32x4*)xr)[lane + 64 * j] = v[j] * rstd * gg; }
    }
}

constexpr int TB = 16;
__device__ __forceinline__ void mlstm_scan_item(const bf16* Q, const bf16* K, const bf16* V, const float* GT, float* HS0, float* HS1, int item, bool ctx_out, LAS unsigned char* lds, int tid) {
    const int b = item >> 3, h = (item >> 1) & 3, dir = item & 1;
    const int dv = tid & 127, kq = tid >> 7;
    LAS float* kbuf = (LAS float*)lds;
    LAS float* vbuf = kbuf + TB * 128;
    LAS float* qbuf = vbuf + TB * 128;
    LAS float* ibuf = qbuf + TB * 128;
    LAS float* fbuf = ibuf + TB;
    LAS float* red = fbuf + TB;
    LAS float* redd = red + 2 * 4 * 128;
    float* HS = dir ? HS1 : HS0;
    float C[32], nn[32];
#pragma unroll
    for (int j = 0; j < 32; ++j) { C[j] = 0.f; nn[j] = 0.f; }
    float m = 0.f; int par = 0;
    for (int s0 = 0; s0 < CTXL + SEQ; s0 += TB) {
        const bool isctx = s0 < CTXL; const int len = isctx ? CTXL : SEQ, i0 = isctx ? s0 : s0 - CTXL;
        const int rbase = isctx ? ML + b * CTXL : b * SEQ;
        for (int e = tid; e < TB * 384; e += NTHREADS) { const int tok = e / 384, c = e % 384, which = c >> 7, d = c & 127;
            const int t = dir ? (len - 1 - (i0 + tok)) : (i0 + tok); const size_t off = (size_t)(rbase + t) * HW + h * 128 + d;
            const bf16* src = which == 0 ? K : which == 1 ? V : Q;
            (which == 0 ? kbuf : which == 1 ? vbuf : qbuf)[tok * 128 + d] = bf2f(src[off]); }
        if (tid < TB) { const int t = dir ? (len - 1 - (i0 + tid)) : (i0 + tid); const float* gp = GT + (size_t)(rbase + t) * 16 + dir * 8 + h;
            const float iv = gp[0], fv = gp[4];
            ibuf[tid] = iv; fbuf[tid] = fminf(fv, 0.f) - log1pf(__expf(-fabsf(fv))); }
        __syncthreads();
        const bool wr_out = !isctx || ctx_out;
        for (int tok = 0; tok < TB; ++tok) {
            const float it = ibuf[tok], lf = fbuf[tok];
            const float mn = fmaxf(lf + m, it), aa = __expf(lf + m - mn), bc = __expf(it - mn); m = mn;
            const float vv = vbuf[tok * 128 + dv] * bc;
            float part = 0.f, dpart = 0.f;
            const LAS float* kp = kbuf + tok * 128 + kq * 32; const LAS float* qp = qbuf + tok * 128 + kq * 32;
#pragma unroll
            for (int j = 0; j < 32; ++j) { const float kk = kp[j], qq = qp[j];
                C[j] = aa * C[j] + kk * vv; part += C[j] * qq;
                nn[j] = aa * nn[j] + bc * kk; dpart += nn[j] * qq; }
            red[(par * 4 + kq) * 128 + dv] = part; if (dv == 0) redd[par * 4 + kq] = dpart;
            __syncthreads();
            if (tid < 128 && wr_out) {
                const float num = (red[(par * 4 + 0) * 128 + tid] + red[(par * 4 + 1) * 128 + tid]) + (red[(par * 4 + 2) * 128 + tid] + red[(par * 4 + 3) * 128 + tid]);
                const float den = (redd[par * 4 + 0] + redd[par * 4 + 1]) + (redd[par * 4 + 2] + redd[par * 4 + 3]);
                const int t = dir ? (len - 1 - (i0 + tok)) : (i0 + tok);
                HS[(size_t)(rbase + t) * HW + h * 128 + tid] = num / fmaxf(fabsf(den), __expf(-m));
            }
            par ^= 1;
        }
    }
    __syncthreads();
}

__device__ __forceinline__ void phase_mlstm_post(const float* HS0, const float* HS1, const bf16* OG, const float* mg, bf16* Y, int nrows, int G, int lane, int wave) {
    const int gw = blockIdx.x * NWAVES + wave, NGW = G * NWAVES;
    for (int r = gw; r < nrows; r += NGW) {
        const size_t off = (size_t)r * HW + lane * 8;
        const f32x4 a0 = *(const f32x4*)(HS0 + off), a1 = *(const f32x4*)(HS0 + off + 4), b0 = *(const f32x4*)(HS1 + off), b1 = *(const f32x4*)(HS1 + off + 4);
        const f32x4 h0 = a0 + b0, h1 = a1 + b1;
        float s = (h0.x * h0.x + h0.y * h0.y) + (h0.z * h0.z + h0.w * h0.w) + (h1.x * h1.x + h1.y * h1.y) + (h1.z * h1.z + h1.w * h1.w);
        s += __shfl_xor(s, 1); s += __shfl_xor(s, 2); s += __shfl_xor(s, 4); s += __shfl_xor(s, 8);
        const float rs = 1.0f / sqrtf(s * (1.0f / 128.0f) + EPS);
        const v4u og = *(const v4u*)(OG + off);
        const f32x4 g0 = *(const f32x4*)(mg + lane * 8), g1 = *(const f32x4*)(mg + lane * 8 + 4);
        v4u o;
        o.x = pk2(h0.x * rs * g0.x * bflo(og.x), h0.y * rs * g0.y * bfhi(og.x)); o.y = pk2(h0.z * rs * g0.z * bflo(og.y), h0.w * rs * g0.w * bfhi(og.y));
        o.z = pk2(h1.x * rs * g1.x * bflo(og.z), h1.y * rs * g1.y * bfhi(og.z)); o.w = pk2(h1.z * rs * g1.z * bflo(og.w), h1.w * rs * g1.w * bfhi(og.w));
        *(v4u*)(Y + (size_t)r * D + lane * 8) = o;
    }
}

__device__ __forceinline__ void sgu_item(const bf16* Z, const float* lg, const float* lb, const float* sw, const float* sb, bf16* Y, int chunk, LAS unsigned char* lds, int tid, int lane, int wave) {
    LAS float* vn = (LAS float*)lds;
    const int row0 = chunk * 128;
    for (int t = wave; t < 128; t += NWAVES) {
        const v2u raw = *(const v2u*)(Z + (size_t)(row0 + t) * 512 + 256 + lane * 4);
        const float x0 = bflo(raw.x), x1 = bfhi(raw.x), x2 = bflo(raw.y), x3 = bfhi(raw.y);
        const float mu = wave_sum((x0 + x1) + (x2 + x3)) * (1.0f / 256.0f);
        const float d0 = x0 - mu, d1 = x1 - mu, d2 = x2 - mu, d3 = x3 - mu;
        const float var = wave_sum((d0 * d0 + d1 * d1) + (d2 * d2 + d3 * d3)) * (1.0f / 256.0f);
        const float rs = 1.0f / sqrtf(var + EPS);
        const f32x4 g = *(const f32x4*)(lg + lane * 4), bb = *(const f32x4*)(lb + lane * 4);
        *(LAS f32x4*)(vn + t * 256 + lane * 4) = (f32x4){d0 * rs * g.x + bb.x, d1 * rs * g.y + bb.y, d2 * rs * g.z + bb.z, d3 * rs * g.w + bb.w};
    }
    __syncthreads();
    const int ch = tid & 255, ph = tid >> 8, g = __builtin_amdgcn_readfirstlane(ch >> 6);
    const float* wg = sw + (size_t)g * 128 * 128; const float* bg = sb + g * 128;
    for (int p = ph * 64; p < ph * 64 + 64; ++p) {
        const float* wr = wg + p * 128; float acc = 0.f;
#pragma unroll 8
        for (int q = 0; q < 128; ++q) acc += wr[q] * vn[q * 256 + ch];
        const float u = bf2f(Z[(size_t)(row0 + p) * 512 + ch]);
        Y[(size_t)(row0 + p) * D + 512 + ch] = (bf16)f2bf(u * (acc + bg[p]));
    }
    __syncthreads();
}

__device__ __forceinline__ void conv_rows(const bf16* YC, const float* cw, const float* cb, const float* lg, const float* lb, bf16* Y, int row0, int nrows, int lane, int wave) {
    const int c0 = lane * 4;
    for (int rr = wave; rr < nrows; rr += NWAVES) {
        const int r = row0 + rr;
        f32x4 acc = *(const f32x4*)(cb + c0);
        int base, pos, len, stride;
        if (r < ML) { const int b = r >> 11, t = r & 2047;
            if (lane < 32) { base = (b << 11) + (t & ~63); pos = t & 63; len = 64; stride = 1; }
            else           { base = (b << 11) + (t & 63); pos = t >> 6; len = 32; stride = 64; } }
        else { const int rc = r - ML; base = ML + (rc & ~255); pos = rc & 255; len = 256; stride = 1; }
#pragma unroll 1
        for (int k = 0; k < 31; ++k) { const int p = pos + k - 15;
            if (p >= 0 && p < len) { const v2u raw = *(const v2u*)(YC + (size_t)(base + p * stride) * 256 + c0); const f32x4 w = *(const f32x4*)(cw + k * 256 + c0);
                acc.x += w.x * bflo(raw.x); acc.y += w.y * bfhi(raw.x); acc.z += w.z * bflo(raw.y); acc.w += w.w * bfhi(raw.y); } }
        const float mu = wave_sum((acc.x + acc.y) + (acc.z + acc.w)) * (1.0f / 256.0f);
        const float d0 = acc.x - mu, d1 = acc.y - mu, d2 = acc.z - mu, d3 = acc.w - mu;
        const float var = wave_sum((d0 * d0 + d1 * d1) + (d2 * d2 + d3 * d3)) * (1.0f / 256.0f);
        const float rs = 1.0f / sqrtf(var + EPS);
        const f32x4 g = *(const f32x4*)(lg + c0), bb = *(const f32x4*)(lb + c0);
        float y0 = d0 * rs * g.x + bb.x, y1 = d1 * rs * g.y + bb.y, y2 = d2 * rs * g.z + bb.z, y3 = d3 * rs * g.w + bb.w;
        y0 *= fsigmoid(y0); y1 *= fsigmoid(y1); y2 *= fsigmoid(y2); y3 *= fsigmoid(y3);
        v2u o; o.x = pk2(y0, y1); o.y = pk2(y2, y3);
        *(v2u*)(Y + (size_t)r * D + 768 + c0) = o;
    }
}
typedef short bf16x8_t __attribute__((ext_vector_type(8)));
typedef short s16x4_t __attribute__((ext_vector_type(4)));
typedef short v4i16_t __attribute__((ext_vector_type(4)));
typedef float f32x16 __attribute__((ext_vector_type(16)));
typedef __bf16 bf16x2_t __attribute__((ext_vector_type(2)));
__device__ __forceinline__ unsigned cvtpk(float lo, float hi) { f32x2 v = {lo, hi}; bf16x2_t b = __builtin_convertvector(v, bf16x2_t); return __builtin_bit_cast(unsigned, b); }
__device__ __forceinline__ s16x4_t tr16(const LAS unsigned char* p) { return __builtin_bit_cast(s16x4_t, __builtin_amdgcn_ds_read_tr16_b64_v4i16((LAS v4i16_t*)p)); }
__device__ __forceinline__ bf16x8_t cat8(s16x4_t lo, s16x4_t hi) { return __builtin_shufflevector(lo, hi, 0, 1, 2, 3, 4, 5, 6, 7); }
#define MFMA32(a, b, c) __builtin_amdgcn_mfma_f32_32x32x16_bf16((a), (b), (c), 0, 0, 0)
__device__ __forceinline__ int crow(int reg, int hh) { return (reg & 3) + 8 * (reg >> 2) + 4 * hh; }
__device__ __forceinline__ int chunk_row0(int b, int a) { return a < 2 ? ML + b * CTXL + a * 128 : b * SEQ + (a - 2) * 128; }
__device__ __forceinline__ int chunk_of_step(int j, int dir) { return dir == 0 ? j : (j == 0 ? 1 : (j == 1 ? 0 : 19 - j)); }
__device__ __forceinline__ float log_sigmoid(float x) { return fminf(x, 0.f) - log1pf(__expf(-fabsf(x))); }
__device__ __forceinline__ float lane_get(float x, int src_lane) { return __builtin_bit_cast(float, __builtin_amdgcn_ds_bpermute(src_lane << 2, __builtin_bit_cast(int, x))); }
__device__ __forceinline__ float wave_incl_add(float x, int lane) {
#pragma unroll
    for (int o = 1; o < 64; o <<= 1) { const float y = lane_get(x, lane - o); if (lane >= o) x += y; }
    return x;
}
__device__ __forceinline__ float wave_incl_max(float x, int lane) {
#pragma unroll
    for (int o = 1; o < 64; o <<= 1) { const float y = lane_get(x, lane - o); if (lane >= o) x = fmaxf(x, y); }
    return x;
}
__device__ __forceinline__ float wave_max(float v, int lane) {
#pragma unroll
    for (int o = 1; o < 64; o <<= 1) v = fmaxf(v, lane_get(v, lane ^ o));
    return v;
}
__device__ __forceinline__ v4u scale8(const v4u& w, float s) {
    v4u o; o.x = cvtpk(bflo(w.x) * s, bfhi(w.x) * s); o.y = cvtpk(bflo(w.y) * s, bfhi(w.y) * s); o.z = cvtpk(bflo(w.z) * s, bfhi(w.z) * s); o.w = cvtpk(bflo(w.w) * s, bfhi(w.w) * s); return o;
}
constexpr int MX_OFF = RING_BYTES + 1024;

#define dpp_f(x, ctrl) __builtin_bit_cast(float, __builtin_amdgcn_update_dpp(0, __builtin_bit_cast(int, (float)(x)), (ctrl), 0xf, 0xf, false))
#define ROW_SUM16(x) do { x += dpp_f(x, 0x121); x += dpp_f(x, 0x122); x += dpp_f(x, 0x124); x += dpp_f(x, 0x128); } while (0)
__device__ __forceinline__ int swz_off(int row, int chunk) { return row * 256 + 16 * (chunk ^ (((row & 3) << 2) | ((row >> 2) & 3))); }

#define ST_LOAD(kr, vr, jj) do { const int row0_ = chunk_row0(b, chunk_of_step((jj), dir)); \
        _Pragma("unroll") for (int i = 0; i < 4; ++i) { const int pc = tid + NTHREADS * i; kr[i] = *(const v4u*)(K + (size_t)(row0_ + (pc >> 4)) * HW + h * 128 + (pc & 15) * 8); } \
        _Pragma("unroll") for (int i = 0; i < 2; ++i) { const int pc = tid + NTHREADS * i; vr[i] = *(const v4u*)(V + (size_t)(row0_ + (pc >> 3)) * HW + h * 128 + dvh * 64 + (pc & 7) * 8); } } while (0)
#define ST_WRITE(kr, vr, jj) do { LAS unsigned char* Kn = Kimg + ((jj) & 1) * 32768; LAS unsigned char* Vn = Vimg + ((jj) & 1) * 16384; \
        _Pragma("unroll") for (int i = 0; i < 4; ++i) { const int pc = tid + NTHREADS * i; *(LAS v4u*)(Kn + pc * 16) = kr[i]; } \
        _Pragma("unroll") for (int i = 0; i < 2; ++i) { const int pc = tid + NTHREADS * i, s_ = pc >> 3; *(LAS v4u*)(Vn + pc * 16) = scale8(vr[i], kap[(jj) * 128 + (dir ? 127 - s_ : s_)]); } } while (0)
#define ST_STEP(j, krL, vrL, krW, vrW) do { \
        __syncthreads(); \
        const int a = chunk_of_step((j), dir); \
        if ((j) + 2 < 18) ST_LOAD(krL, vrL, (j) + 2); \
        if (a >= 2 || store_ctx) { \
            bf16* cp = CT + ((size_t)(seq * 18 + a) * 128 + dvh * 64 + dvt * 32 + r) * 128 + dkt * 32 + 4 * hh; \
            _Pragma("unroll") for (int g = 0; g < 4; ++g) { v2u o; o.x = cvtpk(acc[4 * g], acc[4 * g + 1]); o.y = cvtpk(acc[4 * g + 2], acc[4 * g + 3]); *(v2u*)(cp + 8 * g) = o; } \
            if (dvh == 0) NS[(size_t)(seq * 18 + a) * 512 + tid] = nn; } \
        const float delta = cs[64 + (j)]; \
        _Pragma("unroll") for (int i = 0; i < 16; ++i) acc[i] *= delta; \
        const LAS unsigned char* Kb = Kimg + ((j) & 1) * 32768; const LAS unsigned char* Vb = Vimg + ((j) & 1) * 16384; \
        _Pragma("unroll") for (int ks = 0; ks < 8; ++ks) { \
            const LAS unsigned char* ka = Kb + (16 * ks + 8 * hh + q) * 256 + 2 * (32 * dkt + 16 * blk + 4 * p); \
            const LAS unsigned char* va = Vb + (16 * ks + 8 * hh + q) * 128 + 2 * (32 * dvt + 16 * blk + 4 * p); \
            const bf16x8_t A = cat8(tr16(ka), tr16(ka + 4 * 256)), B = cat8(tr16(va), tr16(va + 4 * 128)); \
            acc = MFMA32(A, B, acc); } \
        if (dvh == 0) { float s_ = 0.f; const int sq = tid >> 7, dk = tid & 127; \
            _Pragma("unroll 8") for (int t = 32 * sq; t < 32 * sq + 32; ++t) s_ += kap[(j) * 128 + (dir ? 127 - t : t)] * bf2f(*(const LAS unsigned short*)(Kb + t * 256 + dk * 2)); \
            nn = delta * nn + s_; } \
        if ((j) + 1 < 18) ST_WRITE(krW, vrW, (j) + 1); \
    } while (0)
__device__ __forceinline__ void mlstm_state_item(const bf16* K, const bf16* V, const float* GT, bf16* CT, float* NS, float* TAB, int item, bool store_ctx, LAS unsigned char* lds, int tid) {
    asm volatile("" : "+v"(tid));
    const int lane = tid & 63, wave = __builtin_amdgcn_readfirstlane(tid >> 6);
    const int dvh = item & 1, dir = (item >> 1) & 1, h = (item >> 2) & 3, b = item >> 4;
    const int seq = (b * 4 + h) * 2 + dir;
    LAS unsigned char* Kimg = lds;
    LAS unsigned char* Vimg = lds + 65536;
    LAS float* kap = (LAS float*)(lds + 98304);
    LAS float* gb = kap + 2304;
    LAS float* ib = gb + 2304;
    LAS float* cs = ib + 2304;
    for (int e = tid; e < 2304; e += NTHREADS) { const int j = e >> 7, tau = e & 127, a = chunk_of_step(j, dir), t = dir ? 127 - tau : tau;
        const float* gp = GT + (size_t)(chunk_row0(b, a) + t) * 16 + dir * 8 + h; ib[e] = gp[0]; gb[e] = log_sigmoid(gp[4]); }
    __syncthreads();
    for (int j = wave; j < 18; j += NWAVES) {
        const float x0 = gb[j * 128 + 2 * lane], x1 = gb[j * 128 + 2 * lane + 1];
        const float sc = wave_incl_add(x0 + x1, lane);
        const float b0 = sc - x1, b1 = sc, g0 = ib[j * 128 + 2 * lane] - b0, g1 = ib[j * 128 + 2 * lane + 1] - b1;
        const float ip = wave_incl_max(fmaxf(g0, g1), lane);
        float ex = lane_get(ip, lane - 1); if (lane == 0) ex = -INFINITY;
        gb[j * 128 + 2 * lane] = g0; gb[j * 128 + 2 * lane + 1] = g1;
        ib[j * 128 + 2 * lane] = fmaxf(ex, g0); ib[j * 128 + 2 * lane + 1] = ip;
        kap[j * 128 + 2 * lane] = b0; kap[j * 128 + 2 * lane + 1] = b1;
        const float pm = lane_get(ip, 63), bl = lane_get(sc, 63);
        if (lane == 0) { cs[j] = bl; cs[32 + j] = pm; }
    }
    __syncthreads();
    if (tid < 18) { float m = 0.f, mp = 0.f, Ml = 0.f;
        for (int j = 0; j <= tid; ++j) { mp = m; Ml = fmaxf(m, cs[32 + j]); m = cs[j] + Ml; }
        cs[64 + tid] = __expf(mp - Ml); cs[96 + tid] = Ml; cs[128 + tid] = mp; }
    __syncthreads();
    for (int e = tid; e < 2304; e += NTHREADS) { const int j = e >> 7, tau = e & 127;
        const float g = gb[e], pm = ib[e], bb = kap[e], mp = cs[128 + j], M = fmaxf(mp, pm);
        if (dvh == 0) { const int a = chunk_of_step(j, dir), t = dir ? 127 - tau : tau; float* tp = TAB + (size_t)(seq * 18 + a) * 512 + t;
            tp[0] = g; tp[128] = M; tp[256] = __expf(mp - M); tp[384] = __expf(-(bb + M)); }
        kap[e] = __expf(g - cs[96 + j]); }
    __syncthreads();

    const int r = lane & 31, hh = lane >> 5, i16 = lane & 15, q = i16 >> 2, p = i16 & 3, blk = (lane >> 4) & 1;
    const int dkt = wave & 3, dvt = wave >> 2;
    f32x16 acc;
#pragma unroll
    for (int i = 0; i < 16; ++i) acc[i] = 0.f;
    float nn = 0.f;
    v4u kA[4], vA[2], kB[4], vB[2];
    ST_LOAD(kA, vA, 0); ST_WRITE(kA, vA, 0); ST_LOAD(kB, vB, 1);
#pragma unroll 1
    for (int jj = 0; jj < 18; jj += 2) {
        ST_STEP(jj, kA, vA, kB, vB);
        ST_STEP(jj + 1, kB, vB, kA, vA);
    }
    __syncthreads();
}
#undef ST_LOAD
#undef ST_WRITE
#undef ST_STEP

template <int TB>
__device__ __forceinline__ void mlstm_weights(const f32x16 (&S)[4], bf16x8_t (&pb)[4][2], const LAS float* GA, int t, int hh, int lane, float qnf, float qnb, float& sff, float& sfb) {
    const float Mf = GA[128 + t], Mb = GA[512 + 128 + t];
    float rsf = 0.f, rsb = 0.f;
#pragma unroll
    for (int st = 0; st < 4; ++st) {
#pragma unroll
        for (int g = 0; g < 4; ++g) {
            const int s0 = 32 * st + 8 * g + 4 * hh;
            if (st < TB) { const f32x4 gv = *(const LAS f32x4*)(GA + s0);
#pragma unroll
                for (int e = 0; e < 4; ++e) rsf += S[st][4 * g + e] * __expf(gv[e] - Mf);
            } else if (st > TB) { const f32x4 gv = *(const LAS f32x4*)(GA + 512 + s0);
#pragma unroll
                for (int e = 0; e < 4; ++e) rsb += S[st][4 * g + e] * __expf(gv[e] - Mb);
            } else { const f32x4 gf = *(const LAS f32x4*)(GA + s0), gbv = *(const LAS f32x4*)(GA + 512 + s0);
#pragma unroll
                for (int e = 0; e < 4; ++e) { const float dts = (float)(t - (s0 + e));
                    const float wf = __expf(gf[e] - Mf + fminf(dts, 0.f) * 1e30f), wb = __expf(gbv[e] - Mb - fmaxf(dts, 0.f) * 1e30f);
                    rsf += S[st][4 * g + e] * wf; rsb += S[st][4 * g + e] * wb; }
            }
        }
        __builtin_amdgcn_sched_barrier(0);
    }
    rsf += lane_get(rsf, lane ^ 32); rsb += lane_get(rsb, lane ^ 32);
    const float alf = GA[256 + t], alb = GA[512 + 256 + t];
    const float invf = 1.0f / fmaxf(fabsf(alf * qnf + rsf), GA[384 + t]), invb = 1.0f / fmaxf(fabsf(alb * qnb + rsb), GA[512 + 384 + t]);
    sff = alf * invf; sfb = alb * invb;
    __builtin_amdgcn_sched_barrier(0);
    float Mf2 = Mf, Mb2 = Mb; asm volatile("" : "+v"(Mf2), "+v"(Mb2));
#pragma unroll
    for (int st = 0; st < 4; ++st) {
        float pv[16];
#pragma unroll
        for (int g = 0; g < 4; ++g) {
            const int s0 = 32 * st + 8 * g + 4 * hh;
            if (st < TB) { const f32x4 gv = *(const LAS f32x4*)(GA + s0);
#pragma unroll
                for (int e = 0; e < 4; ++e) pv[4 * g + e] = S[st][4 * g + e] * (__expf(gv[e] - Mf2) * invf);
            } else if (st > TB) { const f32x4 gv = *(const LAS f32x4*)(GA + 512 + s0);
#pragma unroll
                for (int e = 0; e < 4; ++e) pv[4 * g + e] = S[st][4 * g + e] * (__expf(gv[e] - Mb2) * invb);
            } else { const f32x4 gf = *(const LAS f32x4*)(GA + s0), gbv = *(const LAS f32x4*)(GA + 512 + s0);
#pragma unroll
                for (int e = 0; e < 4; ++e) { const float dts = (float)(t - (s0 + e));
                    const float wf = __expf(gf[e] - Mf2 + fminf(dts, 0.f) * 1e30f), wb = __expf(gbv[e] - Mb2 - fmaxf(dts, 0.f) * 1e30f);
                    pv[4 * g + e] = S[st][4 * g + e] * (wf * invf + wb * invb); }
            }
        }
#pragma unroll
        for (int sp = 0; sp < 2; ++sp) { v4u w; w.x = cvtpk(pv[8 * sp], pv[8 * sp + 1]); w.y = cvtpk(pv[8 * sp + 2], pv[8 * sp + 3]); w.z = cvtpk(pv[8 * sp + 4], pv[8 * sp + 5]); w.w = cvtpk(pv[8 * sp + 6], pv[8 * sp + 7]);
            pb[st][sp] = __builtin_bit_cast(bf16x8_t, w); }
        __builtin_amdgcn_sched_barrier(0);
    }
}

__device__ __forceinline__ void mlstm_out_phase(const bf16* Q, const bf16* K, const bf16* V, const bf16* OG, const bf16* CT, const float* NS, const float* TAB,
                                                const float* mg, bf16* Y, int abase, int G, LAS unsigned char* lds, int tid) {
    asm volatile("" : "+v"(tid));
    const int wave = __builtin_amdgcn_readfirstlane(tid >> 6);
    const int na = 18 - abase, nitems = 64 * na;
    int it = blockIdx.x;
    if (it >= nitems) return;
    LAS unsigned char* Kimg = lds; LAS unsigned char* Vimg = lds + 32768; LAS unsigned char* Cf = lds + 65536; LAS unsigned char* Cb = lds + 98304;
    LAS float* GA = (LAS float*)(lds + MX_OFF);
    LAS float* NSL = GA + 1024;
    LAS float* SSQ = NSL + 256;
    const int tb = wave & 3, dh = wave >> 2;
    v4u kr[4], vr[4], tabr; float nsr[4];
#define OUT_PREFETCH(item_) do { const int bh_ = (item_) / na, a_ = abase + (item_) % na, b_ = bh_ >> 2, h_ = bh_ & 3, row0_ = chunk_row0(b_, a_), sq_ = (b_ * 4 + h_) * 2; \
        _Pragma("unroll") for (int i = 0; i < 4; ++i) { const int pc = tid + NTHREADS * i; const size_t go = (size_t)(row0_ + (pc >> 4)) * HW + h_ * 128 + (pc & 15) * 8; kr[i] = *(const v4u*)(K + go); vr[i] = *(const v4u*)(V + go); } \
        if (tid < 256) tabr = *(const v4u*)(TAB + (size_t)((sq_ + (tid >> 7)) * 18 + a_) * 512 + (tid & 127) * 4); \
        else { const int e_ = tid - 256; const float* np_ = NS + (size_t)((sq_ + (e_ >> 7)) * 18 + a_) * 512 + (e_ & 127); nsr[0] = np_[0]; nsr[1] = np_[128]; nsr[2] = np_[256]; nsr[3] = np_[384]; } } while (0)
    OUT_PREFETCH(it);
#pragma unroll 1
    for (;;) {
        asm volatile("" : "+v"(tid));
        const int lane = tid & 63, r = lane & 31, hh = lane >> 5, i16 = lane & 15, q = i16 >> 2, p = i16 & 3, blk = (lane >> 4) & 1;
        const int t = 32 * tb + r;
        const int bh = it / na, a = abase + it % na, b = bh >> 2, h = bh & 3;
        const int row0 = chunk_row0(b, a), seqf = (b * 4 + h) * 2, seqb = seqf + 1;
#pragma unroll
        for (int i = 0; i < 4; ++i) { const int pc = tid + NTHREADS * i, so = swz_off(pc >> 4, pc & 15); *(LAS v4u*)(Kimg + so) = kr[i]; *(LAS v4u*)(Vimg + so) = vr[i]; }
        if (tid < 256) *(LAS v4u*)(GA + (tid >> 7) * 512 + (tid & 127) * 4) = tabr;
        else NSL[tid - 256] = (nsr[0] + nsr[1]) + (nsr[2] + nsr[3]);
        bf16x8_t qf[8];
#pragma unroll
        for (int ks = 0; ks < 8; ++ks) qf[ks] = *(const bf16x8_t*)(Q + (size_t)(row0 + t) * HW + h * 128 + 16 * ks + 8 * hh);
        __syncthreads();
        f32x16 S[4];
#pragma unroll
        for (int st = 0; st < 4; ++st)
#pragma unroll
            for (int i = 0; i < 16; ++i) S[st][i] = 0.f;
#pragma unroll
        for (int ks = 0; ks < 8; ++ks) {
#pragma unroll
            for (int st = 0; st < 4; ++st) { const bf16x8_t A = *(const LAS bf16x8_t*)(Kimg + swz_off(32 * st + r, 2 * ks + hh)); S[st] = MFMA32(A, qf[ks], S[st]); }
            __builtin_amdgcn_sched_barrier(0); }
        { const unsigned char* cfp = (const unsigned char*)(CT + (size_t)(seqf * 18 + a) * 16384); const unsigned char* cbp = (const unsigned char*)(CT + (size_t)(seqb * 18 + a) * 16384);
#pragma unroll
          for (int i = 0; i < 4; ++i) { const int n = 4 * wave + i, row = 4 * n + (lane >> 4), dc = (lane & 15) ^ (((row & 3) << 2) | ((row >> 2) & 3)); const int go = row * 256 + dc * 16;
              __builtin_amdgcn_global_load_lds((const unsigned*)(cfp + go), (LAS unsigned*)(Cf + n * 1024), 16, 0, 0);
              __builtin_amdgcn_global_load_lds((const unsigned*)(cbp + go), (LAS unsigned*)(Cb + n * 1024), 16, 0, 0); } }
        __builtin_amdgcn_sched_barrier(0);
        float qnf = 0.f, qnb = 0.f;
#pragma unroll
        for (int ks = 0; ks < 8; ++ks)
#pragma unroll
            for (int j = 0; j < 8; ++j) { const float qv = bf2f((unsigned short)qf[ks][j]); const int dk = 16 * ks + 8 * hh + j; qnf += qv * NSL[dk]; qnb += qv * NSL[128 + dk]; }
        qnf += lane_get(qnf, lane ^ 32); qnb += lane_get(qnb, lane ^ 32);
        __builtin_amdgcn_sched_barrier(0);
        bf16x8_t pb[4][2];
        float sff, sfb;
        switch (tb) {
            case 0: mlstm_weights<0>(S, pb, GA, t, hh, lane, qnf, qnb, sff, sfb); break;
            case 1: mlstm_weights<1>(S, pb, GA, t, hh, lane, qnf, qnb, sff, sfb); break;
            case 2: mlstm_weights<2>(S, pb, GA, t, hh, lane, qnf, qnb, sff, sfb); break;
            default: mlstm_weights<3>(S, pb, GA, t, hh, lane, qnf, qnb, sff, sfb); break;
        }
        __builtin_amdgcn_sched_barrier(0);
        const int itn = it + G; const bool more = itn < nitems;
        if (more) OUT_PREFETCH(itn);
        bf16x8_t qf2[8];
#pragma unroll
        for (int ks = 0; ks < 8; ++ks) qf2[ks] = *(const bf16x8_t*)(Q + (size_t)(row0 + t) * HW + h * 128 + 16 * ks + 8 * hh);
        __syncthreads();
        f32x16 Hc[2];
#pragma unroll
        for (int d = 0; d < 2; ++d)
#pragma unroll
            for (int i = 0; i < 16; ++i) Hc[d][i] = 0.f;
#pragma unroll
        for (int d = 0; d < 2; ++d) { const int dvt = 2 * dh + d;
#pragma unroll
            for (int st = 0; st < 4; ++st)
#pragma unroll
                for (int sp = 0; sp < 2; ++sp) { const int vrow = 32 * st + 16 * sp + 4 * hh + q, vch = 4 * dvt + 2 * blk + (p >> 1);
                    const bf16x8_t A = cat8(tr16(Vimg + swz_off(vrow, vch) + 8 * (p & 1)), tr16(Vimg + swz_off(vrow + 8, vch) + 8 * (p & 1))); Hc[d] = MFMA32(A, pb[st][sp], Hc[d]); if (sp) __builtin_amdgcn_sched_barrier(0); } }
        v2u ogr[2][4];
#pragma unroll
        for (int d = 0; d < 2; ++d)
#pragma unroll
            for (int g = 0; g < 4; ++g) ogr[d][g] = *(const v2u*)(OG + (size_t)(row0 + t) * HW + h * 128 + 32 * (2 * dh + d) + 8 * g + 4 * hh);
        __builtin_amdgcn_sched_barrier(0);
#pragma unroll
        for (int dd = 0; dd < 2; ++dd) {
            const float sfac = dd ? sfb : sff; const LAS unsigned char* Cimg = dd ? Cb : Cf;
            bf16x8_t qs[8];
#pragma unroll
            for (int ks = 0; ks < 8; ++ks) { v4u w;
                w.x = cvtpk(bf2f((unsigned short)qf2[ks][0]) * sfac, bf2f((unsigned short)qf2[ks][1]) * sfac); w.y = cvtpk(bf2f((unsigned short)qf2[ks][2]) * sfac, bf2f((unsigned short)qf2[ks][3]) * sfac);
                w.z = cvtpk(bf2f((unsigned short)qf2[ks][4]) * sfac, bf2f((unsigned short)qf2[ks][5]) * sfac); w.w = cvtpk(bf2f((unsigned short)qf2[ks][6]) * sfac, bf2f((unsigned short)qf2[ks][7]) * sfac);
                qs[ks] = __builtin_bit_cast(bf16x8_t, w); }
#pragma unroll
            for (int d = 0; d < 2; ++d) { const int dvt = 2 * dh + d;
#pragma unroll
                for (int ks = 0; ks < 8; ++ks) { const bf16x8_t A = *(const LAS bf16x8_t*)(Cimg + swz_off(32 * dvt + r, 2 * ks + hh)); Hc[d] = MFMA32(A, qs[ks], Hc[d]); if (ks & 1) __builtin_amdgcn_sched_barrier(0); } }
        }
        __builtin_amdgcn_sched_barrier(0);
        float ss = 0.f;
#pragma unroll
        for (int d = 0; d < 2; ++d)
#pragma unroll
            for (int i = 0; i < 16; ++i) ss += Hc[d][i] * Hc[d][i];
        ss += lane_get(ss, lane ^ 32);
        if (hh == 0) SSQ[dh * 128 + t] = ss;
        __syncthreads();
        const float rr = 1.0f / sqrtf((SSQ[t] + SSQ[128 + t]) * (1.0f / 128.0f) + EPS);
#pragma unroll
        for (int d = 0; d < 2; ++d)
#pragma unroll
            for (int g = 0; g < 4; ++g) { const int dv = 32 * (2 * dh + d) + 8 * g + 4 * hh;
                const v2u og = ogr[d][g]; const f32x4 gg = *(const f32x4*)(mg + h * 128 + dv);
                v2u o; o.x = cvtpk(Hc[d][4 * g] * rr * gg.x * bflo(og.x), Hc[d][4 * g + 1] * rr * gg.y * bfhi(og.x)); o.y = cvtpk(Hc[d][4 * g + 2] * rr * gg.z * bflo(og.y), Hc[d][4 * g + 3] * rr * gg.w * bfhi(og.y));
                *(v2u*)(Y + (size_t)(row0 + t) * D + h * 128 + dv) = o; }
        if (!more) break;
        it = itn;
    }
#undef OUT_PREFETCH
    __syncthreads();
}
__device__ __forceinline__ void sgu_item_mfma(const bf16* Z, const float* lg, const float* lb, const bf16* swb, const float* sb, bf16* Y, int chunk, LAS unsigned char* lds, int tid) {
    asm volatile("" : "+v"(tid));
    const int lane = tid & 63, wave = __builtin_amdgcn_readfirstlane(tid >> 6);
    const int row0 = chunk * 128;
    LAS unsigned char* VN = lds;
    {
        const int l16 = lane & 15, tq = lane >> 4;
        f32x4 gg[4], bb[4];
#pragma unroll
        for (int c = 0; c < 4; ++c) { gg[c] = *(const f32x4*)(lg + l16 * 16 + 4 * c); bb[c] = *(const f32x4*)(lb + l16 * 16 + 4 * c); }
        v4u raw[4][2];
#pragma unroll
        for (int tt = 0; tt < 4; ++tt) { const bf16* zp = Z + (size_t)(row0 + wave * 16 + 4 * tt + tq) * 512 + 256 + l16 * 16; raw[tt][0] = *(const v4u*)zp; raw[tt][1] = *(const v4u*)(zp + 8); }
#pragma unroll
        for (int tt = 0; tt < 4; ++tt) { const int t = wave * 16 + 4 * tt + tq;
            float x[16];
#pragma unroll
            for (int c = 0; c < 2; ++c) { x[8 * c] = bflo(raw[tt][c].x); x[8 * c + 1] = bfhi(raw[tt][c].x); x[8 * c + 2] = bflo(raw[tt][c].y); x[8 * c + 3] = bfhi(raw[tt][c].y);
                x[8 * c + 4] = bflo(raw[tt][c].z); x[8 * c + 5] = bfhi(raw[tt][c].z); x[8 * c + 6] = bflo(raw[tt][c].w); x[8 * c + 7] = bfhi(raw[tt][c].w); }
            float s = 0.f;
#pragma unroll
            for (int c = 0; c < 16; ++c) s += x[c];
            ROW_SUM16(s);
            const float mu = s * (1.0f / 256.0f); float vs = 0.f;
#pragma unroll
            for (int c = 0; c < 16; ++c) { x[c] -= mu; vs += x[c] * x[c]; }
            ROW_SUM16(vs);
            const float rs = 1.0f / sqrtf(vs * (1.0f / 256.0f) + EPS);
            v4u o0, o1;
            o0.x = cvtpk(x[0] * rs * gg[0].x + bb[0].x, x[1] * rs * gg[0].y + bb[0].y); o0.y = cvtpk(x[2] * rs * gg[0].z + bb[0].z, x[3] * rs * gg[0].w + bb[0].w);
            o0.z = cvtpk(x[4] * rs * gg[1].x + bb[1].x, x[5] * rs * gg[1].y + bb[1].y); o0.w = cvtpk(x[6] * rs * gg[1].z + bb[1].z, x[7] * rs * gg[1].w + bb[1].w);
            o1.x = cvtpk(x[8] * rs * gg[2].x + bb[2].x, x[9] * rs * gg[2].y + bb[2].y); o1.y = cvtpk(x[10] * rs * gg[2].z + bb[2].z, x[11] * rs * gg[2].w + bb[2].w);
            o1.z = cvtpk(x[12] * rs * gg[3].x + bb[3].x, x[13] * rs * gg[3].y + bb[3].y); o1.w = cvtpk(x[14] * rs * gg[3].z + bb[3].z, x[15] * rs * gg[3].w + bb[3].w);
            *(LAS v4u*)(VN + t * 512 + l16 * 32) = o0; *(LAS v4u*)(VN + t * 512 + l16 * 32 + 16) = o1; }
    }
    __syncthreads();
    const int r = lane & 31, hh = lane >> 5, i16 = lane & 15, q = i16 >> 2, p = i16 & 3, blk = (lane >> 4) & 1;
    const int g = wave >> 1, ct = wave & 1;
    bf16x8_t af[8];
#pragma unroll
    for (int ks = 0; ks < 8; ++ks) { const LAS unsigned char* va = VN + (16 * ks + 8 * hh + q) * 512 + 2 * (64 * g + 32 * ct + 16 * blk + 4 * p); af[ks] = cat8(tr16(va), tr16(va + 4 * 512)); }
    const bf16* wg = swb + (size_t)g * 128 * 128;
#pragma unroll 1
    for (int pt = 0; pt < 4; ++pt) {
        f32x16 acc;
#pragma unroll
        for (int i = 0; i < 16; ++i) acc[i] = 0.f;
        bf16x8_t bfr[8];
#pragma unroll
        for (int ks = 0; ks < 8; ++ks) bfr[ks] = *(const bf16x8_t*)(wg + (size_t)(32 * pt + r) * 128 + 16 * ks + 8 * hh);
#pragma unroll
        for (int ks = 0; ks < 8; ++ks) acc = MFMA32(af[ks], bfr[ks], acc);
        const int tok = row0 + 32 * pt + r;
        const float bs = sb[g * 128 + 32 * pt + r];
#pragma unroll
        for (int gq = 0; gq < 4; ++gq) { const int ch = 64 * g + 32 * ct + 8 * gq + 4 * hh;
            const v2u u = *(const v2u*)(Z + (size_t)tok * 512 + ch);
            v2u o; o.x = cvtpk(bflo(u.x) * (acc[4 * gq] + bs), bfhi(u.x) * (acc[4 * gq + 1] + bs)); o.y = cvtpk(bflo(u.y) * (acc[4 * gq + 2] + bs), bfhi(u.y) * (acc[4 * gq + 3] + bs));
            *(v2u*)(Y + (size_t)tok * D + 512 + ch) = o; }
    }
    __syncthreads();
}

__device__ __forceinline__ void conv_wave_item(const bf16* YC, const float* cw, const float* cb, float* CV, int item, int lane) {
    int base, stride, len, p0, ch0;
    if (item < 1024) { const int b = item >> 6, gr = (item >> 1) & 31; base = b * SEQ + gr * 64; stride = 1; len = 64; p0 = 32 * (item & 1); ch0 = 0; }
    else if (item < 2048) { const int it = item - 1024, b = it >> 6, c = it & 63; base = b * SEQ + c; stride = 64; len = 32; p0 = 0; ch0 = 128; }
    else { const int it = item - 2048, b = it >> 4, half = (it >> 3) & 1, sg = it & 7; base = ML + b * CTXL; stride = 1; len = 256; p0 = 32 * sg; ch0 = 128 * half; }
    const int ch = ch0 + 2 * lane;
    unsigned xin[62];
#pragma unroll
    for (int pp = 0; pp < 62; ++pp) { const int pos = p0 + pp - 15;
        xin[pp] = (pos >= 0 && pos < len) ? *(const unsigned*)(YC + (size_t)(base + pos * stride) * 256 + ch) : 0u; }
    f32x2 wk[31];
#pragma unroll
    for (int k = 0; k < 31; ++k) wk[k] = *(const f32x2*)(cw + k * 256 + ch);
    const f32x2 bias = *(const f32x2*)(cb + ch);
#pragma unroll
    for (int o = 0; o < 32; ++o) { f32x2 acc = bias;
#pragma unroll
        for (int k = 0; k < 31; ++k) { const unsigned w = xin[o + k]; acc.x += wk[k].x * bflo(w); acc.y += wk[k].y * bfhi(w); }
        *(f32x2*)(CV + (size_t)(base + (p0 + o) * stride) * 256 + ch) = acc; }
}

__device__ __forceinline__ void conv_finalize(const float* CV, const float* lg, const float* lb, bf16* Y, int nrows, int G, int tid) {
    asm volatile("" : "+v"(tid));
    const int lane = tid & 63, wave = __builtin_amdgcn_readfirstlane(tid >> 6);
    const int gw = blockIdx.x * NWAVES + wave, NGW = G * NWAVES;
    const int l16 = lane & 15, tq = lane >> 4;
    f32x4 gg[4], bb[4];
#pragma unroll
    for (int c = 0; c < 4; ++c) { gg[c] = *(const f32x4*)(lg + l16 * 16 + 4 * c); bb[c] = *(const f32x4*)(lb + l16 * 16 + 4 * c); }
#pragma unroll 2
    for (int r4 = gw; r4 < nrows / 4; r4 += NGW) {
        const int r = 4 * r4 + tq;
        f32x4 x[4];
#pragma unroll
        for (int c = 0; c < 4; ++c) x[c] = *(const f32x4*)(CV + (size_t)r * 256 + l16 * 16 + 4 * c);
        float s = 0.f;
#pragma unroll
        for (int c = 0; c < 4; ++c) s += (x[c].x + x[c].y) + (x[c].z + x[c].w);
        ROW_SUM16(s);
        const float mu = s * (1.0f / 256.0f); float vs = 0.f;
#pragma unroll
        for (int c = 0; c < 4; ++c) { x[c] = x[c] - mu; vs += (x[c].x * x[c].x + x[c].y * x[c].y) + (x[c].z * x[c].z + x[c].w * x[c].w); }
        ROW_SUM16(vs);
        const float rs = 1.0f / sqrtf(vs * (1.0f / 256.0f) + EPS);
        unsigned o[8];
#pragma unroll
        for (int c = 0; c < 4; ++c) { f32x4 y = x[c] * rs * gg[c] + bb[c];
            y.x *= fsigmoid(y.x); y.y *= fsigmoid(y.y); y.z *= fsigmoid(y.z); y.w *= fsigmoid(y.w);
            o[2 * c] = cvtpk(y.x, y.y); o[2 * c + 1] = cvtpk(y.z, y.w); }
        bf16* yp = Y + (size_t)r * D + 768 + l16 * 16;
        *(v4u*)yp = (v4u){o[0], o[1], o[2], o[3]}; *(v4u*)(yp + 8) = (v4u){o[4], o[5], o[6], o[7]};
    }
}
constexpr int N_PHASES = 18;
#ifndef MK_ONE_LAUNCH
#define MK_ONE_LAUNCH 0
#endif
#ifndef PH_MASK
#define PH_MASK 0x3ff
#endif
#ifndef REP_MASK
#define REP_MASK 0
#endif
#ifndef SUBREP
#define SUBREP 0
#endif
#define SUBREPS(b) ((((SUBREP) >> (b)) & 1) + 1)
#define PH_EN(b) (((PH_MASK) >> (b)) & 1)

__global__ void __launch_bounds__(NTHREADS, 2) fwd_kernel(Args args) {
    extern __shared__ __attribute__((aligned(16))) unsigned char lds_raw[];
    LAS unsigned char* lds = (LAS unsigned char*)lds_raw;
    const int G = gridDim.x;
    unsigned char* ws = args.ws;
    volatile LAS unsigned* MISC = (volatile LAS unsigned*)(lds + MISC_OFF);
    for (int u = threadIdx.x; u < (LDS_BYTES - RING_BYTES) / 4; u += NTHREADS) ((LAS unsigned*)(lds + RING_BYTES))[u] = 0u;
    __syncthreads();
    XcdBarrier bar; bar.bar = (unsigned*)(ws + WS_CTL) + 4096; bar.x = 0; bar.st = nullptr;
    const int lo = args.ph_lo, hi = args.ph_hi;
    if (hi - lo > 1) bar = xcd_barrier_post((unsigned*)(ws + WS_CTL) + 4096, MISC + 8);
#define IN(k) (lo <= (k) && (k) < hi)
#define SEAM(k) do { if (IN(k) && IN((k) + 1)) xcd_barrier(bar); } while (0)

#pragma unroll 1
    for (int ph = lo; ph < hi; ++ph) {
#if REP_MASK
#pragma unroll 1
      for (int rep = 0; rep < ((ph >= 1 && ph <= 16 && (((REP_MASK) >> ((ph - 1) & 7)) & 1)) ? 2 : 1); ++rep) {
#else
      {
#endif
        int tid = threadIdx.x; asm volatile("" : "+v"(tid));
        const int lane = tid & 63, wave = __builtin_amdgcn_readfirstlane(tid >> 6);
        if (ph == 0) { if (PH_EN(8)) phase_prologue(args, lds, G, tid, lane, wave); }
        else if (ph == N_PHASES - 1) { if (PH_EN(9)) phase_final(args.out, args.in[I_FG], G, lane, wave); }
        else {
            const int l = (ph - 1) >> 3, k = (ph - 1) & 7;
            {
            const bool last = (l == DEPTH - 1);
            const int mrest = last ? ML : MT;
            const float* modl = (const float*)(ws + WS_MOD) + (size_t)l * 17 * MODW;
            const unsigned char* wl = ws + WS_W + (size_t)l * W_LAYER;
            if (k == 0 && PH_EN(0)) {
                phase_norm(l == 0 ? args.in[I_X] : args.out, l == 0 ? args.in[I_CTX] : (const float*)(ws + WS_XC), (bf16*)(ws + WS_A), args.in[I_N1G] + l * D, modl, 0, MT, G, lane, wave);
            } else if (k == 1 && PH_EN(1)) {
                pg8::Gemm g{(const bf16*)(ws + WS_A), (const bf16*)(wl + WO_IN), MT, NIN, D}; pg8::StaticOrder S; S.init(MT, NIN, G, (int)blockIdx.x);
                pg8::EpiIn E{ws + WS_P, (const float*)(ws + WS_BIN) + l * NIN};
                pg8::gemm_phase<pg8::EpiIn, pg8::StaticOrder, true, true>(lds, g, S, E, tid);
            } else if (k == 2 && PH_EN(2)) {
                for (int rp = 0; rp < SUBREPS(0); ++rp)
                for (int it = blockIdx.x; it < 256; it += G)
                    mlstm_state_item((const bf16*)(ws + WS_K), (const bf16*)(ws + WS_V), (const float*)(ws + WS_GT), (bf16*)(ws + WS_CT), (float*)(ws + WS_NS), (float*)(ws + WS_TAB), it, !last, lds, tid);
                const int nch = mrest / 128;
                for (int rp = 0; rp < SUBREPS(1); ++rp)
                for (int it = blockIdx.x; it < nch; it += G)
                    sgu_item_mfma((const bf16*)(ws + WS_Z), args.in[I_SLG] + l * 256, args.in[I_SLB] + l * 256, (const bf16*)(ws + WS_SWB) + (size_t)l * 4 * 128 * 128, args.in[I_SB] + l * 4 * 128, (bf16*)(ws + WS_Y), it, lds, tid);
                { int tid2 = tid; asm volatile("" : "+v"(tid2)); const int lane2 = tid2 & 63, wave2 = __builtin_amdgcn_readfirstlane(tid2 >> 6);
                  const int ncv = last ? 2048 : 2304;
#pragma unroll 1
                  for (int rp = 0; rp < SUBREPS(2); ++rp)
#pragma unroll 1
                  for (int it = blockIdx.x * NWAVES + wave2; it < ncv; it += G * NWAVES)
                      conv_wave_item((const bf16*)(ws + WS_YC), args.in[I_CW] + l * 31 * 256, args.in[I_CB] + l * 256, (float*)(ws + WS_CV), it, lane2); }
            } else if (k == 3 && PH_EN(3)) {
                for (int rp = 0; rp < SUBREPS(3); ++rp)
                mlstm_out_phase((const bf16*)(ws + WS_Q), (const bf16*)(ws + WS_K), (const bf16*)(ws + WS_V), (const bf16*)(ws + WS_OG), (const bf16*)(ws + WS_CT), (const float*)(ws + WS_NS), (const float*)(ws + WS_TAB),
                                args.in[I_MG] + l * HW, (bf16*)(ws + WS_Y), last ? 2 : 0, G, lds, tid);
                for (int rp = 0; rp < SUBREPS(4); ++rp)
                conv_finalize((const float*)(ws + WS_CV), args.in[I_CLG] + l * 256, args.in[I_CLB] + l * 256, (bf16*)(ws + WS_Y), mrest, G, tid);
            } else if (k == 4 && PH_EN(4)) {
                pg8::Gemm g{(const bf16*)(ws + WS_Y), (const bf16*)(wl + WO_OUT), mrest, D, D}; pg8::StaticOrder S; S.init(mrest, D, G, (int)blockIdx.x);
                pg8::EpiRes E{l == 0 ? args.in[I_X] : args.out, args.out, l == 0 ? args.in[I_CTX] : (const float*)(ws + WS_XC), (float*)(ws + WS_XC), modl + 2 * D, ML};
                pg8::gemm_phase<pg8::EpiRes, pg8::StaticOrder, true, true>(lds, g, S, E, tid);
            } else if (k == 5 && PH_EN(5)) {
                phase_norm(args.out, (const float*)(ws + WS_XC), (bf16*)(ws + WS_A), args.in[I_N2G] + l * D, modl, 3 * D, mrest, G, lane, wave);
            } else if (k == 6 && PH_EN(6)) {
                pg8::Gemm g{(const bf16*)(ws + WS_A), (const bf16*)(wl + WO_GU), mrest, NGU, D}; pg8::StaticOrder S; S.init(mrest, NGU, G, (int)blockIdx.x);
                pg8::EpiGU E{(bf16*)(ws + WS_H)};
                pg8::gemm_phase<pg8::EpiGU, pg8::StaticOrder, true, true>(lds, g, S, E, tid);
            } else if (PH_EN(7)) {
                pg8::Gemm g{(const bf16*)(ws + WS_H), (const bf16*)(wl + WO_DOWN), mrest, D, FF}; pg8::StaticOrder S; S.init(mrest, D, G, (int)blockIdx.x);
                pg8::EpiRes E{args.out, args.out, (const float*)(ws + WS_XC), (float*)(ws + WS_XC), modl + 5 * D, ML};
                pg8::gemm_phase<pg8::EpiRes, pg8::StaticOrder, true, true>(lds, g, S, E, tid);
            }
            }
        }
      }
        if (ph + 1 < hi) xcd_barrier(bar);
    }
#undef IN
#undef SEAM
}

extern "C" void kernel_launch(void* const* d_in, const int* in_sizes, int n_in, void* d_out, int out_size, void* d_ws, size_t ws_size, hipStream_t stream) {
    static int grid = 0;
    if (grid == 0) {
        if (n_in != 23 || in_sizes[0] != ML * D || out_size != ML * D || ws_size < WS_END) {
            fprintf(stderr, "kernel_launch: unexpected problem (n_in %d, in0 %d, out %d, ws %zu < %zu); nothing launched\n", n_in, n_in > 0 ? in_sizes[0] : -1, out_size, ws_size, (size_t)WS_END); grid = -1; return; }
        int dev = 0, cus = 0, per_cu = 0;
        if (hipGetDevice(&dev) != hipSuccess || hipDeviceGetAttribute(&cus, hipDeviceAttributeMultiprocessorCount, dev) != hipSuccess) { grid = -1; return; }
        if (hipFuncSetAttribute((const void*)fwd_kernel, hipFuncAttributeMaxDynamicSharedMemorySize, LDS_BYTES) != hipSuccess) { fprintf(stderr, "kernel_launch: hipFuncSetAttribute failed\n"); grid = -1; return; }
        if (hipOccupancyMaxActiveBlocksPerMultiprocessor(&per_cu, (const void*)fwd_kernel, NTHREADS, LDS_BYTES) != hipSuccess || per_cu < 1) {
            fprintf(stderr, "kernel_launch: occupancy query reports %d blocks per CU\n", per_cu); per_cu = 1; }
        (void)hipGetLastError();
        grid = cus;
    }
    if (grid < 0) return;
    if (hipMemsetAsync((char*)d_ws + WS_CTL, 0, ZERO_BYTES, stream) != hipSuccess) { fprintf(stderr, "kernel_launch: memset failed\n"); return; }
    Args a{};
    for (int i = 0; i < 23; ++i) a.in[i] = (const float*)d_in[i];
    a.out = (float*)d_out; a.ws = (unsigned char*)d_ws;
#if MK_ONE_LAUNCH
    a.ph_lo = 0; a.ph_hi = N_PHASES;
    hipLaunchKernelGGL(fwd_kernel, dim3(grid), dim3(NTHREADS), LDS_BYTES, stream, a);
#else
    for (int p = 0; p < N_PHASES; ++p) { a.ph_lo = p; a.ph_hi = p + 1; hipLaunchKernelGGL(fwd_kernel, dim3(grid), dim3(NTHREADS), LDS_BYTES, stream, a); }
#endif
    const hipError_t le = hipPeekAtLastError();
    if (le != hipSuccess) fprintf(stderr, "kernel_launch: launch failed: %s\n", hipGetErrorName(le));
}
```

```cpp
#include <hip/hip_runtime.h>
#include <cstdio>
#include <cstdint>
#ifndef MK_ONE_LAUNCH
#define MK_ONE_LAUNCH 1
#endif
namespace pg8 {
#define PG8_LAS __attribute__((address_space(3)))
typedef unsigned short bf16_t;
typedef short bf16x8 __attribute__((ext_vector_type(8)));
typedef float f32x4 __attribute__((ext_vector_type(4)));
typedef unsigned u32x4 __attribute__((ext_vector_type(4)));
constexpr int BM = 256, BK = 64, HALF = 128, HTB = HALF * BK * 2  , STAGE_BYTES = 8 * HTB, NXCD = 8, WGM = 4;

__host__ __device__ __forceinline__ int lds_byte(int r, int c) { const int st = (r >> 4) * 2 + (c >> 5), rr = r & 15, cc = c & 31, ob = rr * 64 + cc * 2; return st * 1024 + (ob ^ (((ob >> 9) & 1) << 5)); }
__host__ __device__ __forceinline__ void stage_rc(int b, int& R, int& C) { const int st = b / 1024, sb = b % 1024, swz = sb ^ (((sb >> 9) & 1) << 5); R = (st >> 1) * 16 + swz / 64; C = (st & 1) * 32 + (swz % 64) / 2; }
__host__ __device__ __forceinline__ int perm32(int rho) { const int n = rho >> 4, i = rho & 15; return 8 * (i >> 2) + 4 * n + (i & 3); }

struct Unit { int pm, pn; };
struct Gemm { const bf16_t* A; const bf16_t* Bt; int M, N, K; };

struct StaticOrder {
    int nM, nN, nwg, G, c;
    __host__ __device__ void init(int M, int N, int G_, int c_) { nM = M / BM; nN = N / BM; nwg = nM * nN; G = G_; c = c_; }
    __host__ __device__ bool next(int i, Unit& u) const {
        const long L = (long)i * G + c; if (L >= nwg) return false;
        int wgid = (int)L; { const int q = nwg / NXCD, r = nwg % NXCD, xcd = wgid % NXCD, off = wgid / NXCD; wgid = (xcd < r ? xcd * (q + 1) : r * (q + 1) + (xcd - r) * q) + off; }
        const int nig = WGM * nN, gid = wgid / nig, fm = gid * WGM, gsz = (nM - fm) < WGM ? (nM - fm) : WGM;
        u.pm = fm + ((wgid % nig) % gsz); u.pn = (wgid % nig) / gsz; return true;
    }
    __device__ __forceinline__ void a_ready(const Unit&) const {}
    __device__ __forceinline__ void done(const Unit&) const {}
};

__device__ __forceinline__ unsigned cvt_pk_bf16(float lo, float hi) { unsigned r; asm volatile("v_cvt_pk_bf16_f32 %0, %1, %2" : "=v"(r) : "v"(lo), "v"(hi)); return r; }
template <class Epi, class Sched, bool ALIGN_EPI = false, bool SP2 = false>
__device__ __forceinline__ void gemm_phase(PG8_LAS unsigned char* lds, const Gemm g, const Sched& S, const Epi& E, const int tid) {
    const int wid = __builtin_amdgcn_readfirstlane(tid >> 6), lane = tid & 63, wr = wid >> 2, wc = wid & 3, fr = lane & 15, fq = lane >> 4;
    const int K = g.K, nt = K / BK;
    unsigned voffA[2], voffB[2];
#pragma unroll
    for (int i = 0; i < 2; ++i) { int R, C; stage_rc(tid * 16 + i * 8192, R, C); const int Rb = Epi::PERM ? ((R & ~31) + perm32(R & 31)) : R;
        voffA[i] = (unsigned)(R * K + C) * 2u; voffB[i] = (unsigned)(Rb * K + C) * 2u; }
    const size_t kstep = (size_t)(BK * 2);
    const size_t hstep = (size_t)HALF * K * 2;
    const size_t tstep = 2 * hstep;
    const unsigned ldsw = (unsigned)wid * 1024u;
    const int aoff = lds_byte(wr * 64 + fr, fq * 8), boff = lds_byte(wc * 32 + fr, fq * 8);
#define PG8_SA(b, h) (((b) * 2 + (h)) * HTB)
#define PG8_SB(b, h) ((4 + (b) * 2 + (h)) * HTB)
#define PG8_STAGE(bufoff, gbase, voff) do { _Pragma("unroll") for (int _i = 0; _i < 2; ++_i) \
        __builtin_amdgcn_global_load_lds((const unsigned*)((const char*)(gbase) + (voff)[_i]), (PG8_LAS unsigned*)(lds + (bufoff) + ldsw + _i * 8192), 16, 0, 0); } while (0)
#define PG8_LDA(dst, b, h) do { _Pragma("unroll") for (int m = 0; m < 4; ++m) _Pragma("unroll") for (int k = 0; k < 2; ++k) dst[m][k] = *(const PG8_LAS bf16x8*)(lds + PG8_SA(b, h) + aoff + m * 2048 + k * 1024); } while (0)
#define PG8_LDB(dst, b, h) do { _Pragma("unroll") for (int n = 0; n < 2; ++n) _Pragma("unroll") for (int k = 0; k < 2; ++k) dst[n][k] = *(const PG8_LAS bf16x8*)(lds + PG8_SB(b, h) + boff + n * 2048 + k * 1024); } while (0)
#define PG8_MMA(ai, bj, At, Bt) do { __builtin_amdgcn_s_setprio(1); _Pragma("unroll") for (int m = 0; m < 4; ++m) _Pragma("unroll") for (int n = 0; n < 2; ++n) _Pragma("unroll") for (int k = 0; k < 2; ++k) \
        acc[ai][bj][m][n] = __builtin_amdgcn_mfma_f32_16x16x32_bf16(Bt[n][k], At[m][k], acc[ai][bj][m][n], 0, 0, 0); __builtin_amdgcn_s_setprio(0); } while (0)
#define PG8_WAIT_V(n) asm volatile("s_waitcnt vmcnt(" #n ")" ::: "memory")
#define PG8_WAIT_L(n) asm volatile("s_waitcnt lgkmcnt(" #n ")" ::: "memory")
#define PG8_BAR __builtin_amdgcn_s_barrier()
#define PG8_SCHED __builtin_amdgcn_sched_barrier(0)
    Unit cur, nxt; int ui = 0;
    if (!S.next(0, cur)) return;
    f32x4 acc[2][2][4][2];
#pragma unroll
    for (int a = 0; a < 2; ++a)
#pragma unroll
        for (int b = 0; b < 2; ++b)
#pragma unroll
            for (int m = 0; m < 4; ++m)
#pragma unroll
                for (int n = 0; n < 2; ++n) acc[a][b][m][n] = (f32x4){0.f, 0.f, 0.f, 0.f};
    bf16x8 At[4][2], B0[2][2], B1[2][2];
    const char* cA = (const char*)g.A + (size_t)cur.pm * tstep; const char* cB = (const char*)g.Bt + (size_t)cur.pn * tstep;
    S.a_ready(cur);
    if constexpr (SP2) {
        PG8_STAGE(PG8_SB(0, 0), cB, voffB); PG8_STAGE(PG8_SB(0, 1), cB + hstep, voffB); PG8_STAGE(PG8_SA(0, 0), cA, voffA); PG8_STAGE(PG8_SA(0, 1), cA + hstep, voffA);
        if (wr == 1) PG8_BAR;
        PG8_WAIT_V(2); PG8_BAR;
        PG8_STAGE(PG8_SB(1, 0), cB + kstep, voffB); PG8_STAGE(PG8_SA(1, 0), cA + kstep, voffA); PG8_STAGE(PG8_SB(1, 1), cB + hstep + kstep, voffB);
        PG8_WAIT_V(6); PG8_BAR;
    } else {
        PG8_STAGE(PG8_SB(0, 0), cB, voffB); PG8_STAGE(PG8_SA(0, 0), cA, voffA); PG8_STAGE(PG8_SB(0, 1), cB + hstep, voffB); PG8_STAGE(PG8_SA(0, 1), cA + hstep, voffA);
        if (wr == 1) PG8_BAR;
        PG8_WAIT_V(4); PG8_BAR;
        PG8_STAGE(PG8_SB(1, 0), cB + kstep, voffB); PG8_STAGE(PG8_SA(1, 0), cA + kstep, voffA); PG8_STAGE(PG8_SB(1, 1), cB + hstep + kstep, voffB);
        PG8_WAIT_V(6); PG8_BAR;
    }
    for (;;) {
        const bool has_next = S.next(ui + 1, nxt);
        const char* nA = has_next ? (const char*)g.A + (size_t)nxt.pm * tstep : cA; const char* nB = has_next ? (const char*)g.Bt + (size_t)nxt.pn * tstep : cB;
        for (int t = 0; t < nt; t += 2) {
            const bool last = (t == nt - 2);
            const char* a1 = cA + (size_t)(t + 1) * kstep;
            const char* a2 = last ? nA : cA + (size_t)(t + 2) * kstep; const char* b2 = last ? nB : cB + (size_t)(t + 2) * kstep;
            const char* a3 = a2 + kstep; const char* b3 = b2 + kstep;
            if (last && has_next) S.a_ready(nxt);
            if constexpr (SP2) {
            PG8_LDB(B0, 0, 0); PG8_LDB(B1, 0, 1); PG8_SCHED; PG8_LDA(At, 0, 0); PG8_STAGE(PG8_SA(1, 1), a1 + hstep, voffA);
            PG8_WAIT_V(8); PG8_WAIT_L(0); PG8_BAR; PG8_MMA(0, 0, At, B0); PG8_MMA(0, 1, At, B1); PG8_BAR; PG8_SCHED;
            PG8_LDA(At, 0, 1); PG8_STAGE(PG8_SB(0, 0), b2, voffB); PG8_STAGE(PG8_SB(0, 1), b2 + hstep, voffB); PG8_STAGE(PG8_SA(0, 0), a2, voffA);
            PG8_WAIT_V(8); PG8_WAIT_L(0); PG8_BAR; PG8_MMA(1, 0, At, B0); PG8_MMA(1, 1, At, B1); PG8_BAR; PG8_SCHED;
            PG8_LDB(B0, 1, 0); PG8_LDB(B1, 1, 1); PG8_SCHED; PG8_LDA(At, 1, 0); PG8_STAGE(PG8_SA(0, 1), a2 + hstep, voffA);
            PG8_WAIT_V(8); PG8_WAIT_L(0); PG8_BAR; PG8_MMA(0, 0, At, B0); PG8_MMA(0, 1, At, B1); PG8_BAR; PG8_SCHED;
            PG8_LDA(At, 1, 1); PG8_STAGE(PG8_SB(1, 0), b3, voffB); PG8_STAGE(PG8_SB(1, 1), b3 + hstep, voffB); PG8_STAGE(PG8_SA(1, 0), a3, voffA);
            PG8_WAIT_V(8); PG8_WAIT_L(0); PG8_BAR; PG8_MMA(1, 0, At, B0); PG8_MMA(1, 1, At, B1); PG8_BAR; PG8_SCHED;
            } else {
            PG8_LDB(B0, 0, 0); PG8_SCHED; PG8_LDA(At, 0, 0); PG8_STAGE(PG8_SA(1, 1), a1 + hstep, voffA);
            PG8_WAIT_L(8); PG8_BAR; PG8_WAIT_L(0); PG8_MMA(0, 0, At, B0); PG8_BAR; PG8_SCHED;
            PG8_LDB(B1, 0, 1); PG8_STAGE(PG8_SB(0, 0), b2, voffB);
            PG8_BAR; PG8_WAIT_L(0); PG8_MMA(0, 1, At, B1); PG8_BAR;
            PG8_LDA(At, 0, 1); PG8_STAGE(PG8_SA(0, 0), a2, voffA);
            PG8_BAR; PG8_WAIT_L(0); PG8_MMA(1, 0, At, B0); PG8_BAR; PG8_SCHED;
            PG8_STAGE(PG8_SB(0, 1), b2 + hstep, voffB);
            PG8_WAIT_V(6); PG8_BAR; PG8_MMA(1, 1, At, B1); PG8_BAR;
            PG8_LDB(B0, 1, 0); PG8_SCHED; PG8_LDA(At, 1, 0); PG8_STAGE(PG8_SA(0, 1), a2 + hstep, voffA);
            PG8_WAIT_L(8); PG8_BAR; PG8_WAIT_L(0); PG8_MMA(0, 0, At, B0); PG8_BAR; PG8_SCHED;
            PG8_LDB(B1, 1, 1); PG8_STAGE(PG8_SB(1, 0), b3, voffB);
            PG8_BAR; PG8_WAIT_L(0); PG8_MMA(0, 1, At, B1); PG8_BAR;
            PG8_LDA(At, 1, 1); PG8_STAGE(PG8_SA(1, 0), a3, voffA);
            PG8_BAR; PG8_WAIT_L(0); PG8_MMA(1, 0, At, B0); PG8_BAR; PG8_SCHED;
            PG8_STAGE(PG8_SB(1, 1), b3 + hstep, voffB);
            PG8_WAIT_V(6); PG8_BAR; PG8_MMA(1, 1, At, B1); PG8_BAR;
            }
        }
        if constexpr (ALIGN_EPI) { if (wr == 0) PG8_BAR; }
        if constexpr (!Epi::AFTER_DRAIN) { E(acc, cur, wr, wc, fr, fq); S.done(cur); }
        if (!has_next) break;
#pragma unroll
        for (int a = 0; a < 2; ++a)
#pragma unroll
            for (int b = 0; b < 2; ++b)
#pragma unroll
                for (int m = 0; m < 4; ++m)
#pragma unroll
                    for (int n = 0; n < 2; ++n) acc[a][b][m][n] = (f32x4){0.f, 0.f, 0.f, 0.f};
        cur = nxt; cA = nA; cB = nB; ++ui;
        if constexpr (ALIGN_EPI) { if (wr == 1) PG8_BAR; }
    }
    PG8_WAIT_V(0);
    if constexpr (!ALIGN_EPI) { if (wr == 0) PG8_BAR; }
    PG8_BAR;
    if constexpr (Epi::AFTER_DRAIN) { E.fused(acc, cur, wr, wc, fr, fq, lds, wid, lane); S.done(cur); }
#undef PG8_SA
#undef PG8_SB
#undef PG8_STAGE
#undef PG8_LDA
#undef PG8_LDB
#undef PG8_MMA
#undef PG8_WAIT_V
#undef PG8_WAIT_L
#undef PG8_BAR
#undef PG8_SCHED
}
}
namespace pg8 {
struct InLastOrder {
    StaticOrder main; int G, c;
    int ntail;
    __device__ void init(bool last, int G_, int c_) { main.init((last ? 128 : 144) * BM, 13 * BM, G_, c_); G = G_; c = c_; ntail = last ? 80 : 0; }
    __device__ bool next(int i, Unit& u) const {
        const long L = (long)i * G + c;
        if (L < main.nwg) return main.next(i, u);
        const int e = (int)(L - main.nwg); if (e >= ntail) return false;
        const int q = e % 5; u.pm = 128 + e / 5; u.pn = q < 4 ? 2 + q : 12; return true;
    }
    __device__ __forceinline__ void a_ready(const Unit&) const {}
    __device__ __forceinline__ void done(const Unit&) const {}
};
__device__ __forceinline__ u32x4 pack8(const f32x4& v0, const f32x4& v1) { u32x4 w; w.x = cvt_pk_bf16(v0[0], v0[1]); w.y = cvt_pk_bf16(v0[2], v0[3]); w.z = cvt_pk_bf16(v1[0], v1[1]); w.w = cvt_pk_bf16(v1[2], v1[3]); return w; }
__device__ __forceinline__ float sigm(float x) { return __builtin_amdgcn_rcpf(1.0f + __expf(-x)); }
__device__ __forceinline__ f32x4 sigm4(const f32x4& v) { return (f32x4){sigm(v[0]), sigm(v[1]), sigm(v[2]), sigm(v[3])}; }
__device__ __forceinline__ float gelu_t(float x) { const float u = 1.5957691216057308f * (x + 0.044715f * x * x * x); return x * sigm(u); }
__device__ __forceinline__ f32x4 gelu4(const f32x4& v) { return (f32x4){gelu_t(v[0]), gelu_t(v[1]), gelu_t(v[2]), gelu_t(v[3])}; }

struct EpiIn {
    static constexpr bool PERM = true, AFTER_DRAIN = false;
    unsigned char* P; const float* bias; int bstride; const float* ss;
    __device__ __forceinline__ void operator()(const f32x4 (&acc)[2][2][4][2], const Unit& u, int wr, int wc, int fr, int fq) const {
        const int pn = u.pn, row0 = u.pm * BM + wr * 64 + fr, cl = wc * 32 + 8 * fq;
        const float* bp = bias + (size_t)(u.pm < 128 ? (u.pm >> 3) : 16) * bstride;
        f32x4 bv[2][2];
#pragma unroll
        for (int bj = 0; bj < 2; ++bj)
#pragma unroll
            for (int n = 0; n < 2; ++n) bv[bj][n] = *(const f32x4*)(bp + pn * BM + bj * HALF + cl + 4 * n);
        float rsc[2][4];
#pragma unroll
        for (int ai = 0; ai < 2; ++ai)
#pragma unroll
            for (int m = 0; m < 4; ++m) rsc[ai][m] = ss ? 1.0f / sqrtf(ss[row0 + ai * HALF + m * 16] * (1.0f / 1024.0f) + 1e-6f) : 1.0f;
        if (pn < 10) {
            bf16_t* base = (bf16_t*)(P + (size_t)(pn >> 1) * (36u << 20));
            const float sc = (pn >= 2 && pn < 4) ? 0.08838834764831845f : 1.0f;
            const int act = pn < 6 ? 0 : pn < 8 ? 1 : 2;
            const int dcol = (pn & 1) * BM + cl;
#pragma unroll
            for (int ai = 0; ai < 2; ++ai)
#pragma unroll
                for (int m = 0; m < 4; ++m) { bf16_t* rowp = base + (size_t)(row0 + ai * HALF + m * 16) * 512 + dcol;
#pragma unroll
                    for (int bj = 0; bj < 2; ++bj) { f32x4 v0 = acc[ai][bj][m][0] * rsc[ai][m] + bv[bj][0], v1 = acc[ai][bj][m][1] * rsc[ai][m] + bv[bj][1];
                        if (act == 1) { v0 = sigm4(v0); v1 = sigm4(v1); } else if (act == 2) { v0 = gelu4(v0); v1 = gelu4(v1); } else { v0 = v0 * sc; v1 = v1 * sc; }
                        *(u32x4*)(rowp + bj * HALF) = pack8(v0, v1); } }
        } else if (pn < 12) {
            const int dcol = (pn - 10) * HALF + cl;
#pragma unroll
            for (int ai = 0; ai < 2; ++ai)
#pragma unroll
                for (int m = 0; m < 4; ++m) { bf16_t* rowp = (bf16_t*)(P + (size_t)5 * (36u << 20)) + (size_t)(row0 + ai * HALF + m * 16) * 256 + dcol;
                    const f32x4 a0 = acc[ai][0][m][0] * rsc[ai][m] + bv[0][0], a1 = acc[ai][0][m][1] * rsc[ai][m] + bv[0][1];
                    const f32x4 g0 = sigm4(acc[ai][1][m][0] * rsc[ai][m] + bv[1][0]), g1 = sigm4(acc[ai][1][m][1] * rsc[ai][m] + bv[1][1]);
                    *(u32x4*)rowp = pack8(a0 * g0, a1 * g1); }
        } else {
            if (wc == 0 && fq < 2) {
#pragma unroll
                for (int ai = 0; ai < 2; ++ai)
#pragma unroll
                    for (int m = 0; m < 4; ++m) { float* rowp = (float*)(P + (size_t)5 * (36u << 20) + (18u << 20)) + (size_t)(row0 + ai * HALF + m * 16) * 16 + 8 * fq;
                        *(f32x4*)rowp = acc[ai][0][m][0] * rsc[ai][m] + bv[0][0]; *(f32x4*)(rowp + 4) = acc[ai][0][m][1] * rsc[ai][m] + bv[0][1]; }
            }
        }
    }
};

struct EpiGU {
    static constexpr bool PERM = true, AFTER_DRAIN = false;
    bf16_t* H; const float* ss; const float* shb;
    __device__ __forceinline__ void operator()(const f32x4 (&acc)[2][2][4][2], const Unit& u, int wr, int wc, int fr, int fq) const {
        const int row0 = u.pm * BM + wr * 64 + fr, cl = wc * 32 + 8 * fq, dcol = u.pn * HALF + cl;
        f32x4 sg0 = {0.f, 0.f, 0.f, 0.f}, sg1 = sg0, su0 = sg0, su1 = sg0;
        if (shb) { const float* sp = shb + (size_t)(u.pm < 128 ? (u.pm >> 3) : 16) * 5632 + u.pn * BM + cl; sg0 = *(const f32x4*)sp; sg1 = *(const f32x4*)(sp + 4); su0 = *(const f32x4*)(sp + HALF); su1 = *(const f32x4*)(sp + HALF + 4); }
#pragma unroll
        for (int ai = 0; ai < 2; ++ai)
#pragma unroll
            for (int m = 0; m < 4; ++m) { const int row = row0 + ai * HALF + m * 16; bf16_t* rowp = H + (size_t)row * 2816 + dcol;
                const float rs = ss ? 1.0f / sqrtf(ss[row] * (1.0f / 1024.0f) + 1e-6f) : 1.0f;
                const f32x4 g0 = acc[ai][0][m][0] * rs + sg0, g1 = acc[ai][0][m][1] * rs + sg1;
                *(u32x4*)rowp = pack8(g0 * sigm4(g0) * (acc[ai][1][m][0] * rs + su0), g1 * sigm4(g1) * (acc[ai][1][m][1] * rs + su1)); }
    }
};

template <bool WA2> struct EpiRes {
    static constexpr bool PERM = false, AFTER_DRAIN = false;
    const float* baseL; float* outL; const float* baseC; float* outC; const float* gate; int nlat;
    bf16_t* A2; const float* gs; float* ss;
    PG8_LAS unsigned char* xl;
    __device__ __forceinline__ void operator()(const f32x4 (&acc)[2][2][4][2], const Unit& u, int wr, int wc, int fr, int fq) const {
        const int trow = u.pm * BM; const bool lat = trow < nlat;
        const char* base = (const char*)(lat ? baseL + (size_t)trow * 1024 : baseC + (size_t)(trow - nlat) * 1024);
        char* out = (char*)(lat ? outL + (size_t)trow * 1024 : outC + (size_t)(trow - nlat) * 1024);
        char* ap = (char*)(A2 + (size_t)trow * 1024);
        const int mrow = lat ? (trow >> 11) : 16;
        const float* gv = gate + (size_t)mrow * 6144; const float* gsv = gs + (size_t)mrow * 1024;
        PG8_LAS float* sl = (PG8_LAS float*)(xl + (wr * 4 + wc) * 2304);
        const int lane = fr + 16 * fq, rr = lane >> 3, cq = lane & 7;
        const int colm = u.pn * BM + wc * 32 + 4 * fq;
        const int colr = u.pn * BM + wc * 32 + 4 * cq;
        f32x4 g[2][2], gsc[2];
#pragma unroll
        for (int bj = 0; bj < 2; ++bj) { gsc[bj] = WA2 ? *(const f32x4*)(gsv + colr + bj * HALF) : (f32x4){0.f, 0.f, 0.f, 0.f};
#pragma unroll
            for (int n = 0; n < 2; ++n) g[bj][n] = *(const f32x4*)(gv + colm + bj * HALF + n * 16); }
        const unsigned lo = (unsigned)((wr * 64 + rr) * 1024 + colr) * 4u;
        f32x4 bv[2][2][2];
#define ER_LOAD(gi) do { _Pragma("unroll") for (int bj = 0; bj < 2; ++bj) _Pragma("unroll") for (int ps = 0; ps < 2; ++ps) \
            bv[(gi) & 1][bj][ps] = *(const f32x4*)(base + (size_t)(lo + (unsigned)(((((gi) >> 2) * HALF + ((gi) & 3) * 16 + 8 * ps) * 1024 + bj * HALF) * 4))); } while (0)
        ER_LOAD(0);
#pragma unroll
        for (int gi = 0; gi < 8; ++gi) { const int ai = gi >> 2, m = gi & 3;
            float q0 = 0.f, q1 = 0.f;
            f32x4 o[2][2];
#pragma unroll
            for (int bj = 0; bj < 2; ++bj) {
                *(PG8_LAS f32x4*)(sl + fr * 36 + 4 * fq) = g[bj][0] * acc[ai][bj][m][0]; *(PG8_LAS f32x4*)(sl + fr * 36 + 16 + 4 * fq) = g[bj][1] * acc[ai][bj][m][1];
                o[bj][0] = bv[gi & 1][bj][0] + *(const PG8_LAS f32x4*)(sl + rr * 36 + 4 * cq); o[bj][1] = bv[gi & 1][bj][1] + *(const PG8_LAS f32x4*)(sl + (rr + 8) * 36 + 4 * cq);
            }
            asm volatile("" ::: "memory");
            if (gi < 7) ER_LOAD(gi + 1);
            asm volatile("" ::: "memory");
#pragma unroll
            for (int bj = 0; bj < 2; ++bj)
#pragma unroll
                for (int ps = 0; ps < 2; ++ps) { const unsigned off = lo + (unsigned)((((ai * HALF + m * 16 + 8 * ps) * 1024) + bj * HALF) * 4); const f32x4 v = o[bj][ps];
                    *(f32x4*)(out + (size_t)off) = v;
                    if (WA2) { const float qq = (v[0] * v[0] + v[1] * v[1]) + (v[2] * v[2] + v[3] * v[3]); if (ps) q1 += qq; else q0 += qq; const f32x4 a = v * gsc[bj];
                        typedef unsigned u32x2v __attribute__((ext_vector_type(2))); u32x2v w; w.x = cvt_pk_bf16(a[0], a[1]); w.y = cvt_pk_bf16(a[2], a[3]);
                        *(u32x2v*)(ap + (size_t)(off >> 1)) = w; } }
            if (WA2) {
                q0 += __shfl_xor(q0, 1); q0 += __shfl_xor(q0, 2); q0 += __shfl_xor(q0, 4); q1 += __shfl_xor(q1, 1); q1 += __shfl_xor(q1, 2); q1 += __shfl_xor(q1, 4);
                if (cq == 0) { float* sp = ss + trow + wr * 64 + ai * HALF + m * 16 + rr; atomicAdd(sp, q0); atomicAdd(sp + 8, q1); } }
            asm volatile("" ::: "memory");
        }
#undef ER_LOAD
    }
};
}
constexpr int D = 1024, NB = 16, SEQ = 2048, CTXL = 256, DEPTH = 2;
constexpr int ML = NB * SEQ, MC = NB * CTXL, MT = ML + MC;
constexpr int NIN_O = 3088, NIN = 3328, FF = 2816, NGU = 2 * FF;
constexpr int HW = 512;
constexpr int MODW = 6 * D;
constexpr float EPS = 1e-6f;
constexpr int NWAVES = 8, NTHREADS = 512;

constexpr size_t MiB = 1u << 20;
constexpr size_t WS_CTL = 0;
constexpr size_t WS_MOD = 1 * MiB;
constexpr size_t WS_SHGU = 2 * MiB;
constexpr size_t WS_SHIN = 2 * MiB + 768 * 1024;
constexpr size_t WS_SS = 3 * MiB;
constexpr size_t ZERO_BYTES = 3 * MiB + 512 * 1024;
constexpr size_t WS_BIN = 3 * MiB + 512 * 1024;
constexpr size_t WS_SWB = WS_BIN + 65536;
constexpr size_t WS_GS = 4 * MiB;
constexpr size_t WS_W = 5 * MiB, W_LAYER = 25 * MiB;
constexpr size_t WO_IN = 0, WO_OUT = 6 * MiB + 512 * 1024, WO_GU = WO_OUT + 2 * MiB, WO_DOWN = WO_GU + 11 * MiB;
constexpr size_t WS_XC = 55 * MiB;
constexpr size_t WS_A = 71 * MiB;
constexpr size_t WS_P = 143 * MiB;
constexpr size_t WS_Q = WS_P, WS_K = WS_Q + 36 * MiB, WS_V = WS_K + 36 * MiB, WS_OG = WS_V + 36 * MiB, WS_Z = WS_OG + 36 * MiB, WS_YC = WS_Z + 36 * MiB, WS_GT = WS_YC + 18 * MiB;
constexpr size_t WS_H = WS_P;
constexpr size_t WS_Y = 344 * MiB;
constexpr size_t WS_CT = WS_A;
constexpr size_t WS_NS = 454 * MiB, WS_TAB = 460 * MiB;
constexpr size_t WS_CV = 418 * MiB;
constexpr size_t WS_END = 486 * MiB;
static_assert(WS_GT + (size_t)MT * 16 * 4 <= WS_Y && WS_H + (size_t)MT * FF * 2 <= WS_Y && WS_W + 2 * W_LAYER <= WS_XC && WO_DOWN + (size_t)D * FF * 2 <= W_LAYER && WS_Y + (size_t)MT * D * 2 <= WS_CV && WS_SS + 3 * (size_t)MT * 4 <= ZERO_BYTES && WS_SHIN + 17 * (size_t)NIN * 4 <= WS_SS && WS_SHGU + 2 * 17 * (size_t)NGU * 4 <= WS_SHIN && WS_GS + 4 * 17 * 1024 * 4 <= WS_W, "ws map");

constexpr int RING_BYTES = 131072, MISC_OFF = RING_BYTES + 320, LDS_BYTES = 151552;

#define GAS __attribute__((address_space(1)))
#define LAS __attribute__((address_space(3)))
typedef unsigned short bf16;
typedef unsigned v4u __attribute__((ext_vector_type(4)));
typedef unsigned v2u __attribute__((ext_vector_type(2)));
typedef float f32x4 __attribute__((ext_vector_type(4)));
typedef float f32x2 __attribute__((ext_vector_type(2)));
#define LDS_WAIT() asm volatile("s_waitcnt lgkmcnt(0)" ::: "memory")
__device__ __forceinline__ unsigned f2bf(float f) { unsigned u = __builtin_bit_cast(unsigned, f); return (u + 0x7fffu + ((u >> 16) & 1u)) >> 16; }
__device__ __forceinline__ unsigned pk2(float lo, float hi) { return f2bf(lo) | (f2bf(hi) << 16); }
__device__ __forceinline__ float bf2f(unsigned short b) { return __builtin_bit_cast(float, (unsigned)b << 16); }
__device__ __forceinline__ float bflo(unsigned w) { return __builtin_bit_cast(float, w << 16); }
__device__ __forceinline__ float bfhi(unsigned w) { return __builtin_bit_cast(float, w & 0xffff0000u); }
__device__ __forceinline__ float fsigmoid(float x) { return __builtin_amdgcn_rcpf(1.0f + __expf(-x)); }
__device__ __forceinline__ float wave_sum(float v) {
#pragma unroll
    for (int o = 1; o < 64; o <<= 1) v += __shfl_xor(v, o);
    return v;
}
__device__ __forceinline__ int modrow_of(int row) { return row < ML ? (row >> 11) : 16; }
#define XB_TMO      128
#define XB_XCNT(j)  (256  + 64 * (j))
#define XB_XSUB(j)  (1280 + 64 * (j))
#define XB_XGEN(j)  (2304 + 64 * (j))
#define XB_TOP      3328
#define XB_TOPGEN   3392
#define XCD_BAR_WORDS 3456
#define XB_SPIN_CAP (1u << 18)

__device__ __forceinline__ unsigned xb_ld(unsigned* p)              { return __hip_atomic_load(p, __ATOMIC_RELAXED, __HIP_MEMORY_SCOPE_AGENT); }
__device__ __forceinline__ unsigned xb_add(unsigned* p, unsigned v) { return __hip_atomic_fetch_add(p, v, __ATOMIC_RELAXED, __HIP_MEMORY_SCOPE_AGENT); }
__device__ __forceinline__ unsigned xb_xcc_id() { return (unsigned)__builtin_amdgcn_s_getreg((3 << 11) | 20) & 0xFu; }
#define XB_SPIN(cond, bar) do { unsigned _sp = 0; while (cond) { __builtin_amdgcn_s_sleep(1); \
    if ((++_sp & 255u) == 0u) { if (xb_ld(&(bar)[XB_TMO])) break; if (_sp > XB_SPIN_CAP) { atomicAdd(&(bar)[XB_TMO], 1u); break; } } } } while (0)

struct XcdBarrier {
    unsigned* bar; unsigned x;
    volatile LAS unsigned* st;
};

__device__ __forceinline__ XcdBarrier xcd_barrier_post(unsigned* bar, volatile LAS unsigned* st) {
    XcdBarrier b; b.bar = bar; b.x = xb_xcc_id(); b.st = st;
    if (threadIdx.x == 0) (void)xb_add(&bar[XB_XCNT(b.x)], 1u);
    return b;
}
__device__ __forceinline__ void xcd_barrier_complete(unsigned* bar, unsigned x, unsigned& nloc, unsigned& nx) {
    const unsigned G = gridDim.x * gridDim.y * gridDim.z;
    unsigned sum, cnt, mine, sp = 0u;
    for (;;) {
        sum = 0u; cnt = 0u; mine = 0u;
#pragma unroll
        for (unsigned j = 0; j < 16; ++j) { const unsigned c = xb_ld(&bar[XB_XCNT(j)]); sum += c; cnt += (c > 0u) ? 1u : 0u; mine = (j == x) ? c : mine; }
        if (sum == G) break;
        __builtin_amdgcn_s_sleep(1);
        if ((++sp & 255u) == 0u) { if (xb_ld(&bar[XB_TMO])) break; if (sp > XB_SPIN_CAP) { atomicAdd(&bar[XB_TMO], 1u); break; } }
    }
    nloc = mine > 0u ? mine : 1u; nx = cnt > 0u ? cnt : 1u;
}

__device__ __forceinline__ void xcd_barrier(const XcdBarrier& b) {
    asm volatile("s_waitcnt vmcnt(0)" ::: "memory");
    __syncthreads();
    if (threadIdx.x == 0) {
        unsigned* bar = b.bar;
        __builtin_amdgcn_s_waitcnt(0);
        unsigned nloc = b.st[0], nx = b.st[1];
        if (nloc == 0u) { xcd_barrier_complete(bar, b.x, nloc, nx); b.st[0] = nloc; b.st[1] = nx; }
        const unsigned old = xb_add(&bar[XB_XSUB(b.x)], 1u);
        const unsigned gen = old / nloc;
        if (old + 1u == (gen + 1u) * nloc) {
            __builtin_amdgcn_fence(__ATOMIC_RELEASE, "agent");
            asm volatile("s_waitcnt vmcnt(0)" ::: "memory");
            const unsigned og = xb_add(&bar[XB_TOP], 1u);
            const unsigned tg = og / nx;
            if (og + 1u == (tg + 1u) * nx) xb_add(&bar[XB_TOPGEN], 1u);
            else XB_SPIN(xb_ld(&bar[XB_TOPGEN]) == tg, bar);
            __builtin_amdgcn_fence(__ATOMIC_ACQUIRE, "agent");
            xb_add(&bar[XB_XGEN(b.x)], 1u);
            asm volatile("s_waitcnt vmcnt(0)" ::: "memory");
        } else {
            XB_SPIN(xb_ld(&bar[XB_XGEN(b.x)]) == gen, bar);
            __builtin_amdgcn_fence(__ATOMIC_ACQUIRE, "agent");
            asm volatile("s_waitcnt vmcnt(0)" ::: "memory");
        }
    }
    __syncthreads();
}

struct Args { const float* in[23]; float* out; unsigned char* ws; int ph_lo, ph_hi; };
enum { I_X = 0, I_C, I_CTX, I_CCTX, I_WMOD, I_BMOD, I_N1G, I_WIN, I_BIN, I_MG, I_SLG, I_SLB, I_SW, I_SB, I_CW, I_CB, I_CLG, I_CLB, I_WOUT, I_N2G, I_WGU, I_WDOWN, I_FG };

__device__ __forceinline__ int win_src_col(int n) {
    if (n < 2048) return n;
    if (n < 2560) return n + 16;
    if (n < 3072) { const int j = n - 2560, tile = j >> 8, jj = j & 255; return 2576 + (jj >> 7) * 256 + tile * 128 + (jj & 127); }
    if (n < 3088) return 2048 + (n - 3072);
    return -1;
}
__device__ __forceinline__ int wgu_src_col(int n) { const int tile = n >> 8, jj = n & 255; return (jj >> 7) * FF + tile * 128 + (jj & 127); }

__device__ __forceinline__ void transpose_item(const float* W, int K, int Nsrc, bf16* WT, int n0, int srcc0, int nvalid, int k0, LAS float* scr, int lane) {
    const int c = lane & 31;
#pragma unroll 8
    for (int i = 0; i < 32; ++i) { const int kk = 2 * i + (lane >> 5);
        float v = 0.f; if (srcc0 >= 0 && c < nvalid) v = W[(size_t)(k0 + kk) * Nsrc + srcc0 + c];
        scr[kk * 33 + c] = v; }
    LDS_WAIT(); asm volatile("" ::: "memory");
    const int c8 = lane & 7;
#pragma unroll
    for (int j = 0; j < 4; ++j) { const int n = (lane >> 3) + 8 * j; const LAS float* s = scr + (8 * c8) * 33 + n;
        v4u o; o.x = pk2(s[0 * 33], s[1 * 33]); o.y = pk2(s[2 * 33], s[3 * 33]); o.z = pk2(s[4 * 33], s[5 * 33]); o.w = pk2(s[6 * 33], s[7 * 33]);
        *(v4u*)(WT + (size_t)(n0 + n) * K + k0 + 8 * c8) = o; }
    LDS_WAIT(); asm volatile("" ::: "memory");
}

__device__ __forceinline__ void gemv17_cols(const LAS float* SL, LAS float* RED, const float* W, int N, int j0, int tid) {
    const int lane = tid & 63, wave = __builtin_amdgcn_readfirstlane(tid >> 6);
    const int j = j0 + lane; const bool ok = j < N;
    float acc[17];
#pragma unroll
    for (int r = 0; r < 17; ++r) acc[r] = 0.f;
    const float* wp = W + (size_t)(wave * 128) * N + (ok ? j : 0);
    const LAS float* sp = SL + wave * 128 * 20;
#pragma unroll 8
    for (int k = 0; k < 128; ++k) { const float w = ok ? wp[(size_t)k * N] : 0.f;
        const LAS f32x4* s4 = (const LAS f32x4*)(sp + k * 20);
        const f32x4 a = s4[0], b = s4[1], c = s4[2], d = s4[3]; const float e = sp[k * 20 + 16];
        acc[0] += a.x * w; acc[1] += a.y * w; acc[2] += a.z * w; acc[3] += a.w * w; acc[4] += b.x * w; acc[5] += b.y * w; acc[6] += b.z * w; acc[7] += b.w * w;
        acc[8] += c.x * w; acc[9] += c.y * w; acc[10] += c.z * w; acc[11] += c.w * w; acc[12] += d.x * w; acc[13] += d.y * w; acc[14] += d.z * w; acc[15] += d.w * w; acc[16] += e * w; }
#pragma unroll
    for (int r = 0; r < 17; ++r) RED[(wave * 17 + r) * 64 + lane] = acc[r];
}
__device__ __forceinline__ float gemv17_sum(const LAS float* RED, int e) {
    float s = 0.f;
#pragma unroll
    for (int w = 0; w < 8; ++w) s += RED[w * 17 * 64 + e];
    return s;
}

__device__ __forceinline__ void phase_prologue(const Args& a, LAS unsigned char* lds, int G, int tid, int lane, int wave) {
    unsigned char* ws = a.ws;
    LAS float* scr = (LAS float*)(lds + wave * 16384);
    const int gw = blockIdx.x * NWAVES + wave, NGW = G * NWAVES;
    constexpr int I_IN = 16 * (NIN / 32), I_OUT = 16 * 32, I_GU = 16 * (NGU / 32), I_DN = (FF / 64) * 32, I_LAYER = I_IN + I_OUT + I_GU + I_DN;
    for (int it = gw; it < 2 * I_LAYER; it += NGW) {
        const int l = it / I_LAYER; int r = it % I_LAYER;
        unsigned char* wl = ws + WS_W + (size_t)l * W_LAYER;
        if (r < I_IN) { const int kb = r / (NIN / 32), nb = r % (NIN / 32), n0 = nb * 32, sc = win_src_col(n0);
            transpose_item(a.in[I_WIN] + (size_t)l * D * NIN_O, D, NIN_O, (bf16*)(wl + WO_IN), n0, sc, n0 == 3072 ? 16 : 32, kb * 64, scr, lane); continue; }
        r -= I_IN;
        if (r < I_OUT) { const int kb = r / 32, nb = r % 32;
            transpose_item(a.in[I_WOUT] + (size_t)l * D * D, D, D, (bf16*)(wl + WO_OUT), nb * 32, nb * 32, 32, kb * 64, scr, lane); continue; }
        r -= I_OUT;
        if (r < I_GU) { const int kb = r / (NGU / 32), nb = r % (NGU / 32), n0 = nb * 32;
            transpose_item(a.in[I_WGU] + (size_t)l * D * NGU, D, NGU, (bf16*)(wl + WO_GU), n0, wgu_src_col(n0), 32, kb * 64, scr, lane); continue; }
        r -= I_GU;
        { const int kb = r / 32, nb = r % 32;
            transpose_item(a.in[I_WDOWN] + (size_t)l * FF * D, FF, D, (bf16*)(wl + WO_DOWN), nb * 32, nb * 32, 32, kb * 64, scr, lane); }
    }
    for (int e = blockIdx.x * NTHREADS + tid; e < 2 * NIN; e += G * NTHREADS) { const int l = e / NIN, n = e % NIN, s = win_src_col(n);
        ((float*)(ws + WS_BIN))[e] = s >= 0 ? a.in[I_BIN][l * NIN_O + s] : 0.f; }
    for (int e = blockIdx.x * NTHREADS + tid; e < 2 * 4 * 128 * 128; e += G * NTHREADS) ((bf16*)(ws + WS_SWB))[e] = (bf16)f2bf(a.in[I_SW][e]);
    __syncthreads();
    LAS float* SL = (LAS float*)lds; LAS float* RED = SL + 1024 * 20;
    float* MOD = (float*)(ws + WS_MOD);
    bool filled = false;
    for (int it = blockIdx.x; it < 2 * 96; it += G) {
        const int l = it / 96, j0 = (it % 96) * 64;
        if (!filled) { for (int e = tid; e < 17 * 1024; e += NTHREADS) { const int r = e >> 10, k = e & 1023; const float cv = r < 16 ? a.in[I_C][r * D + k] : a.in[I_CCTX][k]; SL[k * 20 + r] = cv * fsigmoid(cv); } filled = true; }
        __syncthreads();
        gemv17_cols(SL, RED, a.in[I_WMOD] + (size_t)l * D * MODW, MODW, j0, tid);
        __syncthreads();
        for (int e = tid; e < 17 * 64; e += NTHREADS) { const int r = e >> 6, j = j0 + (e & 63); MOD[(size_t)(l * 17 + r) * MODW + j] = gemv17_sum(RED, e) + a.in[I_BMOD][l * MODW + j]; }
    }
    __syncthreads();
}

__device__ __forceinline__ int wgu_dst_col(int c) { const int half = c >= FF ? 1 : 0, cc = c - half * FF; return (cc >> 7) * 256 + half * 128 + (cc & 127); }
__device__ __forceinline__ int win_dst_col(int c) {
    if (c < 2048) return c;
    if (c < 2064) return 3072 + (c - 2048);
    if (c < 2576) return c - 16;
    const int cc = c - 2576, half = cc >> 8, w = cc & 255; return 2560 + (w >> 7) * 256 + half * 128 + (w & 127);
}
__device__ __forceinline__ void phase_shifts(const Args& a, LAS unsigned char* lds, int G, int tid) {
    unsigned char* ws = a.ws; const float* MOD = (const float*)(ws + WS_MOD);
    for (int e = blockIdx.x * NTHREADS + tid; e < 2 * 2 * 17 * 1024; e += G * NTHREADS) { const int l = e / (2 * 17 * 1024), w = (e / (17 * 1024)) & 1, r = (e >> 10) % 17, c = e & 1023;
        ((float*)(ws + WS_GS))[e] = (w ? a.in[I_N2G] : a.in[I_N1G])[l * D + c] * (1.0f + MOD[(size_t)(l * 17 + r) * MODW + (w ? 4 : 1) * D + c]); }
    LAS float* SL = (LAS float*)lds; LAS float* RED = SL + 1024 * 20;
    for (int it = blockIdx.x; it < 176 + 49; it += G) {
        const bool gu = it < 176; const int l = gu ? it / 88 : 1, j0 = gu ? (it % 88) * 64 : (it - 176) * 64;
        const int shoff = gu ? 3 * D : 0, Nsrc = gu ? NGU : NIN_O;
        __syncthreads();
        for (int e = tid; e < 17 * 1024; e += NTHREADS) { const int r = e >> 10, k = e & 1023; SL[k * 20 + r] = MOD[(size_t)(l * 17 + r) * MODW + shoff + k]; }
        __syncthreads();
        gemv17_cols(SL, RED, gu ? a.in[I_WGU] + (size_t)l * D * NGU : a.in[I_WIN] + (size_t)D * NIN_O, Nsrc, j0, tid);
        __syncthreads();
        for (int e = tid; e < 17 * 64; e += NTHREADS) { const int r = e >> 6, j = j0 + (e & 63);
            if (j < Nsrc) { const float v = gemv17_sum(RED, e);
                if (gu) ((float*)(ws + WS_SHGU))[(size_t)(l * 17 + r) * NGU + wgu_dst_col(j)] = v;
                else ((float*)(ws + WS_SHIN))[(size_t)r * NIN + win_dst_col(j)] = v + a.in[I_BIN][NIN_O + j]; } }
    }
    __syncthreads();
}

__device__ __forceinline__ void phase_norm(const float* xl, const float* xc, bf16* A, const float* g, const float* mod, int sh_off, int nrows, int G, int lane, int wave) {
    const int gw = blockIdx.x * NWAVES + wave, NGW = G * NWAVES;
    for (int r = gw; r < nrows; r += NGW) {
        const float* xr = r < ML ? xl + (size_t)r * D : xc + (size_t)(r - ML) * D;
        const float* mr = mod + (size_t)modrow_of(r) * MODW + sh_off;
        f32x4 v[4]; float s = 0.f;
#pragma unroll
        for (int j = 0; j < 4; ++j) { v[j] = ((const f32x4*)xr)[lane + 64 * j]; s += (v[j].x * v[j].x + v[j].y * v[j].y) + (v[j].z * v[j].z + v[j].w * v[j].w); }
        const float rstd = 1.0f / sqrtf(wave_sum(s) * (1.0f / D) + EPS);
        unsigned long long* o8 = (unsigned long long*)(A + (size_t)r * D) + lane;
#pragma unroll
        for (int j = 0; j < 4; ++j) { const int c = (lane + 64 * j) * 4;
            const f32x4 gg = *(const f32x4*)(g + c), sh = *(const f32x4*)(mr + c), sc = *(const f32x4*)(mr + D + c);
            const f32x4 y = v[j] * rstd * gg * (1.0f + sc) + sh;
            o8[64 * j] = (unsigned long long)pk2(y.x, y.y) | ((unsigned long long)pk2(y.z, y.w) << 32); }
    }
}

__device__ __forceinline__ void phase_final(float* x, const float* g, int G, int lane, int wave) {
    const int gw = blockIdx.x * NWAVES + wave, NGW = G * NWAVES;
    for (int r = gw; r < ML; r += NGW) {
        float* xr = x + (size_t)r * D;
        f32x4 v[4]; float s = 0.f;
#pragma unroll
        for (int j = 0; j < 4; ++j) { v[j] = ((const f32x4*)xr)[lane + 64 * j]; s += (v[j].x * v[j].x + v[j].y * v[j].y) + (v[j].z * v[j].z + v[j].w * v[j].w); }
        const float rstd = 1.0f / sqrtf(wave_sum(s) * (1.0f / D) + EPS);
#pragma unroll
        for (int j = 0; j < 4; ++j) { const f32x4 gg = ((const f32x4*)g)[lane + 64 * j]; ((f32x4*)xr)[lane + 64 * j] = v[j] * rstd * gg; }
    }
}

constexpr int TB = 16;
__device__ __forceinline__ void mlstm_scan_item(const bf16* Q, const bf16* K, const bf16* V, const float* GT, float* HS0, float* HS1, int item, bool ctx_out, LAS unsigned char* lds, int tid) {
    const int b = item >> 3, h = (item >> 1) & 3, dir = item & 1;
    const int dv = tid & 127, kq = tid >> 7;
    LAS float* kbuf = (LAS float*)lds;
    LAS float* vbuf = kbuf + TB * 128;
    LAS float* qbuf = vbuf + TB * 128;
    LAS float* ibuf = qbuf + TB * 128;
    LAS float* fbuf = ibuf + TB;
    LAS float* red = fbuf + TB;
    LAS float* redd = red + 2 * 4 * 128;
    float* HS = dir ? HS1 : HS0;
    float C[32], nn[32];
#pragma unroll
    for (int j = 0; j < 32; ++j) { C[j] = 0.f; nn[j] = 0.f; }
    float m = 0.f; int par = 0;
    for (int s0 = 0; s0 < CTXL + SEQ; s0 += TB) {
        const bool isctx = s0 < CTXL; const int len = isctx ? CTXL : SEQ, i0 = isctx ? s0 : s0 - CTXL;
        const int rbase = isctx ? ML + b * CTXL : b * SEQ;
        for (int e = tid; e < TB * 384; e += NTHREADS) { const int tok = e / 384, c = e % 384, which = c >> 7, d = c & 127;
            const int t = dir ? (len - 1 - (i0 + tok)) : (i0 + tok); const size_t off = (size_t)(rbase + t) * HW + h * 128 + d;
            const bf16* src = which == 0 ? K : which == 1 ? V : Q;
            (which == 0 ? kbuf : which == 1 ? vbuf : qbuf)[tok * 128 + d] = bf2f(src[off]); }
        if (tid < TB) { const int t = dir ? (len - 1 - (i0 + tid)) : (i0 + tid); const float* gp = GT + (size_t)(rbase + t) * 16 + dir * 8 + h;
            const float iv = gp[0], fv = gp[4];
            ibuf[tid] = iv; fbuf[tid] = fminf(fv, 0.f) - log1pf(__expf(-fabsf(fv))); }
        __syncthreads();
        const bool wr_out = !isctx || ctx_out;
        for (int tok = 0; tok < TB; ++tok) {
            const float it = ibuf[tok], lf = fbuf[tok];
            const float mn = fmaxf(lf + m, it), aa = __expf(lf + m - mn), bc = __expf(it - mn); m = mn;
            const float vv = vbuf[tok * 128 + dv] * bc;
            float part = 0.f, dpart = 0.f;
            const LAS float* kp = kbuf + tok * 128 + kq * 32; const LAS float* qp = qbuf + tok * 128 + kq * 32;
#pragma unroll
            for (int j = 0; j < 32; ++j) { const float kk = kp[j], qq = qp[j];
                C[j] = aa * C[j] + kk * vv; part += C[j] * qq;
                nn[j] = aa * nn[j] + bc * kk; dpart += nn[j] * qq; }
            red[(par * 4 + kq) * 128 + dv] = part; if (dv == 0) redd[par * 4 + kq] = dpart;
            __syncthreads();
            if (tid < 128 && wr_out) {
                const float num = (red[(par * 4 + 0) * 128 + tid] + red[(par * 4 + 1) * 128 + tid]) + (red[(par * 4 + 2) * 128 + tid] + red[(par * 4 + 3) * 128 + tid]);
                const float den = (redd[par * 4 + 0] + redd[par * 4 + 1]) + (redd[par * 4 + 2] + redd[par * 4 + 3]);
                const int t = dir ? (len - 1 - (i0 + tok)) : (i0 + tok);
                HS[(size_t)(rbase + t) * HW + h * 128 + tid] = num / fmaxf(fabsf(den), __expf(-m));
            }
            par ^= 1;
        }
    }
    __syncthreads();
}

__device__ __forceinline__ void phase_mlstm_post(const float* HS0, const float* HS1, const bf16* OG, const float* mg, bf16* Y, int nrows, int G, int lane, int wave) {
    const int gw = blockIdx.x * NWAVES + wave, NGW = G * NWAVES;
    for (int r = gw; r < nrows; r += NGW) {
        const size_t off = (size_t)r * HW + lane * 8;
        const f32x4 a0 = *(const f32x4*)(HS0 + off), a1 = *(const f32x4*)(HS0 + off + 4), b0 = *(const f32x4*)(HS1 + off), b1 = *(const f32x4*)(HS1 + off + 4);
        const f32x4 h0 = a0 + b0, h1 = a1 + b1;
        float s = (h0.x * h0.x + h0.y * h0.y) + (h0.z * h0.z + h0.w * h0.w) + (h1.x * h1.x + h1.y * h1.y) + (h1.z * h1.z + h1.w * h1.w);
        s += __shfl_xor(s, 1); s += __shfl_xor(s, 2); s += __shfl_xor(s, 4); s += __shfl_xor(s, 8);
        const float rs = 1.0f / sqrtf(s * (1.0f / 128.0f) + EPS);
        const v4u og = *(const v4u*)(OG + off);
        const f32x4 g0 = *(const f32x4*)(mg + lane * 8), g1 = *(const f32x4*)(mg + lane * 8 + 4);
        v4u o;
        o.x = pk2(h0.x * rs * g0.x * bflo(og.x), h0.y * rs * g0.y * bfhi(og.x)); o.y = pk2(h0.z * rs * g0.z * bflo(og.y), h0.w * rs * g0.w * bfhi(og.y));
        o.z = pk2(h1.x * rs * g1.x * bflo(og.z), h1.y * rs * g1.y * bfhi(og.z)); o.w = pk2(h1.z * rs * g1.z * bflo(og.w), h1.w * rs * g1.w * bfhi(og.w));
        *(v4u*)(Y + (size_t)r * D + lane * 8) = o;
    }
}

__device__ __forceinline__ void sgu_item(const bf16* Z, const float* lg, const float* lb, const float* sw, const float* sb, bf16* Y, int chunk, LAS unsigned char* lds, int tid, int lane, int wave) {
    LAS float* vn = (LAS float*)lds;
    const int row0 = chunk * 128;
    for (int t = wave; t < 128; t += NWAVES) {
        const v2u raw = *(const v2u*)(Z + (size_t)(row0 + t) * 512 + 256 + lane * 4);
        const float x0 = bflo(raw.x), x1 = bfhi(raw.x), x2 = bflo(raw.y), x3 = bfhi(raw.y);
        const float mu = wave_sum((x0 + x1) + (x2 + x3)) * (1.0f / 256.0f);
        const float d0 = x0 - mu, d1 = x1 - mu, d2 = x2 - mu, d3 = x3 - mu;
        const float var = wave_sum((d0 * d0 + d1 * d1) + (d2 * d2 + d3 * d3)) * (1.0f / 256.0f);
        const float rs = 1.0f / sqrtf(var + EPS);
        const f32x4 g = *(const f32x4*)(lg + lane * 4), bb = *(const f32x4*)(lb + lane * 4);
        *(LAS f32x4*)(vn + t * 256 + lane * 4) = (f32x4){d0 * rs * g.x + bb.x, d1 * rs * g.y + bb.y, d2 * rs * g.z + bb.z, d3 * rs * g.w + bb.w};
    }
    __syncthreads();
    const int ch = tid & 255, ph = tid >> 8, g = __builtin_amdgcn_readfirstlane(ch >> 6);
    const float* wg = sw + (size_t)g * 128 * 128; const float* bg = sb + g * 128;
    for (int p = ph * 64; p < ph * 64 + 64; ++p) {
        const float* wr = wg + p * 128; float acc = 0.f;
#pragma unroll 8
        for (int q = 0; q < 128; ++q) acc += wr[q] * vn[q * 256 + ch];
        const float u = bf2f(Z[(size_t)(row0 + p) * 512 + ch]);
        Y[(size_t)(row0 + p) * D + 512 + ch] = (bf16)f2bf(u * (acc + bg[p]));
    }
    __syncthreads();
}

__device__ __forceinline__ void conv_rows(const bf16* YC, const float* cw, const float* cb, const float* lg, const float* lb, bf16* Y, int row0, int nrows, int lane, int wave) {
    const int c0 = lane * 4;
    for (int rr = wave; rr < nrows; rr += NWAVES) {
        const int r = row0 + rr;
        f32x4 acc = *(const f32x4*)(cb + c0);
        int base, pos, len, stride;
        if (r < ML) { const int b = r >> 11, t = r & 2047;
            if (lane < 32) { base = (b << 11) + (t & ~63); pos = t & 63; len = 64; stride = 1; }
            else           { base = (b << 11) + (t & 63); pos = t >> 6; len = 32; stride = 64; } }
        else { const int rc = r - ML; base = ML + (rc & ~255); pos = rc & 255; len = 256; stride = 1; }
#pragma unroll 1
        for (int k = 0; k < 31; ++k) { const int p = pos + k - 15;
            if (p >= 0 && p < len) { const v2u raw = *(const v2u*)(YC + (size_t)(base + p * stride) * 256 + c0); const f32x4 w = *(const f32x4*)(cw + k * 256 + c0);
                acc.x += w.x * bflo(raw.x); acc.y += w.y * bfhi(raw.x); acc.z += w.z * bflo(raw.y); acc.w += w.w * bfhi(raw.y); } }
        const float mu = wave_sum((acc.x + acc.y) + (acc.z + acc.w)) * (1.0f / 256.0f);
        const float d0 = acc.x - mu, d1 = acc.y - mu, d2 = acc.z - mu, d3 = acc.w - mu;
        const float var = wave_sum((d0 * d0 + d1 * d1) + (d2 * d2 + d3 * d3)) * (1.0f / 256.0f);
        const float rs = 1.0f / sqrtf(var + EPS);
        const f32x4 g = *(const f32x4*)(lg + c0), bb = *(const f32x4*)(lb + c0);
        float y0 = d0 * rs * g.x + bb.x, y1 = d1 * rs * g.y + bb.y, y2 = d2 * rs * g.z + bb.z, y3 = d3 * rs * g.w + bb.w;
        y0 *= fsigmoid(y0); y1 *= fsigmoid(y1); y2 *= fsigmoid(y2); y3 *= fsigmoid(y3);
        v2u o; o.x = pk2(y0, y1); o.y = pk2(y2, y3);
        *(v2u*)(Y + (size_t)r * D + 768 + c0) = o;
    }
}
typedef short bf16x8_t __attribute__((ext_vector_type(8)));
typedef short s16x4_t __attribute__((ext_vector_type(4)));
typedef short v4i16_t __attribute__((ext_vector_type(4)));
typedef float f32x16 __attribute__((ext_vector_type(16)));
typedef __bf16 bf16x2_t __attribute__((ext_vector_type(2)));
__device__ __forceinline__ unsigned cvtpk(float lo, float hi) { f32x2 v = {lo, hi}; bf16x2_t b = __builtin_convertvector(v, bf16x2_t); return __builtin_bit_cast(unsigned, b); }
__device__ __forceinline__ s16x4_t tr16(const LAS unsigned char* p) { return __builtin_bit_cast(s16x4_t, __builtin_amdgcn_ds_read_tr16_b64_v4i16((LAS v4i16_t*)p)); }
__device__ __forceinline__ bf16x8_t cat8(s16x4_t lo, s16x4_t hi) { return __builtin_shufflevector(lo, hi, 0, 1, 2, 3, 4, 5, 6, 7); }
#define MFMA32(a, b, c) __builtin_amdgcn_mfma_f32_32x32x16_bf16((a), (b), (c), 0, 0, 0)
__device__ __forceinline__ int crow(int reg, int hh) { return (reg & 3) + 8 * (reg >> 2) + 4 * hh; }
__device__ __forceinline__ int chunk_row0(int b, int a) { return a < 2 ? ML + b * CTXL + a * 128 : b * SEQ + (a - 2) * 128; }
__device__ __forceinline__ int chunk_of_step(int j, int dir) { return dir == 0 ? j : (j == 0 ? 1 : (j == 1 ? 0 : 19 - j)); }
__device__ __forceinline__ float log_sigmoid(float x) { return fminf(x, 0.f) - log1pf(__expf(-fabsf(x))); }
__device__ __forceinline__ float lane_get(float x, int src_lane) { return __builtin_bit_cast(float, __builtin_amdgcn_ds_bpermute(src_lane << 2, __builtin_bit_cast(int, x))); }
__device__ __forceinline__ float wave_incl_add(float x, int lane) {
#pragma unroll
    for (int o = 1; o < 64; o <<= 1) { const float y = lane_get(x, lane - o); if (lane >= o) x += y; }
    return x;
}
__device__ __forceinline__ float wave_incl_max(float x, int lane) {
#pragma unroll
    for (int o = 1; o < 64; o <<= 1) { const float y = lane_get(x, lane - o); if (lane >= o) x = fmaxf(x, y); }
    return x;
}
__device__ __forceinline__ float wave_max(float v, int lane) {
#pragma unroll
    for (int o = 1; o < 64; o <<= 1) v = fmaxf(v, lane_get(v, lane ^ o));
    return v;
}
__device__ __forceinline__ v4u scale8(const v4u& w, float s) {
    v4u o; o.x = cvtpk(bflo(w.x) * s, bfhi(w.x) * s); o.y = cvtpk(bflo(w.y) * s, bfhi(w.y) * s); o.z = cvtpk(bflo(w.z) * s, bfhi(w.z) * s); o.w = cvtpk(bflo(w.w) * s, bfhi(w.w) * s); return o;
}
constexpr int MX_OFF = RING_BYTES + 1024;

#define dpp_f(x, ctrl) __builtin_bit_cast(float, __builtin_amdgcn_update_dpp(0, __builtin_bit_cast(int, (float)(x)), (ctrl), 0xf, 0xf, false))
#define ROW_SUM16(x) do { x += dpp_f(x, 0x121); x += dpp_f(x, 0x122); x += dpp_f(x, 0x124); x += dpp_f(x, 0x128); } while (0)
__device__ __forceinline__ int swz_off(int row, int chunk) { return row * 256 + 16 * (chunk ^ (((row & 3) << 2) | ((row >> 2) & 3))); }

#define LDS_BARRIER() do { asm volatile("s_waitcnt lgkmcnt(0)" ::: "memory"); __builtin_amdgcn_s_barrier(); asm volatile("" ::: "memory"); } while (0)
#define ST_LOAD(kr, vr, jj) do { const int row0_ = chunk_row0(b, chunk_of_step((jj), dir)); \
        _Pragma("unroll") for (int i = 0; i < 4; ++i) { const int pc = tid + NTHREADS * i; kr[i] = *(const v4u*)(K + (size_t)(row0_ + (pc >> 4)) * HW + h * 128 + (pc & 15) * 8); } \
        _Pragma("unroll") for (int i = 0; i < 2; ++i) { const int pc = tid + NTHREADS * i; vr[i] = *(const v4u*)(V + (size_t)(row0_ + (pc >> 3)) * HW + h * 128 + dvh * 64 + (pc & 7) * 8); } } while (0)
#define ST_WRITE(kr, vr, jj) do { LAS unsigned char* Kn = Kimg + ((jj) & 1) * 32768; LAS unsigned char* Vn = Vimg + ((jj) & 1) * 16384; \
        _Pragma("unroll") for (int i = 0; i < 4; ++i) { const int pc = tid + NTHREADS * i; *(LAS v4u*)(Kn + pc * 16) = kr[i]; } \
        _Pragma("unroll") for (int i = 0; i < 2; ++i) { const int pc = tid + NTHREADS * i, s_ = pc >> 3; *(LAS v4u*)(Vn + pc * 16) = scale8(vr[i], kpn[(jj) * 128 + s_]); } } while (0)
#define ST_STEP(j, krL, vrL, krW, vrW) do { \
        LDS_BARRIER(); \
        const int a = chunk_of_step((j), dir); \
        if ((j) + 2 < 18) ST_LOAD(krL, vrL, (j) + 2); \
        if (a >= 2 || store_ctx) { \
            bf16* cp = CT + ((size_t)(seq * 18 + a) * 128 + dvh * 64 + dvt * 32 + r) * 128 + dkt * 32 + 4 * hh; \
            _Pragma("unroll") for (int g = 0; g < 4; ++g) { v2u o; o.x = cvtpk(acc[4 * g], acc[4 * g + 1]); o.y = cvtpk(acc[4 * g + 2], acc[4 * g + 3]); *(v2u*)(cp + 8 * g) = o; } \
            if (dvh == 0 && dvt == 0) NS[(size_t)(seq * 18 + a) * 256 + hh * 128 + dkt * 32 + r] = nn; } \
        const float delta = cs[64 + (j)]; \
        _Pragma("unroll") for (int i = 0; i < 16; ++i) acc[i] *= delta; \
        const LAS unsigned char* Kb = Kimg + ((j) & 1) * 32768; const LAS unsigned char* Vb = Vimg + ((j) & 1) * 16384; \
        bf16x8_t Af[8], Bf[8]; \
        _Pragma("unroll") for (int ks = 0; ks < 8; ++ks) { \
            const LAS unsigned char* ka = Kb + (16 * ks + 8 * hh + q) * 256 + 2 * (32 * dkt + 16 * blk + 4 * p); \
            const LAS unsigned char* va = Vb + (16 * ks + 8 * hh + q) * 128 + 2 * (32 * dvt + 16 * blk + 4 * p); \
            Af[ks] = cat8(tr16(ka), tr16(ka + 4 * 256)); Bf[ks] = cat8(tr16(va), tr16(va + 4 * 128)); } \
        f32x16 acc2; _Pragma("unroll") for (int i = 0; i < 16; ++i) acc2[i] = 0.f; \
        _Pragma("unroll") for (int ks = 0; ks < 8; ks += 2) { acc = MFMA32(Af[ks], Bf[ks], acc); acc2 = MFMA32(Af[ks + 1], Bf[ks + 1], acc2); } \
        if (dvh == 0 && dvt == 0) { float s_ = 0.f;        \
            _Pragma("unroll") for (int ks = 0; ks < 8; ++ks) { const LAS f32x4* kp4 = (const LAS f32x4*)(kpn + (j) * 128 + 16 * ks + 8 * hh); const f32x4 k0 = kp4[0], k1 = kp4[1]; \
                s_ += k0.x * bf2f((unsigned short)Af[ks][0]) + k0.y * bf2f((unsigned short)Af[ks][1]) + k0.z * bf2f((unsigned short)Af[ks][2]) + k0.w * bf2f((unsigned short)Af[ks][3]) \
                    + k1.x * bf2f((unsigned short)Af[ks][4]) + k1.y * bf2f((unsigned short)Af[ks][5]) + k1.z * bf2f((unsigned short)Af[ks][6]) + k1.w * bf2f((unsigned short)Af[ks][7]); } \
            nn = delta * nn + s_; } \
        _Pragma("unroll") for (int i = 0; i < 16; ++i) acc[i] += acc2[i]; \
        if ((j) + 1 < 18) ST_WRITE(krW, vrW, (j) + 1); \
    } while (0)
__device__ __forceinline__ void mlstm_state_item(const bf16* K, const bf16* V, const float* GT, bf16* CT, float* NS, float* TAB, int item, bool store_ctx, LAS unsigned char* lds, int tid) {
    asm volatile("" : "+v"(tid));
    const int lane = tid & 63, wave = __builtin_amdgcn_readfirstlane(tid >> 6);
    const int dvh = item & 1, dir = (item >> 1) & 1, h = (item >> 2) & 3, b = item >> 4;
    const int seq = (b * 4 + h) * 2 + dir;
    LAS unsigned char* Kimg = lds;
    LAS unsigned char* Vimg = lds + 65536;
    LAS float* kap = (LAS float*)(lds + 98304);
    LAS float* gb = kap + 2304;
    LAS float* ib = gb + 2304;
    LAS float* cs = ib + 2304;
    for (int e = tid; e < 2304; e += NTHREADS) { const int j = e >> 7, tau = e & 127, a = chunk_of_step(j, dir), t = dir ? 127 - tau : tau;
        const float* gp = GT + (size_t)(chunk_row0(b, a) + t) * 16 + dir * 8 + h; ib[e] = gp[0]; gb[e] = log_sigmoid(gp[4]); }
    __syncthreads();
    for (int j = wave; j < 18; j += NWAVES) {
        const float x0 = gb[j * 128 + 2 * lane], x1 = gb[j * 128 + 2 * lane + 1];
        const float sc = wave_incl_add(x0 + x1, lane);
        const float b0 = sc - x1, b1 = sc, g0 = ib[j * 128 + 2 * lane] - b0, g1 = ib[j * 128 + 2 * lane + 1] - b1;
        const float ip = wave_incl_max(fmaxf(g0, g1), lane);
        float ex = lane_get(ip, lane - 1); if (lane == 0) ex = -INFINITY;
        gb[j * 128 + 2 * lane] = g0; gb[j * 128 + 2 * lane + 1] = g1;
        ib[j * 128 + 2 * lane] = fmaxf(ex, g0); ib[j * 128 + 2 * lane + 1] = ip;
        kap[j * 128 + 2 * lane] = b0; kap[j * 128 + 2 * lane + 1] = b1;
        const float pm = lane_get(ip, 63), bl = lane_get(sc, 63);
        if (lane == 0) { cs[j] = bl; cs[32 + j] = pm; }
    }
    __syncthreads();
    if (tid < 18) { float m = 0.f, mp = 0.f, Ml = 0.f;
        for (int j = 0; j <= tid; ++j) { mp = m; Ml = fmaxf(m, cs[32 + j]); m = cs[j] + Ml; }
        cs[64 + tid] = __expf(mp - Ml); cs[96 + tid] = Ml; cs[128 + tid] = mp; }
    __syncthreads();
    float kv[5];
#pragma unroll
    for (int i = 0; i < 5; ++i) { const int e = tid + NTHREADS * i; kv[i] = 0.f;
        if (e < 2304) { const int j = e >> 7, tau = e & 127;
            const float g = gb[e], pm = ib[e], bb = kap[e], mp = cs[128 + j], M = fmaxf(mp, pm);
            if (dvh == 0) { const int a = chunk_of_step(j, dir), t = dir ? 127 - tau : tau; float* tp = TAB + (size_t)(seq * 18 + a) * 512 + t;
                tp[0] = g; tp[128] = M; tp[256] = __expf(mp - M); tp[384] = __expf(-(bb + M)); }
            kv[i] = __expf(g - cs[96 + j]); } }
    __syncthreads();
    LAS float* kpn = gb;
#pragma unroll
    for (int i = 0; i < 5; ++i) { const int e = tid + NTHREADS * i; if (e < 2304) { const int j = e >> 7, tau = e & 127; kpn[j * 128 + (dir ? 127 - tau : tau)] = kv[i]; } }
    __syncthreads();

    const int r = lane & 31, hh = lane >> 5, i16 = lane & 15, q = i16 >> 2, p = i16 & 3, blk = (lane >> 4) & 1;
    const int dkt = wave & 3, dvt = wave >> 2;
    f32x16 acc;
#pragma unroll
    for (int i = 0; i < 16; ++i) acc[i] = 0.f;
    float nn = 0.f;
    v4u kA[4], vA[2], kB[4], vB[2];
    ST_LOAD(kA, vA, 0); ST_WRITE(kA, vA, 0); ST_LOAD(kB, vB, 1);
#pragma unroll 1
    for (int jj = 0; jj < 18; jj += 2) {
        ST_STEP(jj, kA, vA, kB, vB);
        ST_STEP(jj + 1, kB, vB, kA, vA);
    }
    __syncthreads();
}
#undef ST_LOAD
#undef ST_WRITE
#undef ST_STEP

template <int TB>
__device__ __forceinline__ void mlstm_weights(const f32x16 (&S)[4], bf16x8_t (&pb)[4][2], const LAS float* GA, int t, int hh, int lane, float qnf, float qnb, float& sff, float& sfb) {
    const float Mf = GA[128 + t], Mb = GA[512 + 128 + t];
    float rsf = 0.f, rsb = 0.f;
#pragma unroll
    for (int st = 0; st < 4; ++st) {
#pragma unroll
        for (int g = 0; g < 4; ++g) {
            const int s0 = 32 * st + 8 * g + 4 * hh;
            if (st < TB) { const f32x4 gv = *(const LAS f32x4*)(GA + s0);
#pragma unroll
                for (int e = 0; e < 4; ++e) rsf += S[st][4 * g + e] * __expf(gv[e] - Mf);
            } else if (st > TB) { const f32x4 gv = *(const LAS f32x4*)(GA + 512 + s0);
#pragma unroll
                for (int e = 0; e < 4; ++e) rsb += S[st][4 * g + e] * __expf(gv[e] - Mb);
            } else { const f32x4 gf = *(const LAS f32x4*)(GA + s0), gbv = *(const LAS f32x4*)(GA + 512 + s0);
#pragma unroll
                for (int e = 0; e < 4; ++e) { const float dts = (float)(t - (s0 + e));
                    const float wf = __expf(gf[e] - Mf + fminf(dts, 0.f) * 1e30f), wb = __expf(gbv[e] - Mb - fmaxf(dts, 0.f) * 1e30f);
                    rsf += S[st][4 * g + e] * wf; rsb += S[st][4 * g + e] * wb; }
            }
        }
        __builtin_amdgcn_sched_barrier(0);
    }
    rsf += lane_get(rsf, lane ^ 32); rsb += lane_get(rsb, lane ^ 32);
    const float alf = GA[256 + t], alb = GA[512 + 256 + t];
    const float invf = 1.0f / fmaxf(fabsf(alf * qnf + rsf), GA[384 + t]), invb = 1.0f / fmaxf(fabsf(alb * qnb + rsb), GA[512 + 384 + t]);
    sff = alf * invf; sfb = alb * invb;
    __builtin_amdgcn_sched_barrier(0);
    float Mf2 = Mf, Mb2 = Mb; asm volatile("" : "+v"(Mf2), "+v"(Mb2));
#pragma unroll
    for (int st = 0; st < 4; ++st) {
        float pv[16];
#pragma unroll
        for (int g = 0; g < 4; ++g) {
            const int s0 = 32 * st + 8 * g + 4 * hh;
            if (st < TB) { const f32x4 gv = *(const LAS f32x4*)(GA + s0);
#pragma unroll
                for (int e = 0; e < 4; ++e) pv[4 * g + e] = S[st][4 * g + e] * (__expf(gv[e] - Mf2) * invf);
            } else if (st > TB) { const f32x4 gv = *(const LAS f32x4*)(GA + 512 + s0);
#pragma unroll
                for (int e = 0; e < 4; ++e) pv[4 * g + e] = S[st][4 * g + e] * (__expf(gv[e] - Mb2) * invb);
            } else { const f32x4 gf = *(const LAS f32x4*)(GA + s0), gbv = *(const LAS f32x4*)(GA + 512 + s0);
#pragma unroll
                for (int e = 0; e < 4; ++e) { const float dts = (float)(t - (s0 + e));
                    const float wf = __expf(gf[e] - Mf2 + fminf(dts, 0.f) * 1e30f), wb = __expf(gbv[e] - Mb2 - fmaxf(dts, 0.f) * 1e30f);
                    pv[4 * g + e] = S[st][4 * g + e] * (wf * invf + wb * invb); }
            }
        }
#pragma unroll
        for (int sp = 0; sp < 2; ++sp) { v4u w; w.x = cvtpk(pv[8 * sp], pv[8 * sp + 1]); w.y = cvtpk(pv[8 * sp + 2], pv[8 * sp + 3]); w.z = cvtpk(pv[8 * sp + 4], pv[8 * sp + 5]); w.w = cvtpk(pv[8 * sp + 6], pv[8 * sp + 7]);
            pb[st][sp] = __builtin_bit_cast(bf16x8_t, w); }
        __builtin_amdgcn_sched_barrier(0);
    }
}

__device__ __forceinline__ void mlstm_out_phase(const bf16* Q, const bf16* K, const bf16* V, const bf16* OG, const bf16* CT, const float* NS, const float* TAB,
                                                const float* mg, bf16* Y, int abase, int G, LAS unsigned char* lds, int tid) {
    asm volatile("" : "+v"(tid));
    const int wave = __builtin_amdgcn_readfirstlane(tid >> 6);
    const int na = 18 - abase, nitems = 64 * na;
    int it = blockIdx.x;
    if (it >= nitems) return;
    LAS unsigned char* Kimg = lds; LAS unsigned char* Vimg = lds + 32768; LAS unsigned char* Cf = lds + 65536; LAS unsigned char* Cb = lds + 98304;
    LAS float* GA = (LAS float*)(lds + MX_OFF);
    LAS float* NSL = GA + 1024;
    LAS float* SSQ = NSL + 256;
    const int tb = wave & 3, dh = wave >> 2;
    v4u kr[4], vr[4], tabr; float nsr[4];
#define OUT_PREFETCH(item_) do { const int bh_ = (item_) / na, a_ = abase + (item_) % na, b_ = bh_ >> 2, h_ = bh_ & 3, row0_ = chunk_row0(b_, a_), sq_ = (b_ * 4 + h_) * 2; \
        _Pragma("unroll") for (int i = 0; i < 4; ++i) { const int pc = tid + NTHREADS * i; const size_t go = (size_t)(row0_ + (pc >> 4)) * HW + h_ * 128 + (pc & 15) * 8; kr[i] = *(const v4u*)(K + go); vr[i] = *(const v4u*)(V + go); } \
        if (tid < 256) tabr = *(const v4u*)(TAB + (size_t)((sq_ + (tid >> 7)) * 18 + a_) * 512 + (tid & 127) * 4); \
        else { const int e_ = tid - 256; const float* np_ = NS + (size_t)((sq_ + (e_ >> 7)) * 18 + a_) * 256 + (e_ & 127); nsr[0] = np_[0]; nsr[1] = np_[128]; nsr[2] = 0.f; nsr[3] = 0.f; } } while (0)
    OUT_PREFETCH(it);
#pragma unroll 1
    for (;;) {
        asm volatile("" : "+v"(tid));
        const int lane = tid & 63, r = lane & 31, hh = lane >> 5, i16 = lane & 15, q = i16 >> 2, p = i16 & 3, blk = (lane >> 4) & 1;
        const int t = 32 * tb + r;
        const int bh = it / na, a = abase + it % na, b = bh >> 2, h = bh & 3;
        const int row0 = chunk_row0(b, a), seqf = (b * 4 + h) * 2, seqb = seqf + 1;
#pragma unroll
        for (int i = 0; i < 4; ++i) { const int pc = tid + NTHREADS * i, so = swz_off(pc >> 4, pc & 15); *(LAS v4u*)(Kimg + so) = kr[i]; *(LAS v4u*)(Vimg + so) = vr[i]; }
        if (tid < 256) *(LAS v4u*)(GA + (tid >> 7) * 512 + (tid & 127) * 4) = tabr;
        else NSL[tid - 256] = (nsr[0] + nsr[1]) + (nsr[2] + nsr[3]);
        bf16x8_t qf[8];
#pragma unroll
        for (int ks = 0; ks < 8; ++ks) qf[ks] = *(const bf16x8_t*)(Q + (size_t)(row0 + t) * HW + h * 128 + 16 * ks + 8 * hh);
        __syncthreads();
        f32x16 S[4];
#pragma unroll
        for (int st = 0; st < 4; ++st)
#pragma unroll
            for (int i = 0; i < 16; ++i) S[st][i] = 0.f;
        int la = lane; asm volatile("" : "+v"(la));
        const int ra = la & 31, ha = la >> 5;
#pragma unroll
        for (int ks = 0; ks < 8; ++ks) {
#pragma unroll
            for (int st = 0; st < 4; ++st) { const bf16x8_t A = *(const LAS bf16x8_t*)(Kimg + swz_off(32 * st + ra, 2 * ks + ha)); S[st] = MFMA32(A, qf[ks], S[st]); }
            __builtin_amdgcn_sched_barrier(0); }
        { const unsigned char* cfp = (const unsigned char*)(CT + (size_t)(seqf * 18 + a) * 16384); const unsigned char* cbp = (const unsigned char*)(CT + (size_t)(seqb * 18 + a) * 16384);
#pragma unroll
          for (int i = 0; i < 4; ++i) { const int n = 4 * wave + i, row = 4 * n + (lane >> 4), dc = (lane & 15) ^ (((row & 3) << 2) | ((row >> 2) & 3)); const int go = row * 256 + dc * 16;
              __builtin_amdgcn_global_load_lds((const unsigned*)(cfp + go), (LAS unsigned*)(Cf + n * 1024), 16, 0, 0);
              __builtin_amdgcn_global_load_lds((const unsigned*)(cbp + go), (LAS unsigned*)(Cb + n * 1024), 16, 0, 0); } }
        __builtin_amdgcn_sched_barrier(0);
        float qnf = 0.f, qnb = 0.f;
#pragma unroll
        for (int ks = 0; ks < 8; ++ks)
#pragma unroll
            for (int j = 0; j < 8; ++j) { const float qv = bf2f((unsigned short)qf[ks][j]); const int dk = 16 * ks + 8 * hh + j; qnf += qv * NSL[dk]; qnb += qv * NSL[128 + dk]; }
        qnf += lane_get(qnf, lane ^ 32); qnb += lane_get(qnb, lane ^ 32);
        __builtin_amdgcn_sched_barrier(0);
        bf16x8_t pb[4][2];
        float sff, sfb;
        switch (tb) {
            case 0: mlstm_weights<0>(S, pb, GA, t, hh, lane, qnf, qnb, sff, sfb); break;
            case 1: mlstm_weights<1>(S, pb, GA, t, hh, lane, qnf, qnb, sff, sfb); break;
            case 2: mlstm_weights<2>(S, pb, GA, t, hh, lane, qnf, qnb, sff, sfb); break;
            default: mlstm_weights<3>(S, pb, GA, t, hh, lane, qnf, qnb, sff, sfb); break;
        }
        __builtin_amdgcn_sched_barrier(0);
        const int itn = it + G; const bool more = itn < nitems;
        bf16x8_t qf2[8];
#pragma unroll
        for (int ks = 0; ks < 8; ++ks) qf2[ks] = *(const bf16x8_t*)(Q + (size_t)(row0 + t) * HW + h * 128 + 16 * ks + 8 * hh);
        __syncthreads();
        if (more) OUT_PREFETCH(itn);
        f32x16 Hc[2];
#pragma unroll
        for (int d = 0; d < 2; ++d)
#pragma unroll
            for (int i = 0; i < 16; ++i) Hc[d][i] = 0.f;
        int lb_ = lane; asm volatile("" : "+v"(lb_));
        const int hb = lb_ >> 5, qb = (lb_ & 15) >> 2, pb_ = lb_ & 3, blkb = (lb_ >> 4) & 1;
#pragma unroll
        for (int d = 0; d < 2; ++d) { const int dvt = 2 * dh + d;
#pragma unroll
            for (int st = 0; st < 4; ++st)
#pragma unroll
                for (int sp = 0; sp < 2; ++sp) { const int vrow = 32 * st + 16 * sp + 4 * hb + qb, vch = 4 * dvt + 2 * blkb + (pb_ >> 1);
                    const bf16x8_t A = cat8(tr16(Vimg + swz_off(vrow, vch) + 8 * (pb_ & 1)), tr16(Vimg + swz_off(vrow + 8, vch) + 8 * (pb_ & 1))); Hc[d] = MFMA32(A, pb[st][sp], Hc[d]); if (sp) __builtin_amdgcn_sched_barrier(0); } }
        v2u ogr[2][4];
#pragma unroll
        for (int d = 0; d < 2; ++d)
#pragma unroll
            for (int g = 0; g < 4; ++g) ogr[d][g] = *(const v2u*)(OG + (size_t)(row0 + t) * HW + h * 128 + 32 * (2 * dh + d) + 8 * g + 4 * hh);
        __builtin_amdgcn_sched_barrier(0);
#pragma unroll
        for (int dd = 0; dd < 2; ++dd) {
            int lc = lane; asm volatile("" : "+v"(lc)); const int rc = lc & 31, hc = lc >> 5;
            const float sfac = dd ? sfb : sff; const LAS unsigned char* Cimg = dd ? Cb : Cf;
            bf16x8_t qs[8];
#pragma unroll
            for (int ks = 0; ks < 8; ++ks) { v4u w;
                w.x = cvtpk(bf2f((unsigned short)qf2[ks][0]) * sfac, bf2f((unsigned short)qf2[ks][1]) * sfac); w.y = cvtpk(bf2f((unsigned short)qf2[ks][2]) * sfac, bf2f((unsigned short)qf2[ks][3]) * sfac);
                w.z = cvtpk(bf2f((unsigned short)qf2[ks][4]) * sfac, bf2f((unsigned short)qf2[ks][5]) * sfac); w.w = cvtpk(bf2f((unsigned short)qf2[ks][6]) * sfac, bf2f((unsigned short)qf2[ks][7]) * sfac);
                qs[ks] = __builtin_bit_cast(bf16x8_t, w); }
#pragma unroll
            for (int d = 0; d < 2; ++d) { const int dvt = 2 * dh + d;
#pragma unroll
                for (int ks = 0; ks < 8; ++ks) { const bf16x8_t A = *(const LAS bf16x8_t*)(Cimg + swz_off(32 * dvt + rc, 2 * ks + hc)); Hc[d] = MFMA32(A, qs[ks], Hc[d]); if (ks & 1) __builtin_amdgcn_sched_barrier(0); } }
        }
        __builtin_amdgcn_sched_barrier(0);
        float ss = 0.f;
#pragma unroll
        for (int d = 0; d < 2; ++d)
#pragma unroll
            for (int i = 0; i < 16; ++i) ss += Hc[d][i] * Hc[d][i];
        ss += lane_get(ss, lane ^ 32);
        if (hh == 0) SSQ[dh * 128 + t] = ss;
        LDS_BARRIER();
        const float rr = 1.0f / sqrtf((SSQ[t] + SSQ[128 + t]) * (1.0f / 128.0f) + EPS);
#pragma unroll
        for (int d = 0; d < 2; ++d)
#pragma unroll
            for (int g = 0; g < 4; ++g) { const int dv = 32 * (2 * dh + d) + 8 * g + 4 * hh;
                const v2u og = ogr[d][g]; const f32x4 gg = *(const f32x4*)(mg + h * 128 + dv);
                v2u o; o.x = cvtpk(Hc[d][4 * g] * rr * gg.x * bflo(og.x), Hc[d][4 * g + 1] * rr * gg.y * bfhi(og.x)); o.y = cvtpk(Hc[d][4 * g + 2] * rr * gg.z * bflo(og.y), Hc[d][4 * g + 3] * rr * gg.w * bfhi(og.y));
                *(v2u*)(Y + (size_t)(row0 + t) * D + h * 128 + dv) = o; }
        if (!more) break;
        it = itn;
    }
#undef OUT_PREFETCH
    __syncthreads();
}
__device__ __forceinline__ void sgu_item_mfma(const bf16* Z, const float* lg, const float* lb, const bf16* swb, const float* sb, bf16* Y, int chunk, LAS unsigned char* lds, int tid) {
    asm volatile("" : "+v"(tid));
    const int lane = tid & 63, wave = __builtin_amdgcn_readfirstlane(tid >> 6);
    const int row0 = chunk * 128;
    LAS unsigned char* VN = lds;
    {
        const int l16 = lane & 15, tq = lane >> 4;
        f32x4 gg[4], bb[4];
#pragma unroll
        for (int c = 0; c < 4; ++c) { gg[c] = *(const f32x4*)(lg + l16 * 16 + 4 * c); bb[c] = *(const f32x4*)(lb + l16 * 16 + 4 * c); }
        v4u raw[4][2];
#pragma unroll
        for (int tt = 0; tt < 4; ++tt) { const bf16* zp = Z + (size_t)(row0 + wave * 16 + 4 * tt + tq) * 512 + 256 + l16 * 16; raw[tt][0] = *(const v4u*)zp; raw[tt][1] = *(const v4u*)(zp + 8); }
#pragma unroll
        for (int tt = 0; tt < 4; ++tt) { const int t = wave * 16 + 4 * tt + tq;
            float x[16];
#pragma unroll
            for (int c = 0; c < 2; ++c) { x[8 * c] = bflo(raw[tt][c].x); x[8 * c + 1] = bfhi(raw[tt][c].x); x[8 * c + 2] = bflo(raw[tt][c].y); x[8 * c + 3] = bfhi(raw[tt][c].y);
                x[8 * c + 4] = bflo(raw[tt][c].z); x[8 * c + 5] = bfhi(raw[tt][c].z); x[8 * c + 6] = bflo(raw[tt][c].w); x[8 * c + 7] = bfhi(raw[tt][c].w); }
            float s = 0.f;
#pragma unroll
            for (int c = 0; c < 16; ++c) s += x[c];
            ROW_SUM16(s);
            const float mu = s * (1.0f / 256.0f); float vs = 0.f;
#pragma unroll
            for (int c = 0; c < 16; ++c) { x[c] -= mu; vs += x[c] * x[c]; }
            ROW_SUM16(vs);
            const float rs = 1.0f / sqrtf(vs * (1.0f / 256.0f) + EPS);
            v4u o0, o1;
            o0.x = cvtpk(x[0] * rs * gg[0].x + bb[0].x, x[1] * rs * gg[0].y + bb[0].y); o0.y = cvtpk(x[2] * rs * gg[0].z + bb[0].z, x[3] * rs * gg[0].w + bb[0].w);
            o0.z = cvtpk(x[4] * rs * gg[1].x + bb[1].x, x[5] * rs * gg[1].y + bb[1].y); o0.w = cvtpk(x[6] * rs * gg[1].z + bb[1].z, x[7] * rs * gg[1].w + bb[1].w);
            o1.x = cvtpk(x[8] * rs * gg[2].x + bb[2].x, x[9] * rs * gg[2].y + bb[2].y); o1.y = cvtpk(x[10] * rs * gg[2].z + bb[2].z, x[11] * rs * gg[2].w + bb[2].w);
            o1.z = cvtpk(x[12] * rs * gg[3].x + bb[3].x, x[13] * rs * gg[3].y + bb[3].y); o1.w = cvtpk(x[14] * rs * gg[3].z + bb[3].z, x[15] * rs * gg[3].w + bb[3].w);
            *(LAS v4u*)(VN + t * 512 + l16 * 32) = o0; *(LAS v4u*)(VN + t * 512 + l16 * 32 + 16) = o1; }
    }
    __syncthreads();
    const int r = lane & 31, hh = lane >> 5, i16 = lane & 15, q = i16 >> 2, p = i16 & 3, blk = (lane >> 4) & 1;
    const int g = wave >> 1, ct = wave & 1;
    bf16x8_t af[8];
#pragma unroll
    for (int ks = 0; ks < 8; ++ks) { const LAS unsigned char* va = VN + (16 * ks + 8 * hh + q) * 512 + 2 * (64 * g + 32 * ct + 16 * blk + 4 * p); af[ks] = cat8(tr16(va), tr16(va + 4 * 512)); }
    const bf16* wg = swb + (size_t)g * 128 * 128;
#pragma unroll 1
    for (int pt = 0; pt < 4; ++pt) {
        f32x16 acc;
#pragma unroll
        for (int i = 0; i < 16; ++i) acc[i] = 0.f;
        bf16x8_t bfr[8];
#pragma unroll
        for (int ks = 0; ks < 8; ++ks) bfr[ks] = *(const bf16x8_t*)(wg + (size_t)(32 * pt + r) * 128 + 16 * ks + 8 * hh);
#pragma unroll
        for (int ks = 0; ks < 8; ++ks) acc = MFMA32(af[ks], bfr[ks], acc);
        const int tok = row0 + 32 * pt + r;
        const float bs = sb[g * 128 + 32 * pt + r];
#pragma unroll
        for (int gq = 0; gq < 4; ++gq) { const int ch = 64 * g + 32 * ct + 8 * gq + 4 * hh;
            const v2u u = *(const v2u*)(Z + (size_t)tok * 512 + ch);
            v2u o; o.x = cvtpk(bflo(u.x) * (acc[4 * gq] + bs), bfhi(u.x) * (acc[4 * gq + 1] + bs)); o.y = cvtpk(bflo(u.y) * (acc[4 * gq + 2] + bs), bfhi(u.y) * (acc[4 * gq + 3] + bs));
            *(v2u*)(Y + (size_t)tok * D + 512 + ch) = o; }
    }
    __syncthreads();
}

__device__ __forceinline__ void conv_wave_item(const bf16* YC, const float* cw, const float* cb, float* CV, int item, int lane) {
    int base, stride, len, p0, ch0;
    if (item < 1024) { const int b = item >> 6, gr = (item >> 1) & 31; base = b * SEQ + gr * 64; stride = 1; len = 64; p0 = 32 * (item & 1); ch0 = 0; }
    else if (item < 2048) { const int it = item - 1024, b = it >> 6, c = it & 63; base = b * SEQ + c; stride = 64; len = 32; p0 = 0; ch0 = 128; }
    else { const int it = item - 2048, b = it >> 4, half = (it >> 3) & 1, sg = it & 7; base = ML + b * CTXL; stride = 1; len = 256; p0 = 32 * sg; ch0 = 128 * half; }
    const int ch = ch0 + 2 * lane;
    unsigned xin[62];
#pragma unroll
    for (int pp = 0; pp < 62; ++pp) { const int pos = p0 + pp - 15;
        xin[pp] = (pos >= 0 && pos < len) ? *(const unsigned*)(YC + (size_t)(base + pos * stride) * 256 + ch) : 0u; }
    f32x2 wk[31];
#pragma unroll
    for (int k = 0; k < 31; ++k) wk[k] = *(const f32x2*)(cw + k * 256 + ch);
    const f32x2 bias = *(const f32x2*)(cb + ch);
#pragma unroll
    for (int o = 0; o < 32; ++o) { f32x2 acc = bias;
#pragma unroll
        for (int k = 0; k < 31; ++k) { const unsigned w = xin[o + k]; acc.x += wk[k].x * bflo(w); acc.y += wk[k].y * bfhi(w); }
        *(f32x2*)(CV + (size_t)(base + (p0 + o) * stride) * 256 + ch) = acc; }
}

__device__ __forceinline__ void conv_finalize(const float* CV, const float* lg, const float* lb, bf16* Y, int nrows, int G, int tid) {
    asm volatile("" : "+v"(tid));
    const int lane = tid & 63, wave = __builtin_amdgcn_readfirstlane(tid >> 6);
    const int gw = blockIdx.x * NWAVES + wave, NGW = G * NWAVES;
    const int l16 = lane & 15, tq = lane >> 4;
    f32x4 gg[4], bb[4];
#pragma unroll
    for (int c = 0; c < 4; ++c) { gg[c] = *(const f32x4*)(lg + l16 * 16 + 4 * c); bb[c] = *(const f32x4*)(lb + l16 * 16 + 4 * c); }
#pragma unroll 2
    for (int r4 = gw; r4 < nrows / 4; r4 += NGW) {
        const int r = 4 * r4 + tq;
        f32x4 x[4];
#pragma unroll
        for (int c = 0; c < 4; ++c) x[c] = *(const f32x4*)(CV + (size_t)r * 256 + l16 * 16 + 4 * c);
        float s = 0.f;
#pragma unroll
        for (int c = 0; c < 4; ++c) s += (x[c].x + x[c].y) + (x[c].z + x[c].w);
        ROW_SUM16(s);
        const float mu = s * (1.0f / 256.0f); float vs = 0.f;
#pragma unroll
        for (int c = 0; c < 4; ++c) { x[c] = x[c] - mu; vs += (x[c].x * x[c].x + x[c].y * x[c].y) + (x[c].z * x[c].z + x[c].w * x[c].w); }
        ROW_SUM16(vs);
        const float rs = 1.0f / sqrtf(vs * (1.0f / 256.0f) + EPS);
        unsigned o[8];
#pragma unroll
        for (int c = 0; c < 4; ++c) { f32x4 y = x[c] * rs * gg[c] + bb[c];
            y.x *= fsigmoid(y.x); y.y *= fsigmoid(y.y); y.z *= fsigmoid(y.z); y.w *= fsigmoid(y.w);
            o[2 * c] = cvtpk(y.x, y.y); o[2 * c + 1] = cvtpk(y.z, y.w); }
        bf16* yp = Y + (size_t)r * D + 768 + l16 * 16;
        *(v4u*)yp = (v4u){o[0], o[1], o[2], o[3]}; *(v4u*)(yp + 8) = (v4u){o[4], o[5], o[6], o[7]};
    }
}
constexpr int N_PHASES = 18;
#ifndef MK_ONE_LAUNCH
#define MK_ONE_LAUNCH 0
#endif
#ifndef PH_MASK
#define PH_MASK 0x3ff
#endif
#ifndef REP_MASK
#define REP_MASK 0
#endif
#ifndef DEFER
#define DEFER 1
#endif
#ifndef SUBREP
#define SUBREP 0
#endif
#define SUBREPS(b) ((((SUBREP) >> (b)) & 1) + 1)
#define PH_EN(b) (((PH_MASK) >> (b)) & 1)

__global__ void __launch_bounds__(NTHREADS, 2) fwd_kernel(Args args) {
    extern __shared__ __attribute__((aligned(16))) unsigned char lds_raw[];
    LAS unsigned char* lds = (LAS unsigned char*)lds_raw;
    const int G = gridDim.x;
    unsigned char* ws = args.ws;
    volatile LAS unsigned* MISC = (volatile LAS unsigned*)(lds + MISC_OFF);
    for (int u = threadIdx.x; u < (LDS_BYTES - RING_BYTES) / 4; u += NTHREADS) ((LAS unsigned*)(lds + RING_BYTES))[u] = 0u;
    __syncthreads();
    XcdBarrier bar; bar.bar = (unsigned*)(ws + WS_CTL) + 4096; bar.x = 0; bar.st = nullptr;
    const int lo = args.ph_lo, hi = args.ph_hi;
    if (hi - lo > 1) bar = xcd_barrier_post((unsigned*)(ws + WS_CTL) + 4096, MISC + 8);
#define IN(k) (lo <= (k) && (k) < hi)
#define SEAM(k) do { if (IN(k) && IN((k) + 1)) xcd_barrier(bar); } while (0)

#pragma unroll 1
    for (int ph = lo; ph < hi; ++ph) {
#if REP_MASK
#pragma unroll 1
      for (int rep = 0; rep < ((ph >= 1 && ph <= 16 && (((REP_MASK) >> ((ph - 1) & 7)) & 1)) ? 2 : 1); ++rep) {
#else
      {
#endif
        int tid = threadIdx.x; asm volatile("" : "+v"(tid));
        const int lane = tid & 63, wave = __builtin_amdgcn_readfirstlane(tid >> 6);
        if (ph == 0) { if (PH_EN(8)) phase_prologue(args, lds, G, tid, lane, wave); }
        else if (ph == N_PHASES - 1) { if (PH_EN(9)) phase_final(args.out, args.in[I_FG], G, lane, wave); }
        else {
            const int l = (ph - 1) >> 3, k = (ph - 1) & 7;
            if (DEFER && (k == 5 || (k == 0 && l == 1))) continue;
            {
            const bool last = (l == DEPTH - 1);
            const int mrest = last ? ML : MT;
            const float* modl = (const float*)(ws + WS_MOD) + (size_t)l * 17 * MODW;
            const unsigned char* wl = ws + WS_W + (size_t)l * W_LAYER;
            if (k == 0 && PH_EN(0)) {
                phase_norm(l == 0 ? args.in[I_X] : args.out, l == 0 ? args.in[I_CTX] : (const float*)(ws + WS_XC), (bf16*)(ws + WS_A), args.in[I_N1G] + l * D, modl, 0, MT, G, lane, wave);
                if (DEFER) phase_shifts(args, lds, G, tid);
            } else if (k == 1 && PH_EN(1)) {
                int tk1 = tid; asm volatile("" : "+v"(tk1));
                pg8::Gemm g{(const bf16*)(ws + WS_A), (const bf16*)(wl + WO_IN), MT, NIN, D}; pg8::InLastOrder S; S.init(last, G, (int)blockIdx.x);
                pg8::EpiIn E{ws + WS_P, (!DEFER || l == 0) ? (const float*)(ws + WS_BIN) + l * NIN : (const float*)(ws + WS_SHIN), (!DEFER || l == 0) ? 0 : NIN, (!DEFER || l == 0) ? nullptr : (const float*)(ws + WS_SS) + 2 * MT};
                pg8::gemm_phase<pg8::EpiIn, pg8::InLastOrder, true, true>(lds, g, S, E, tk1);
            } else if (k == 2 && PH_EN(2)) {
                for (int rp = 0; rp < SUBREPS(0); ++rp)
                for (int it = blockIdx.x; it < 256; it += G)
                    mlstm_state_item((const bf16*)(ws + WS_K), (const bf16*)(ws + WS_V), (const float*)(ws + WS_GT), (bf16*)(ws + WS_CT), (float*)(ws + WS_NS), (float*)(ws + WS_TAB), it, !last, lds, tid);
                const int nch = mrest / 128;
                for (int rp = 0; rp < SUBREPS(1); ++rp)
                for (int it = blockIdx.x; it < nch; it += G)
                    sgu_item_mfma((const bf16*)(ws + WS_Z), args.in[I_SLG] + l * 256, args.in[I_SLB] + l * 256, (const bf16*)(ws + WS_SWB) + (size_t)l * 4 * 128 * 128, args.in[I_SB] + l * 4 * 128, (bf16*)(ws + WS_Y), it, lds, tid);
                { int tid2 = tid; asm volatile("" : "+v"(tid2)); const int lane2 = tid2 & 63, wave2 = __builtin_amdgcn_readfirstlane(tid2 >> 6);
                  const int ncv = last ? 2048 : 2304;
#pragma unroll 1
                  for (int rp = 0; rp < SUBREPS(2); ++rp)
#pragma unroll 1
                  for (int it = blockIdx.x * NWAVES + wave2; it < ncv; it += G * NWAVES)
                      conv_wave_item((const bf16*)(ws + WS_YC), args.in[I_CW] + l * 31 * 256, args.in[I_CB] + l * 256, (float*)(ws + WS_CV), it, lane2); }
            } else if (k == 3 && PH_EN(3)) {
                for (int rp = 0; rp < SUBREPS(3); ++rp)
                mlstm_out_phase((const bf16*)(ws + WS_Q), (const bf16*)(ws + WS_K), (const bf16*)(ws + WS_V), (const bf16*)(ws + WS_OG), (const bf16*)(ws + WS_CT), (const float*)(ws + WS_NS), (const float*)(ws + WS_TAB),
                                args.in[I_MG] + l * HW, (bf16*)(ws + WS_Y), last ? 2 : 0, G, lds, tid);
                for (int rp = 0; rp < SUBREPS(4); ++rp)
                conv_finalize((const float*)(ws + WS_CV), args.in[I_CLG] + l * 256, args.in[I_CLB] + l * 256, (bf16*)(ws + WS_Y), mrest, G, tid);
            } else if (k == 4 && PH_EN(4)) {
                int tk2 = tid; asm volatile("" : "+v"(tk2));
                pg8::Gemm g{(const bf16*)(ws + WS_Y), (const bf16*)(wl + WO_OUT), mrest, D, D}; pg8::StaticOrder S; S.init(mrest, D, G, (int)blockIdx.x);
                pg8::EpiRes<DEFER != 0> E{l == 0 ? args.in[I_X] : args.out, args.out, l == 0 ? args.in[I_CTX] : (const float*)(ws + WS_XC), (float*)(ws + WS_XC), modl + 2 * D, ML,
                              (bf16*)(ws + WS_A), (const float*)(ws + WS_GS) + (size_t)((l * 2 + 1) * 17) * 1024, (float*)(ws + WS_SS) + (size_t)l * MT, lds + MX_OFF};
                pg8::gemm_phase<pg8::EpiRes<DEFER != 0>, pg8::StaticOrder, true, true>(lds, g, S, E, tk2);
            } else if (k == 5 && PH_EN(5)) {
                phase_norm(args.out, (const float*)(ws + WS_XC), (bf16*)(ws + WS_A), args.in[I_N2G] + l * D, modl, 3 * D, mrest, G, lane, wave);
            } else if (k == 6 && PH_EN(6)) {
                int tk3 = tid; asm volatile("" : "+v"(tk3));
                pg8::Gemm g{(const bf16*)(ws + WS_A), (const bf16*)(wl + WO_GU), mrest, NGU, D}; pg8::StaticOrder S; S.init(mrest, NGU, G, (int)blockIdx.x);
                pg8::EpiGU E{(bf16*)(ws + WS_H), DEFER ? (const float*)(ws + WS_SS) + (size_t)l * MT : nullptr, DEFER ? (const float*)(ws + WS_SHGU) + (size_t)l * 17 * NGU : nullptr};
                pg8::gemm_phase<pg8::EpiGU, pg8::StaticOrder, true, true>(lds, g, S, E, tk3);
            } else if (PH_EN(7)) {
                int tk4 = tid; asm volatile("" : "+v"(tk4));
                pg8::Gemm g{(const bf16*)(ws + WS_H), (const bf16*)(wl + WO_DOWN), mrest, D, FF}; pg8::StaticOrder S; S.init(mrest, D, G, (int)blockIdx.x);
                pg8::EpiRes<DEFER != 0> E{args.out, args.out, (const float*)(ws + WS_XC), (float*)(ws + WS_XC), modl + 5 * D, ML,
                              (bf16*)(ws + WS_A), (const float*)(ws + WS_GS) + (size_t)(2 * 17) * 1024, (float*)(ws + WS_SS) + 2 * (size_t)MT, lds + MX_OFF};
                pg8::gemm_phase<pg8::EpiRes<DEFER != 0>, pg8::StaticOrder, true, true>(lds, g, S, E, tk4);
            }
            }
        }
      }
        if (ph + 1 < hi) xcd_barrier(bar);
    }
#undef IN
#undef SEAM
}

extern "C" void kernel_launch(void* const* d_in, const int* in_sizes, int n_in, void* d_out, int out_size, void* d_ws, size_t ws_size, hipStream_t stream) {
    static int grid = 0;
    if (grid == 0) {
        if (n_in != 23 || in_sizes[0] != ML * D || out_size != ML * D || ws_size < WS_END) {
            fprintf(stderr, "kernel_launch: unexpected problem (n_in %d, in0 %d, out %d, ws %zu < %zu); nothing launched\n", n_in, n_in > 0 ? in_sizes[0] : -1, out_size, ws_size, (size_t)WS_END); grid = -1; return; }
        int dev = 0, cus = 0, per_cu = 0;
        if (hipGetDevice(&dev) != hipSuccess || hipDeviceGetAttribute(&cus, hipDeviceAttributeMultiprocessorCount, dev) != hipSuccess) { grid = -1; return; }
        if (hipFuncSetAttribute((const void*)fwd_kernel, hipFuncAttributeMaxDynamicSharedMemorySize, LDS_BYTES) != hipSuccess) { fprintf(stderr, "kernel_launch: hipFuncSetAttribute failed\n"); grid = -1; return; }
        if (hipOccupancyMaxActiveBlocksPerMultiprocessor(&per_cu, (const void*)fwd_kernel, NTHREADS, LDS_BYTES) != hipSuccess || per_cu < 1) {
            fprintf(stderr, "kernel_launch: occupancy query reports %d blocks per CU\n", per_cu); per_cu = 1; }
        (void)hipGetLastError();
        grid = cus;
    }
    if (grid < 0) return;
    if (hipMemsetAsync((char*)d_ws + WS_CTL, 0, ZERO_BYTES, stream) != hipSuccess) { fprintf(stderr, "kernel_launch: memset failed\n"); return; }
    Args a{};
    for (int i = 0; i < 23; ++i) a.in[i] = (const float*)d_in[i];
    a.out = (float*)d_out; a.ws = (unsigned char*)d_ws;
#if MK_ONE_LAUNCH
    a.ph_lo = 0; a.ph_hi = N_PHASES;
    hipLaunchKernelGGL(fwd_kernel, dim3(grid), dim3(NTHREADS), LDS_BYTES, stream, a);
#else
    for (int p = 0; p < N_PHASES; ++p) { a.ph_lo = p; a.ph_hi = p + 1; hipLaunchKernelGGL(fwd_kernel, dim3(grid), dim3(NTHREADS), LDS_BYTES, stream, a); }
#endif
    const hipError_t le = hipPeekAtLastError();
    if (le != hipSuccess) fprintf(stderr, "kernel_launch: launch failed: %s\n", hipGetErrorName(le));
}
```

```cpp
#include <hip/hip_runtime.h>
#include <cstdio>
#include <cstdint>
#ifndef MK_ONE_LAUNCH
#define MK_ONE_LAUNCH 1
#endif
namespace pg8 {
#define PG8_LAS __attribute__((address_space(3)))
typedef unsigned short bf16_t;
typedef short bf16x8 __attribute__((ext_vector_type(8)));
typedef float f32x4 __attribute__((ext_vector_type(4)));
typedef unsigned u32x4 __attribute__((ext_vector_type(4)));
constexpr int BM = 256, BK = 64, HALF = 128, HTB = HALF * BK * 2  , STAGE_BYTES = 8 * HTB, NXCD = 8, WGM = 4;

__host__ __device__ __forceinline__ int lds_byte(int r, int c) { const int st = (r >> 4) * 2 + (c >> 5), rr = r & 15, cc = c & 31, ob = rr * 64 + cc * 2; return st * 1024 + (ob ^ (((ob >> 9) & 1) << 5)); }
__host__ __device__ __forceinline__ void stage_rc(int b, int& R, int& C) { const int st = b / 1024, sb = b % 1024, swz = sb ^ (((sb >> 9) & 1) << 5); R = (st >> 1) * 16 + swz / 64; C = (st & 1) * 32 + (swz % 64) / 2; }
__host__ __device__ __forceinline__ int perm32(int rho) { const int n = rho >> 4, i = rho & 15; return 8 * (i >> 2) + 4 * n + (i & 3); }

struct Unit { int pm, pn; };
struct Gemm { const bf16_t* A; const bf16_t* Bt; int M, N, K; };

struct StaticOrder {
    int nM, nN, nwg, G, c;
    __host__ __device__ void init(int M, int N, int G_, int c_) { nM = M / BM; nN = N / BM; nwg = nM * nN; G = G_; c = c_; }
    __host__ __device__ bool next(int i, Unit& u) const {
        const long L = (long)i * G + c; if (L >= nwg) return false;
        int wgid = (int)L; { const int q = nwg / NXCD, r = nwg % NXCD, xcd = wgid % NXCD, off = wgid / NXCD; wgid = (xcd < r ? xcd * (q + 1) : r * (q + 1) + (xcd - r) * q) + off; }
        const int nig = WGM * nN, gid = wgid / nig, fm = gid * WGM, gsz = (nM - fm) < WGM ? (nM - fm) : WGM;
        u.pm = fm + ((wgid % nig) % gsz); u.pn = (wgid % nig) / gsz; return true;
    }
    __device__ __forceinline__ void a_ready(const Unit&) const {}
    __device__ __forceinline__ void done(const Unit&) const {}
};

__device__ __forceinline__ unsigned cvt_pk_bf16(float lo, float hi) { unsigned r; asm volatile("v_cvt_pk_bf16_f32 %0, %1, %2" : "=v"(r) : "v"(lo), "v"(hi)); return r; }
template <class Epi, class Sched, bool ALIGN_EPI = false, bool SP2 = false>
__device__ __forceinline__ void gemm_phase(PG8_LAS unsigned char* lds, const Gemm g, const Sched& S, const Epi& E, const int tid) {
    const int wid = __builtin_amdgcn_readfirstlane(tid >> 6), lane = tid & 63, wr = wid >> 2, wc = wid & 3, fr = lane & 15, fq = lane >> 4;
    const int K = g.K, nt = K / BK;
    unsigned voffA[2], voffB[2];
#pragma unroll
    for (int i = 0; i < 2; ++i) { int R, C; stage_rc(tid * 16 + i * 8192, R, C); const int Rb = Epi::PERM ? ((R & ~31) + perm32(R & 31)) : R;
        voffA[i] = (unsigned)(R * K + C) * 2u; voffB[i] = (unsigned)(Rb * K + C) * 2u; }
    const size_t kstep = (size_t)(BK * 2);
    const size_t hstep = (size_t)HALF * K * 2;
    const size_t tstep = 2 * hstep;
    const unsigned ldsw = (unsigned)wid * 1024u;
    const int aoff = lds_byte(wr * 64 + fr, fq * 8), boff = lds_byte(wc * 32 + fr, fq * 8);
#define PG8_SA(b, h) (((b) * 2 + (h)) * HTB)
#define PG8_SB(b, h) ((4 + (b) * 2 + (h)) * HTB)
#define PG8_STAGE(bufoff, gbase, voff) do { _Pragma("unroll") for (int _i = 0; _i < 2; ++_i) \
        __builtin_amdgcn_global_load_lds((const unsigned*)((const char*)(gbase) + (voff)[_i]), (PG8_LAS unsigned*)(lds + (bufoff) + ldsw + _i * 8192), 16, 0, 0); } while (0)
#define PG8_LDA(dst, b, h) do { _Pragma("unroll") for (int m = 0; m < 4; ++m) _Pragma("unroll") for (int k = 0; k < 2; ++k) dst[m][k] = *(const PG8_LAS bf16x8*)(lds + PG8_SA(b, h) + aoff + m * 2048 + k * 1024); } while (0)
#define PG8_LDB(dst, b, h) do { _Pragma("unroll") for (int n = 0; n < 2; ++n) _Pragma("unroll") for (int k = 0; k < 2; ++k) dst[n][k] = *(const PG8_LAS bf16x8*)(lds + PG8_SB(b, h) + boff + n * 2048 + k * 1024); } while (0)
#define PG8_MMA(ai, bj, At, Bt) do { __builtin_amdgcn_s_setprio(1); _Pragma("unroll") for (int m = 0; m < 4; ++m) _Pragma("unroll") for (int n = 0; n < 2; ++n) _Pragma("unroll") for (int k = 0; k < 2; ++k) \
        acc[ai][bj][m][n] = __builtin_amdgcn_mfma_f32_16x16x32_bf16(Bt[n][k], At[m][k], acc[ai][bj][m][n], 0, 0, 0); __builtin_amdgcn_s_setprio(0); } while (0)
#define PG8_WAIT_V(n) asm volatile("s_waitcnt vmcnt(" #n ")" ::: "memory")
#define PG8_WAIT_L(n) asm volatile("s_waitcnt lgkmcnt(" #n ")" ::: "memory")
#define PG8_BAR __builtin_amdgcn_s_barrier()
#define PG8_SCHED __builtin_amdgcn_sched_barrier(0)
    Unit cur, nxt; int ui = 0;
    if (!S.next(0, cur)) return;
    f32x4 acc[2][2][4][2];
#pragma unroll
    for (int a = 0; a < 2; ++a)
#pragma unroll
        for (int b = 0; b < 2; ++b)
#pragma unroll
            for (int m = 0; m < 4; ++m)
#pragma unroll
                for (int n = 0; n < 2; ++n) acc[a][b][m][n] = (f32x4){0.f, 0.f, 0.f, 0.f};
    bf16x8 At[4][2], B0[2][2], B1[2][2];
    const char* cA = (const char*)g.A + (size_t)cur.pm * tstep; const char* cB = (const char*)g.Bt + (size_t)cur.pn * tstep;
    S.a_ready(cur);
    if constexpr (SP2) {
        PG8_STAGE(PG8_SB(0, 0), cB, voffB); PG8_STAGE(PG8_SB(0, 1), cB + hstep, voffB); PG8_STAGE(PG8_SA(0, 0), cA, voffA); PG8_STAGE(PG8_SA(0, 1), cA + hstep, voffA);
        if (wr == 1) PG8_BAR;
        PG8_WAIT_V(2); PG8_BAR;
        PG8_STAGE(PG8_SB(1, 0), cB + kstep, voffB); PG8_STAGE(PG8_SA(1, 0), cA + kstep, voffA); PG8_STAGE(PG8_SB(1, 1), cB + hstep + kstep, voffB);
        PG8_WAIT_V(6); PG8_BAR;
    } else {
        PG8_STAGE(PG8_SB(0, 0), cB, voffB); PG8_STAGE(PG8_SA(0, 0), cA, voffA); PG8_STAGE(PG8_SB(0, 1), cB + hstep, voffB); PG8_STAGE(PG8_SA(0, 1), cA + hstep, voffA);
        if (wr == 1) PG8_BAR;
        PG8_WAIT_V(4); PG8_BAR;
        PG8_STAGE(PG8_SB(1, 0), cB + kstep, voffB); PG8_STAGE(PG8_SA(1, 0), cA + kstep, voffA); PG8_STAGE(PG8_SB(1, 1), cB + hstep + kstep, voffB);
        PG8_WAIT_V(6); PG8_BAR;
    }
    for (;;) {
        const bool has_next = S.next(ui + 1, nxt);
        const char* nA = has_next ? (const char*)g.A + (size_t)nxt.pm * tstep : cA; const char* nB = has_next ? (const char*)g.Bt + (size_t)nxt.pn * tstep : cB;
        for (int t = 0; t < nt; t += 2) {
            const bool last = (t == nt - 2);
            const char* a1 = cA + (size_t)(t + 1) * kstep;
            const char* a2 = last ? nA : cA + (size_t)(t + 2) * kstep; const char* b2 = last ? nB : cB + (size_t)(t + 2) * kstep;
            const char* a3 = a2 + kstep; const char* b3 = b2 + kstep;
            if (last && has_next) S.a_ready(nxt);
            if constexpr (SP2) {
            PG8_LDB(B0, 0, 0); PG8_LDB(B1, 0, 1); PG8_SCHED; PG8_LDA(At, 0, 0); PG8_STAGE(PG8_SA(1, 1), a1 + hstep, voffA);
            PG8_WAIT_V(8); PG8_WAIT_L(0); PG8_BAR; PG8_MMA(0, 0, At, B0); PG8_MMA(0, 1, At, B1); PG8_BAR; PG8_SCHED;
            PG8_LDA(At, 0, 1); PG8_STAGE(PG8_SB(0, 0), b2, voffB); PG8_STAGE(PG8_SB(0, 1), b2 + hstep, voffB); PG8_STAGE(PG8_SA(0, 0), a2, voffA);
            PG8_WAIT_V(8); PG8_WAIT_L(0); PG8_BAR; PG8_MMA(1, 0, At, B0); PG8_MMA(1, 1, At, B1); PG8_BAR; PG8_SCHED;
            PG8_LDB(B0, 1, 0); PG8_LDB(B1, 1, 1); PG8_SCHED; PG8_LDA(At, 1, 0); PG8_STAGE(PG8_SA(0, 1), a2 + hstep, voffA);
            PG8_WAIT_V(8); PG8_WAIT_L(0); PG8_BAR; PG8_MMA(0, 0, At, B0); PG8_MMA(0, 1, At, B1); PG8_BAR; PG8_SCHED;
            PG8_LDA(At, 1, 1); PG8_STAGE(PG8_SB(1, 0), b3, voffB); PG8_STAGE(PG8_SB(1, 1), b3 + hstep, voffB); PG8_STAGE(PG8_SA(1, 0), a3, voffA);
            PG8_WAIT_V(8); PG8_WAIT_L(0); PG8_BAR; PG8_MMA(1, 0, At, B0); PG8_MMA(1, 1, At, B1); PG8_BAR; PG8_SCHED;
            } else {
            PG8_LDB(B0, 0, 0); PG8_SCHED; PG8_LDA(At, 0, 0); PG8_STAGE(PG8_SA(1, 1), a1 + hstep, voffA);
            PG8_WAIT_L(8); PG8_BAR; PG8_WAIT_L(0); PG8_MMA(0, 0, At, B0); PG8_BAR; PG8_SCHED;
            PG8_LDB(B1, 0, 1); PG8_STAGE(PG8_SB(0, 0), b2, voffB);
            PG8_BAR; PG8_WAIT_L(0); PG8_MMA(0, 1, At, B1); PG8_BAR;
            PG8_LDA(At, 0, 1); PG8_STAGE(PG8_SA(0, 0), a2, voffA);
            PG8_BAR; PG8_WAIT_L(0); PG8_MMA(1, 0, At, B0); PG8_BAR; PG8_SCHED;
            PG8_STAGE(PG8_SB(0, 1), b2 + hstep, voffB);
            PG8_WAIT_V(6); PG8_BAR; PG8_MMA(1, 1, At, B1); PG8_BAR;
            PG8_LDB(B0, 1, 0); PG8_SCHED; PG8_LDA(At, 1, 0); PG8_STAGE(PG8_SA(0, 1), a2 + hstep, voffA);
            PG8_WAIT_L(8); PG8_BAR; PG8_WAIT_L(0); PG8_MMA(0, 0, At, B0); PG8_BAR; PG8_SCHED;
            PG8_LDB(B1, 1, 1); PG8_STAGE(PG8_SB(1, 0), b3, voffB);
            PG8_BAR; PG8_WAIT_L(0); PG8_MMA(0, 1, At, B1); PG8_BAR;
            PG8_LDA(At, 1, 1); PG8_STAGE(PG8_SA(1, 0), a3, voffA);
            PG8_BAR; PG8_WAIT_L(0); PG8_MMA(1, 0, At, B0); PG8_BAR; PG8_SCHED;
            PG8_STAGE(PG8_SB(1, 1), b3 + hstep, voffB);
            PG8_WAIT_V(6); PG8_BAR; PG8_MMA(1, 1, At, B1); PG8_BAR;
            }
        }
        if constexpr (ALIGN_EPI) { if (wr == 0) PG8_BAR; }
        if constexpr (!Epi::AFTER_DRAIN) { E(acc, cur, wr, wc, fr, fq); S.done(cur); }
        if (!has_next) break;
#pragma unroll
        for (int a = 0; a < 2; ++a)
#pragma unroll
            for (int b = 0; b < 2; ++b)
#pragma unroll
                for (int m = 0; m < 4; ++m)
#pragma unroll
                    for (int n = 0; n < 2; ++n) acc[a][b][m][n] = (f32x4){0.f, 0.f, 0.f, 0.f};
        cur = nxt; cA = nA; cB = nB; ++ui;
        if constexpr (ALIGN_EPI) { if (wr == 1) PG8_BAR; }
    }
    PG8_WAIT_V(0);
    if constexpr (!ALIGN_EPI) { if (wr == 0) PG8_BAR; }
    PG8_BAR;
    if constexpr (Epi::AFTER_DRAIN) { E.fused(acc, cur, wr, wc, fr, fq, lds, wid, lane); S.done(cur); }
#undef PG8_SA
#undef PG8_SB
#undef PG8_STAGE
#undef PG8_LDA
#undef PG8_LDB
#undef PG8_MMA
#undef PG8_WAIT_V
#undef PG8_WAIT_L
#undef PG8_BAR
#undef PG8_SCHED
}
}
namespace pg8 {
struct InLastOrder {
    StaticOrder main; int G, c;
    int ntail;
    __device__ void init(bool last, int G_, int c_) { main.init((last ? 128 : 144) * BM, 13 * BM, G_, c_); G = G_; c = c_; ntail = last ? 80 : 0; }
    __device__ bool next(int i, Unit& u) const {
        const long L = (long)i * G + c;
        if (L < main.nwg) return main.next(i, u);
        const int e = (int)(L - main.nwg); if (e >= ntail) return false;
        const int q = e % 5; u.pm = 128 + e / 5; u.pn = q < 4 ? 2 + q : 12; return true;
    }
    __device__ __forceinline__ void a_ready(const Unit&) const {}
    __device__ __forceinline__ void done(const Unit&) const {}
};
__device__ __forceinline__ u32x4 pack8(const f32x4& v0, const f32x4& v1) { u32x4 w; w.x = cvt_pk_bf16(v0[0], v0[1]); w.y = cvt_pk_bf16(v0[2], v0[3]); w.z = cvt_pk_bf16(v1[0], v1[1]); w.w = cvt_pk_bf16(v1[2], v1[3]); return w; }
__device__ __forceinline__ float sigm(float x) { return __builtin_amdgcn_rcpf(1.0f + __expf(-x)); }
__device__ __forceinline__ f32x4 sigm4(const f32x4& v) { return (f32x4){sigm(v[0]), sigm(v[1]), sigm(v[2]), sigm(v[3])}; }
__device__ __forceinline__ float gelu_t(float x) { const float u = 1.5957691216057308f * (x + 0.044715f * x * x * x); return x * sigm(u); }
__device__ __forceinline__ f32x4 gelu4(const f32x4& v) { return (f32x4){gelu_t(v[0]), gelu_t(v[1]), gelu_t(v[2]), gelu_t(v[3])}; }

struct EpiIn {
    static constexpr bool PERM = true, AFTER_DRAIN = false;
    unsigned char* P; const float* bias; int bstride; const float* ss;
    __device__ __forceinline__ void operator()(const f32x4 (&acc)[2][2][4][2], const Unit& u, int wr, int wc, int fr, int fq) const {
        const int pn = u.pn, row0 = u.pm * BM + wr * 64 + fr, cl = wc * 32 + 8 * fq;
        const float* bp = bias + (size_t)(u.pm < 128 ? (u.pm >> 3) : 16) * bstride;
        f32x4 bv[2][2];
#pragma unroll
        for (int bj = 0; bj < 2; ++bj)
#pragma unroll
            for (int n = 0; n < 2; ++n) bv[bj][n] = *(const f32x4*)(bp + pn * BM + bj * HALF + cl + 4 * n);
        float rsc[2][4];
#pragma unroll
        for (int ai = 0; ai < 2; ++ai)
#pragma unroll
            for (int m = 0; m < 4; ++m) rsc[ai][m] = ss ? 1.0f / sqrtf(ss[row0 + ai * HALF + m * 16] * (1.0f / 1024.0f) + 1e-6f) : 1.0f;
        if (pn < 10) {
            bf16_t* base = (bf16_t*)(P + (size_t)(pn >> 1) * (36u << 20));
            const float sc = (pn >= 2 && pn < 4) ? 0.08838834764831845f : 1.0f;
            const int act = pn < 6 ? 0 : pn < 8 ? 1 : 2;
            const int dcol = (pn & 1) * BM + cl;
#pragma unroll
            for (int ai = 0; ai < 2; ++ai)
#pragma unroll
                for (int m = 0; m < 4; ++m) { bf16_t* rowp = base + (size_t)(row0 + ai * HALF + m * 16) * 512 + dcol;
#pragma unroll
                    for (int bj = 0; bj < 2; ++bj) { f32x4 v0 = acc[ai][bj][m][0] * rsc[ai][m] + bv[bj][0], v1 = acc[ai][bj][m][1] * rsc[ai][m] + bv[bj][1];
                        if (act == 1) { v0 = sigm4(v0); v1 = sigm4(v1); } else if (act == 2) { v0 = gelu4(v0); v1 = gelu4(v1); } else { v0 = v0 * sc; v1 = v1 * sc; }
                        *(u32x4*)(rowp + bj * HALF) = pack8(v0, v1); } }
        } else if (pn < 12) {
            const int dcol = (pn - 10) * HALF + cl;
#pragma unroll
            for (int ai = 0; ai < 2; ++ai)
#pragma unroll
                for (int m = 0; m < 4; ++m) { bf16_t* rowp = (bf16_t*)(P + (size_t)5 * (36u << 20)) + (size_t)(row0 + ai * HALF + m * 16) * 256 + dcol;
                    const f32x4 a0 = acc[ai][0][m][0] * rsc[ai][m] + bv[0][0], a1 = acc[ai][0][m][1] * rsc[ai][m] + bv[0][1];
                    const f32x4 g0 = sigm4(acc[ai][1][m][0] * rsc[ai][m] + bv[1][0]), g1 = sigm4(acc[ai][1][m][1] * rsc[ai][m] + bv[1][1]);
                    *(u32x4*)rowp = pack8(a0 * g0, a1 * g1); }
        } else {
            if (wc == 0 && fq < 2) {
#pragma unroll
                for (int ai = 0; ai < 2; ++ai)
#pragma unroll
                    for (int m = 0; m < 4; ++m) { float* rowp = (float*)(P + (size_t)5 * (36u << 20) + (18u << 20)) + (size_t)(row0 + ai * HALF + m * 16) * 16 + 8 * fq;
                        *(f32x4*)rowp = acc[ai][0][m][0] * rsc[ai][m] + bv[0][0]; *(f32x4*)(rowp + 4) = acc[ai][0][m][1] * rsc[ai][m] + bv[0][1]; }
            }
        }
    }
};

struct EpiGU {
    static constexpr bool PERM = true, AFTER_DRAIN = false;
    bf16_t* H; const float* ss; const float* shb;
    __device__ __forceinline__ void operator()(const f32x4 (&acc)[2][2][4][2], const Unit& u, int wr, int wc, int fr, int fq) const {
        const int row0 = u.pm * BM + wr * 64 + fr, cl = wc * 32 + 8 * fq, dcol = u.pn * HALF + cl;
        f32x4 sg0 = {0.f, 0.f, 0.f, 0.f}, sg1 = sg0, su0 = sg0, su1 = sg0;
        if (shb) { const float* sp = shb + (size_t)(u.pm < 128 ? (u.pm >> 3) : 16) * 5632 + u.pn * BM + cl; sg0 = *(const f32x4*)sp; sg1 = *(const f32x4*)(sp + 4); su0 = *(const f32x4*)(sp + HALF); su1 = *(const f32x4*)(sp + HALF + 4); }
#pragma unroll
        for (int ai = 0; ai < 2; ++ai)
#pragma unroll
            for (int m = 0; m < 4; ++m) { const int row = row0 + ai * HALF + m * 16; bf16_t* rowp = H + (size_t)row * 2816 + dcol;
                const float rs = ss ? 1.0f / sqrtf(ss[row] * (1.0f / 1024.0f) + 1e-6f) : 1.0f;
                const f32x4 g0 = acc[ai][0][m][0] * rs + sg0, g1 = acc[ai][0][m][1] * rs + sg1;
                *(u32x4*)rowp = pack8(g0 * sigm4(g0) * (acc[ai][1][m][0] * rs + su0), g1 * sigm4(g1) * (acc[ai][1][m][1] * rs + su1)); }
    }
};

template <bool WA2> struct EpiRes {
    static constexpr bool PERM = false, AFTER_DRAIN = false;
    const float* baseL; float* outL; const float* baseC; float* outC; const float* gate; int nlat;
    bf16_t* A2; const float* gs; float* ss;
    PG8_LAS unsigned char* xl;
    __device__ __forceinline__ void operator()(const f32x4 (&acc)[2][2][4][2], const Unit& u, int wr, int wc, int fr, int fq) const {
        const int trow = u.pm * BM; const bool lat = trow < nlat;
        const char* base = (const char*)(lat ? baseL + (size_t)trow * 1024 : baseC + (size_t)(trow - nlat) * 1024);
        char* out = (char*)(lat ? outL + (size_t)trow * 1024 : outC + (size_t)(trow - nlat) * 1024);
        char* ap = (char*)(A2 + (size_t)trow * 1024);
        const int mrow = lat ? (trow >> 11) : 16;
        const float* gv = gate + (size_t)mrow * 6144; const float* gsv = gs + (size_t)mrow * 1024;
        PG8_LAS float* sl = (PG8_LAS float*)(xl + (wr * 4 + wc) * 2304);
        const int lane = fr + 16 * fq, rr = lane >> 3, cq = lane & 7;
        const int colm = u.pn * BM + wc * 32 + 4 * fq;
        const int colr = u.pn * BM + wc * 32 + 4 * cq;
        f32x4 g[2][2], gsc[2];
#pragma unroll
        for (int bj = 0; bj < 2; ++bj) { gsc[bj] = WA2 ? *(const f32x4*)(gsv + colr + bj * HALF) : (f32x4){0.f, 0.f, 0.f, 0.f};
#pragma unroll
            for (int n = 0; n < 2; ++n) g[bj][n] = *(const f32x4*)(gv + colm + bj * HALF + n * 16); }
        const unsigned lo = (unsigned)((wr * 64 + rr) * 1024 + colr) * 4u;
        f32x4 bv[2][2][2];
#define ER_LOAD(gi) do { _Pragma("unroll") for (int bj = 0; bj < 2; ++bj) _Pragma("unroll") for (int ps = 0; ps < 2; ++ps) \
            bv[(gi) & 1][bj][ps] = *(const f32x4*)(base + (size_t)(lo + (unsigned)(((((gi) >> 2) * HALF + ((gi) & 3) * 16 + 8 * ps) * 1024 + bj * HALF) * 4))); } while (0)
        ER_LOAD(0);
#pragma unroll
        for (int gi = 0; gi < 8; ++gi) { const int ai = gi >> 2, m = gi & 3;
            float q0 = 0.f, q1 = 0.f;
            f32x4 o[2][2];
#pragma unroll
            for (int bj = 0; bj < 2; ++bj) {
                *(PG8_LAS f32x4*)(sl + fr * 36 + 4 * fq) = g[bj][0] * acc[ai][bj][m][0]; *(PG8_LAS f32x4*)(sl + fr * 36 + 16 + 4 * fq) = g[bj][1] * acc[ai][bj][m][1];
                o[bj][0] = bv[gi & 1][bj][0] + *(const PG8_LAS f32x4*)(sl + rr * 36 + 4 * cq); o[bj][1] = bv[gi & 1][bj][1] + *(const PG8_LAS f32x4*)(sl + (rr + 8) * 36 + 4 * cq);
            }
            asm volatile("" ::: "memory");
            if (gi < 7) ER_LOAD(gi + 1);
            asm volatile("" ::: "memory");
#pragma unroll
            for (int bj = 0; bj < 2; ++bj)
#pragma unroll
                for (int ps = 0; ps < 2; ++ps) { const unsigned off = lo + (unsigned)((((ai * HALF + m * 16 + 8 * ps) * 1024) + bj * HALF) * 4); const f32x4 v = o[bj][ps];
                    *(f32x4*)(out + (size_t)off) = v;
                    if (WA2) { const float qq = (v[0] * v[0] + v[1] * v[1]) + (v[2] * v[2] + v[3] * v[3]); if (ps) q1 += qq; else q0 += qq; const f32x4 a = v * gsc[bj];
                        typedef unsigned u32x2v __attribute__((ext_vector_type(2))); u32x2v w; w.x = cvt_pk_bf16(a[0], a[1]); w.y = cvt_pk_bf16(a[2], a[3]);
                        *(u32x2v*)(ap + (size_t)(off >> 1)) = w; } }
            if (WA2) {
                q0 += __shfl_xor(q0, 1); q0 += __shfl_xor(q0, 2); q0 += __shfl_xor(q0, 4); q1 += __shfl_xor(q1, 1); q1 += __shfl_xor(q1, 2); q1 += __shfl_xor(q1, 4);
                if (cq == 0) { float* sp = ss + trow + wr * 64 + ai * HALF + m * 16 + rr; atomicAdd(sp, q0); atomicAdd(sp + 8, q1); } }
            asm volatile("" ::: "memory");
        }
#undef ER_LOAD
    }
};
}
constexpr int D = 1024, NB = 16, SEQ = 2048, CTXL = 256, DEPTH = 2;
constexpr int ML = NB * SEQ, MC = NB * CTXL, MT = ML + MC;
constexpr int NIN_O = 3088, NIN = 3328, FF = 2816, NGU = 2 * FF;
constexpr int HW = 512;
constexpr int MODW = 6 * D;
constexpr float EPS = 1e-6f;
constexpr int NWAVES = 8, NTHREADS = 512;

constexpr size_t MiB = 1u << 20;
constexpr size_t WS_CTL = 0;
constexpr size_t WS_MOD = 1 * MiB;
constexpr size_t WS_SHGU = 2 * MiB;
constexpr size_t WS_SHIN = 2 * MiB + 768 * 1024;
constexpr size_t WS_SS = 3 * MiB;
constexpr size_t ZERO_BYTES = 3 * MiB + 512 * 1024;
constexpr size_t WS_BIN = 3 * MiB + 512 * 1024;
constexpr size_t WS_SWB = WS_BIN + 65536;
constexpr size_t WS_GS = 4 * MiB;
constexpr size_t WS_W = 5 * MiB, W_LAYER = 25 * MiB;
constexpr size_t WO_IN = 0, WO_OUT = 6 * MiB + 512 * 1024, WO_GU = WO_OUT + 2 * MiB, WO_DOWN = WO_GU + 11 * MiB;
constexpr size_t WS_XC = 55 * MiB;
constexpr size_t WS_A = 71 * MiB;
constexpr size_t WS_P = 143 * MiB;
constexpr size_t WS_Q = WS_P, WS_K = WS_Q + 36 * MiB, WS_V = WS_K + 36 * MiB, WS_OG = WS_V + 36 * MiB, WS_Z = WS_OG + 36 * MiB, WS_YC = WS_Z + 36 * MiB, WS_GT = WS_YC + 18 * MiB;
constexpr size_t WS_H = WS_P;
constexpr size_t WS_Y = 344 * MiB;
constexpr size_t WS_CT = WS_A;
constexpr size_t WS_NS = 454 * MiB, WS_TAB = 460 * MiB;
constexpr size_t WS_CV = 418 * MiB;
constexpr size_t WS_END = 486 * MiB;
static_assert(WS_GT + (size_t)MT * 16 * 4 <= WS_Y && WS_H + (size_t)MT * FF * 2 <= WS_Y && WS_W + 2 * W_LAYER <= WS_XC && WO_DOWN + (size_t)D * FF * 2 <= W_LAYER && WS_Y + (size_t)MT * D * 2 <= WS_CV && WS_SS + 3 * (size_t)MT * 4 <= ZERO_BYTES && WS_SHIN + 17 * (size_t)NIN * 4 <= WS_SS && WS_SHGU + 2 * 17 * (size_t)NGU * 4 <= WS_SHIN && WS_GS + 4 * 17 * 1024 * 4 <= WS_W, "ws map");

constexpr int RING_BYTES = 131072, MISC_OFF = RING_BYTES + 320, LDS_BYTES = 151552;

#define GAS __attribute__((address_space(1)))
#define LAS __attribute__((address_space(3)))
typedef unsigned short bf16;
typedef unsigned v4u __attribute__((ext_vector_type(4)));
typedef unsigned v2u __attribute__((ext_vector_type(2)));
typedef float f32x4 __attribute__((ext_vector_type(4)));
typedef float f32x2 __attribute__((ext_vector_type(2)));
#define LDS_WAIT() asm volatile("s_waitcnt lgkmcnt(0)" ::: "memory")
__device__ __forceinline__ unsigned f2bf(float f) { unsigned u = __builtin_bit_cast(unsigned, f); return (u + 0x7fffu + ((u >> 16) & 1u)) >> 16; }
__device__ __forceinline__ unsigned pk2(float lo, float hi) { return f2bf(lo) | (f2bf(hi) << 16); }
__device__ __forceinline__ float bf2f(unsigned short b) { return __builtin_bit_cast(float, (unsigned)b << 16); }
__device__ __forceinline__ float bflo(unsigned w) { return __builtin_bit_cast(float, w << 16); }
__device__ __forceinline__ float bfhi(unsigned w) { return __builtin_bit_cast(float, w & 0xffff0000u); }
__device__ __forceinline__ float fsigmoid(float x) { return __builtin_amdgcn_rcpf(1.0f + __expf(-x)); }
__device__ __forceinline__ float wave_sum(float v) {
#pragma unroll
    for (int o = 1; o < 64; o <<= 1) v += __shfl_xor(v, o);
    return v;
}
__device__ __forceinline__ int modrow_of(int row) { return row < ML ? (row >> 11) : 16; }
#define XB_TMO      128
#define XB_XCNT(j)  (256  + 64 * (j))
#define XB_XSUB(j)  (1280 + 64 * (j))
#define XB_XGEN(j)  (2304 + 64 * (j))
#define XB_TOP      3328
#define XB_TOPGEN   3392
#define XCD_BAR_WORDS 3456
#define XB_SPIN_CAP (1u << 18)

__device__ __forceinline__ unsigned xb_ld(unsigned* p)              { return __hip_atomic_load(p, __ATOMIC_RELAXED, __HIP_MEMORY_SCOPE_AGENT); }
__device__ __forceinline__ unsigned xb_add(unsigned* p, unsigned v) { return __hip_atomic_fetch_add(p, v, __ATOMIC_RELAXED, __HIP_MEMORY_SCOPE_AGENT); }
__device__ __forceinline__ unsigned xb_xcc_id() { return (unsigned)__builtin_amdgcn_s_getreg((3 << 11) | 20) & 0xFu; }
#define XB_SPIN(cond, bar) do { unsigned _sp = 0; while (cond) { __builtin_amdgcn_s_sleep(1); \
    if ((++_sp & 255u) == 0u) { if (xb_ld(&(bar)[XB_TMO])) break; if (_sp > XB_SPIN_CAP) { atomicAdd(&(bar)[XB_TMO], 1u); break; } } } } while (0)

struct XcdBarrier {
    unsigned* bar; unsigned x;
    volatile LAS unsigned* st;
};

__device__ __forceinline__ XcdBarrier xcd_barrier_post(unsigned* bar, volatile LAS unsigned* st) {
    XcdBarrier b; b.bar = bar; b.x = xb_xcc_id(); b.st = st;
    if (threadIdx.x == 0) (void)xb_add(&bar[XB_XCNT(b.x)], 1u);
    return b;
}
__device__ __forceinline__ void xcd_barrier_complete(unsigned* bar, unsigned x, unsigned& nloc, unsigned& nx) {
    const unsigned G = gridDim.x * gridDim.y * gridDim.z;
    unsigned sum, cnt, mine, sp = 0u;
    for (;;) {
        sum = 0u; cnt = 0u; mine = 0u;
#pragma unroll
        for (unsigned j = 0; j < 16; ++j) { const unsigned c = xb_ld(&bar[XB_XCNT(j)]); sum += c; cnt += (c > 0u) ? 1u : 0u; mine = (j == x) ? c : mine; }
        if (sum == G) break;
        __builtin_amdgcn_s_sleep(1);
        if ((++sp & 255u) == 0u) { if (xb_ld(&bar[XB_TMO])) break; if (sp > XB_SPIN_CAP) { atomicAdd(&bar[XB_TMO], 1u); break; } }
    }
    nloc = mine > 0u ? mine : 1u; nx = cnt > 0u ? cnt : 1u;
}

__device__ __forceinline__ void xcd_barrier(const XcdBarrier& b) {
    asm volatile("s_waitcnt vmcnt(0)" ::: "memory");
    __syncthreads();
    if (threadIdx.x == 0) {
        unsigned* bar = b.bar;
        __builtin_amdgcn_s_waitcnt(0);
        unsigned nloc = b.st[0], nx = b.st[1];
        if (nloc == 0u) { xcd_barrier_complete(bar, b.x, nloc, nx); b.st[0] = nloc; b.st[1] = nx; }
        const unsigned old = xb_add(&bar[XB_XSUB(b.x)], 1u);
        const unsigned gen = old / nloc;
        if (old + 1u == (gen + 1u) * nloc) {
            __builtin_amdgcn_fence(__ATOMIC_RELEASE, "agent");
            asm volatile("s_waitcnt vmcnt(0)" ::: "memory");
            const unsigned og = xb_add(&bar[XB_TOP], 1u);
            const unsigned tg = og / nx;
            if (og + 1u == (tg + 1u) * nx) xb_add(&bar[XB_TOPGEN], 1u);
            else XB_SPIN(xb_ld(&bar[XB_TOPGEN]) == tg, bar);
            __builtin_amdgcn_fence(__ATOMIC_ACQUIRE, "agent");
            xb_add(&bar[XB_XGEN(b.x)], 1u);
            asm volatile("s_waitcnt vmcnt(0)" ::: "memory");
        } else {
            XB_SPIN(xb_ld(&bar[XB_XGEN(b.x)]) == gen, bar);
            __builtin_amdgcn_fence(__ATOMIC_ACQUIRE, "agent");
            asm volatile("s_waitcnt vmcnt(0)" ::: "memory");
        }
    }
    __syncthreads();
}

struct Args { const float* in[23]; float* out; unsigned char* ws; int ph_lo, ph_hi; };
enum { I_X = 0, I_C, I_CTX, I_CCTX, I_WMOD, I_BMOD, I_N1G, I_WIN, I_BIN, I_MG, I_SLG, I_SLB, I_SW, I_SB, I_CW, I_CB, I_CLG, I_CLB, I_WOUT, I_N2G, I_WGU, I_WDOWN, I_FG };

__device__ __forceinline__ int win_src_col(int n) {
    if (n < 2048) return n;
    if (n < 2560) return n + 16;
    if (n < 3072) { const int j = n - 2560, tile = j >> 8, jj = j & 255; return 2576 + (jj >> 7) * 256 + tile * 128 + (jj & 127); }
    if (n < 3088) return 2048 + (n - 3072);
    return -1;
}
__device__ __forceinline__ int wgu_src_col(int n) { const int tile = n >> 8, jj = n & 255; return (jj >> 7) * FF + tile * 128 + (jj & 127); }

__device__ __forceinline__ void transpose_item(const float* W, int K, int Nsrc, bf16* WT, int n0, int srcc0, int nvalid, int k0, LAS float* scr, int lane) {
    const int c4 = (lane & 7) * 4, r8 = lane >> 3;
    f32x4 v[8];
#pragma unroll
    for (int i = 0; i < 8; ++i) { v[i] = (f32x4){0.f, 0.f, 0.f, 0.f}; if (srcc0 >= 0 && c4 < nvalid) v[i] = *(const f32x4*)(W + (size_t)(k0 + 8 * i + r8) * Nsrc + srcc0 + c4); }
#pragma unroll
    for (int i = 0; i < 8; ++i) { LAS float* d = scr + (8 * i + r8) * 33 + c4; d[0] = v[i].x; d[1] = v[i].y; d[2] = v[i].z; d[3] = v[i].w; }
    LDS_WAIT(); asm volatile("" ::: "memory");
    const int c8 = lane & 7;
#pragma unroll
    for (int j = 0; j < 4; ++j) { const int n = (lane >> 3) + 8 * j; const LAS float* s = scr + (8 * c8) * 33 + n;
        v4u o; o.x = pk2(s[0 * 33], s[1 * 33]); o.y = pk2(s[2 * 33], s[3 * 33]); o.z = pk2(s[4 * 33], s[5 * 33]); o.w = pk2(s[6 * 33], s[7 * 33]);
        *(v4u*)(WT + (size_t)(n0 + n) * K + k0 + 8 * c8) = o; }
    LDS_WAIT(); asm volatile("" ::: "memory");
}

__device__ __forceinline__ void gemv17_cols(const LAS float* SL, LAS float* RED, const float* W, int N, int j0, int tid) {
    const int lane = tid & 63, wave = __builtin_amdgcn_readfirstlane(tid >> 6);
    const int j = j0 + lane; const bool ok = j < N;
    float acc[17];
#pragma unroll
    for (int r = 0; r < 17; ++r) acc[r] = 0.f;
    const float* wp = W + (size_t)(wave * 128) * N + (ok ? j : 0);
    const LAS float* sp = SL + wave * 128 * 20;
#pragma unroll 1
    for (int k0 = 0; k0 < 128; k0 += 16) {
    float wv[16];
#pragma unroll
    for (int kk = 0; kk < 16; ++kk) wv[kk] = ok ? wp[(size_t)(k0 + kk) * N] : 0.f;
#pragma unroll
    for (int kk = 0; kk < 16; ++kk) { const int k = k0 + kk; const float w = wv[kk];
        const LAS f32x4* s4 = (const LAS f32x4*)(sp + k * 20);
        const f32x4 a = s4[0], b = s4[1], c = s4[2], d = s4[3]; const float e = sp[k * 20 + 16];
        acc[0] += a.x * w; acc[1] += a.y * w; acc[2] += a.z * w; acc[3] += a.w * w; acc[4] += b.x * w; acc[5] += b.y * w; acc[6] += b.z * w; acc[7] += b.w * w;
        acc[8] += c.x * w; acc[9] += c.y * w; acc[10] += c.z * w; acc[11] += c.w * w; acc[12] += d.x * w; acc[13] += d.y * w; acc[14] += d.z * w; acc[15] += d.w * w; acc[16] += e * w; }
    }
#pragma unroll
    for (int r = 0; r < 17; ++r) RED[(wave * 17 + r) * 64 + lane] = acc[r];
}
__device__ __forceinline__ float gemv17_sum(const LAS float* RED, int e) {
    float s = 0.f;
#pragma unroll
    for (int w = 0; w < 8; ++w) s += RED[w * 17 * 64 + e];
    return s;
}

__device__ __forceinline__ void phase_prologue(const Args& a, LAS unsigned char* lds, int G, int tid, int lane, int wave) {
    unsigned char* ws = a.ws;
    LAS float* scr = (LAS float*)(lds + wave * 16384);
    const int gw = blockIdx.x * NWAVES + wave, NGW = G * NWAVES;
    constexpr int I_IN = 16 * (NIN / 32), I_OUT = 16 * 32, I_GU = 16 * (NGU / 32), I_DN = (FF / 64) * 32, I_LAYER = I_IN + I_OUT + I_GU + I_DN;
    for (int it = gw; it < 2 * I_LAYER; it += NGW) {
        const int l = it / I_LAYER; int r = it % I_LAYER;
        unsigned char* wl = ws + WS_W + (size_t)l * W_LAYER;
        if (r < I_IN) { const int kb = r / (NIN / 32), nb = r % (NIN / 32), n0 = nb * 32, sc = win_src_col(n0);
            transpose_item(a.in[I_WIN] + (size_t)l * D * NIN_O, D, NIN_O, (bf16*)(wl + WO_IN), n0, sc, n0 == 3072 ? 16 : 32, kb * 64, scr, lane); continue; }
        r -= I_IN;
        if (r < I_OUT) { const int kb = r / 32, nb = r % 32;
            transpose_item(a.in[I_WOUT] + (size_t)l * D * D, D, D, (bf16*)(wl + WO_OUT), nb * 32, nb * 32, 32, kb * 64, scr, lane); continue; }
        r -= I_OUT;
        if (r < I_GU) { const int kb = r / (NGU / 32), nb = r % (NGU / 32), n0 = nb * 32;
            transpose_item(a.in[I_WGU] + (size_t)l * D * NGU, D, NGU, (bf16*)(wl + WO_GU), n0, wgu_src_col(n0), 32, kb * 64, scr, lane); continue; }
        r -= I_GU;
        { const int kb = r / 32, nb = r % 32;
            transpose_item(a.in[I_WDOWN] + (size_t)l * FF * D, FF, D, (bf16*)(wl + WO_DOWN), nb * 32, nb * 32, 32, kb * 64, scr, lane); }
    }
    for (int e = blockIdx.x * NTHREADS + tid; e < 2 * NIN; e += G * NTHREADS) { const int l = e / NIN, n = e % NIN, s = win_src_col(n);
        ((float*)(ws + WS_BIN))[e] = s >= 0 ? a.in[I_BIN][l * NIN_O + s] : 0.f; }
    for (int e = blockIdx.x * NTHREADS + tid; e < 2 * 4 * 128 * 128; e += G * NTHREADS) ((bf16*)(ws + WS_SWB))[e] = (bf16)f2bf(a.in[I_SW][e]);
    __syncthreads();
    LAS float* SL = (LAS float*)lds; LAS float* RED = SL + 1024 * 20;
    float* MOD = (float*)(ws + WS_MOD);
    bool filled = false;
    for (int it = blockIdx.x; it < 2 * 96; it += G) {
        const int l = it / 96, j0 = (it % 96) * 64;
        if (!filled) { for (int e = tid; e < 17 * 1024; e += NTHREADS) { const int r = e >> 10, k = e & 1023; const float cv = r < 16 ? a.in[I_C][r * D + k] : a.in[I_CCTX][k]; SL[k * 20 + r] = cv * fsigmoid(cv); } filled = true; }
        __syncthreads();
        gemv17_cols(SL, RED, a.in[I_WMOD] + (size_t)l * D * MODW, MODW, j0, tid);
        __syncthreads();
        for (int e = tid; e < 17 * 64; e += NTHREADS) { const int r = e >> 6, j = j0 + (e & 63); MOD[(size_t)(l * 17 + r) * MODW + j] = gemv17_sum(RED, e) + a.in[I_BMOD][l * MODW + j]; }
    }
    __syncthreads();
}

__device__ __forceinline__ int wgu_dst_col(int c) { const int half = c >= FF ? 1 : 0, cc = c - half * FF; return (cc >> 7) * 256 + half * 128 + (cc & 127); }
__device__ __forceinline__ int win_dst_col(int c) {
    if (c < 2048) return c;
    if (c < 2064) return 3072 + (c - 2048);
    if (c < 2576) return c - 16;
    const int cc = c - 2576, half = cc >> 8, w = cc & 255; return 2560 + (w >> 7) * 256 + half * 128 + (w & 127);
}
__device__ __forceinline__ void phase_shifts(const Args& a, LAS unsigned char* lds, int G, int tid) {
    unsigned char* ws = a.ws; const float* MOD = (const float*)(ws + WS_MOD);
    for (int e = blockIdx.x * NTHREADS + tid; e < 2 * 2 * 17 * 1024; e += G * NTHREADS) { const int l = e / (2 * 17 * 1024), w = (e / (17 * 1024)) & 1, r = (e >> 10) % 17, c = e & 1023;
        ((float*)(ws + WS_GS))[e] = (w ? a.in[I_N2G] : a.in[I_N1G])[l * D + c] * (1.0f + MOD[(size_t)(l * 17 + r) * MODW + (w ? 4 : 1) * D + c]); }
    LAS float* SL = (LAS float*)lds; LAS float* RED = SL + 1024 * 20;
    for (int it = blockIdx.x; it < 176 + 49; it += G) {
        const bool gu = it < 176; const int l = gu ? it / 88 : 1, j0 = gu ? (it % 88) * 64 : (it - 176) * 64;
        const int shoff = gu ? 3 * D : 0, Nsrc = gu ? NGU : NIN_O;
        __syncthreads();
        for (int e = tid; e < 17 * 1024; e += NTHREADS) { const int r = e >> 10, k = e & 1023; SL[k * 20 + r] = MOD[(size_t)(l * 17 + r) * MODW + shoff + k]; }
        __syncthreads();
        gemv17_cols(SL, RED, gu ? a.in[I_WGU] + (size_t)l * D * NGU : a.in[I_WIN] + (size_t)D * NIN_O, Nsrc, j0, tid);
        __syncthreads();
        for (int e = tid; e < 17 * 64; e += NTHREADS) { const int r = e >> 6, j = j0 + (e & 63);
            if (j < Nsrc) { const float v = gemv17_sum(RED, e);
                if (gu) ((float*)(ws + WS_SHGU))[(size_t)(l * 17 + r) * NGU + wgu_dst_col(j)] = v;
                else ((float*)(ws + WS_SHIN))[(size_t)r * NIN + win_dst_col(j)] = v + a.in[I_BIN][NIN_O + j]; } }
    }
    __syncthreads();
}

__device__ __forceinline__ void phase_norm(const float* xl, const float* xc, bf16* A, const float* g, const float* mod, int sh_off, int nrows, int G, int lane, int wave) {
    const int gw = blockIdx.x * NWAVES + wave, NGW = G * NWAVES;
    for (int r = gw; r < nrows; r += NGW) {
        const float* xr = r < ML ? xl + (size_t)r * D : xc + (size_t)(r - ML) * D;
        const float* mr = mod + (size_t)modrow_of(r) * MODW + sh_off;
        f32x4 v[4]; float s = 0.f;
#pragma unroll
        for (int j = 0; j < 4; ++j) { v[j] = ((const f32x4*)xr)[lane + 64 * j]; s += (v[j].x * v[j].x + v[j].y * v[j].y) + (v[j].z * v[j].z + v[j].w * v[j].w); }
        const float rstd = 1.0f / sqrtf(wave_sum(s) * (1.0f / D) + EPS);
        unsigned long long* o8 = (unsigned long long*)(A + (size_t)r * D) + lane;
#pragma unroll
        for (int j = 0; j < 4; ++j) { const int c = (lane + 64 * j) * 4;
            const f32x4 gg = *(const f32x4*)(g + c), sh = *(const f32x4*)(mr + c), sc = *(const f32x4*)(mr + D + c);
            const f32x4 y = v[j] * rstd * gg * (1.0f + sc) + sh;
            o8[64 * j] = (unsigned long long)pk2(y.x, y.y) | ((unsigned long long)pk2(y.z, y.w) << 32); }
    }
}

__device__ __forceinline__ void phase_final(float* x, const float* g, int G, int lane, int wave) {
    const int gw = blockIdx.x * NWAVES + wave, NGW = G * NWAVES;
    for (int r = gw; r < ML; r += NGW) {
        float* xr = x + (size_t)r * D;
        f32x4 v[4]; float s = 0.f;
#pragma unroll
        for (int j = 0; j < 4; ++j) { v[j] = ((const f32x4*)xr)[lane + 64 * j]; s += (v[j].x * v[j].x + v[j].y * v[j].y) + (v[j].z * v[j].z + v[j].w * v[j].w); }
        const float rstd = 1.0f / sqrtf(wave_sum(s) * (1.0f / D) + EPS);
#pragma unroll
        for (int j = 0; j < 4; ++j) { const f32x4 gg = ((const f32x4*)g)[lane + 64 * j]; ((f32x4*)xr)[lane + 64 * j] = v[j] * rstd * gg; }
    }
}

constexpr int TB = 16;
__device__ __forceinline__ void mlstm_scan_item(const bf16* Q, const bf16* K, const bf16* V, const float* GT, float* HS0, float* HS1, int item, bool ctx_out, LAS unsigned char* lds, int tid) {
    const int b = item >> 3, h = (item >> 1) & 3, dir = item & 1;
    const int dv = tid & 127, kq = tid >> 7;
    LAS float* kbuf = (LAS float*)lds;
    LAS float* vbuf = kbuf + TB * 128;
    LAS float* qbuf = vbuf + TB * 128;
    LAS float* ibuf = qbuf + TB * 128;
    LAS float* fbuf = ibuf + TB;
    LAS float* red = fbuf + TB;
    LAS float* redd = red + 2 * 4 * 128;
    float* HS = dir ? HS1 : HS0;
    float C[32], nn[32];
#pragma unroll
    for (int j = 0; j < 32; ++j) { C[j] = 0.f; nn[j] = 0.f; }
    float m = 0.f; int par = 0;
    for (int s0 = 0; s0 < CTXL + SEQ; s0 += TB) {
        const bool isctx = s0 < CTXL; const int len = isctx ? CTXL : SEQ, i0 = isctx ? s0 : s0 - CTXL;
        const int rbase = isctx ? ML + b * CTXL : b * SEQ;
        for (int e = tid; e < TB * 384; e += NTHREADS) { const int tok = e / 384, c = e % 384, which = c >> 7, d = c & 127;
            const int t = dir ? (len - 1 - (i0 + tok)) : (i0 + tok); const size_t off = (size_t)(rbase + t) * HW + h * 128 + d;
            const bf16* src = which == 0 ? K : which == 1 ? V : Q;
            (which == 0 ? kbuf : which == 1 ? vbuf : qbuf)[tok * 128 + d] = bf2f(src[off]); }
        if (tid < TB) { const int t = dir ? (len - 1 - (i0 + tid)) : (i0 + tid); const float* gp = GT + (size_t)(rbase + t) * 16 + dir * 8 + h;
            const float iv = gp[0], fv = gp[4];
            ibuf[tid] = iv; fbuf[tid] = fminf(fv, 0.f) - log1pf(__expf(-fabsf(fv))); }
        __syncthreads();
        const bool wr_out = !isctx || ctx_out;
        for (int tok = 0; tok < TB; ++tok) {
            const float it = ibuf[tok], lf = fbuf[tok];
            const float mn = fmaxf(lf + m, it), aa = __expf(lf + m - mn), bc = __expf(it - mn); m = mn;
            const float vv = vbuf[tok * 128 + dv] * bc;
            float part = 0.f, dpart = 0.f;
            const LAS float* kp = kbuf + tok * 128 + kq * 32; const LAS float* qp = qbuf + tok * 128 + kq * 32;
#pragma unroll
            for (int j = 0; j < 32; ++j) { const float kk = kp[j], qq = qp[j];
                C[j] = aa * C[j] + kk * vv; part += C[j] * qq;
                nn[j] = aa * nn[j] + bc * kk; dpart += nn[j] * qq; }
            red[(par * 4 + kq) * 128 + dv] = part; if (dv == 0) redd[par * 4 + kq] = dpart;
            __syncthreads();
            if (tid < 128 && wr_out) {
                const float num = (red[(par * 4 + 0) * 128 + tid] + red[(par * 4 + 1) * 128 + tid]) + (red[(par * 4 + 2) * 128 + tid] + red[(par * 4 + 3) * 128 + tid]);
                const float den = (redd[par * 4 + 0] + redd[par * 4 + 1]) + (redd[par * 4 + 2] + redd[par * 4 + 3]);
                const int t = dir ? (len - 1 - (i0 + tok)) : (i0 + tok);
                HS[(size_t)(rbase + t) * HW + h * 128 + tid] = num / fmaxf(fabsf(den), __expf(-m));
            }
            par ^= 1;
        }
    }
    __syncthreads();
}

__device__ __forceinline__ void phase_mlstm_post(const float* HS0, const float* HS1, const bf16* OG, const float* mg, bf16* Y, int nrows, int G, int lane, int wave) {
    const int gw = blockIdx.x * NWAVES + wave, NGW = G * NWAVES;
    for (int r = gw; r < nrows; r += NGW) {
        const size_t off = (size_t)r * HW + lane * 8;
        const f32x4 a0 = *(const f32x4*)(HS0 + off), a1 = *(const f32x4*)(HS0 + off + 4), b0 = *(const f32x4*)(HS1 + off), b1 = *(const f32x4*)(HS1 + off + 4);
        const f32x4 h0 = a0 + b0, h1 = a1 + b1;
        float s = (h0.x * h0.x + h0.y * h0.y) + (h0.z * h0.z + h0.w * h0.w) + (h1.x * h1.x + h1.y * h1.y) + (h1.z * h1.z + h1.w * h1.w);
        s += __shfl_xor(s, 1); s += __shfl_xor(s, 2); s += __shfl_xor(s, 4); s += __shfl_xor(s, 8);
        const float rs = 1.0f / sqrtf(s * (1.0f / 128.0f) + EPS);
        const v4u og = *(const v4u*)(OG + off);
        const f32x4 g0 = *(const f32x4*)(mg + lane * 8), g1 = *(const f32x4*)(mg + lane * 8 + 4);
        v4u o;
        o.x = pk2(h0.x * rs * g0.x * bflo(og.x), h0.y * rs * g0.y * bfhi(og.x)); o.y = pk2(h0.z * rs * g0.z * bflo(og.y), h0.w * rs * g0.w * bfhi(og.y));
        o.z = pk2(h1.x * rs * g1.x * bflo(og.z), h1.y * rs * g1.y * bfhi(og.z)); o.w = pk2(h1.z * rs * g1.z * bflo(og.w), h1.w * rs * g1.w * bfhi(og.w));
        *(v4u*)(Y + (size_t)r * D + lane * 8) = o;
    }
}

__device__ __forceinline__ void sgu_item(const bf16* Z, const float* lg, const float* lb, const float* sw, const float* sb, bf16* Y, int chunk, LAS unsigned char* lds, int tid, int lane, int wave) {
    LAS float* vn = (LAS float*)lds;
    const int row0 = chunk * 128;
    for (int t = wave; t < 128; t += NWAVES) {
        const v2u raw = *(const v2u*)(Z + (size_t)(row0 + t) * 512 + 256 + lane * 4);
        const float x0 = bflo(raw.x), x1 = bfhi(raw.x), x2 = bflo(raw.y), x3 = bfhi(raw.y);
        const float mu = wave_sum((x0 + x1) + (x2 + x3)) * (1.0f / 256.0f);
        const float d0 = x0 - mu, d1 = x1 - mu, d2 = x2 - mu, d3 = x3 - mu;
        const float var = wave_sum((d0 * d0 + d1 * d1) + (d2 * d2 + d3 * d3)) * (1.0f / 256.0f);
        const float rs = 1.0f / sqrtf(var + EPS);
        const f32x4 g = *(const f32x4*)(lg + lane * 4), bb = *(const f32x4*)(lb + lane * 4);
        *(LAS f32x4*)(vn + t * 256 + lane * 4) = (f32x4){d0 * rs * g.x + bb.x, d1 * rs * g.y + bb.y, d2 * rs * g.z + bb.z, d3 * rs * g.w + bb.w};
    }
    __syncthreads();
    const int ch = tid & 255, ph = tid >> 8, g = __builtin_amdgcn_readfirstlane(ch >> 6);
    const float* wg = sw + (size_t)g * 128 * 128; const float* bg = sb + g * 128;
    for (int p = ph * 64; p < ph * 64 + 64; ++p) {
        const float* wr = wg + p * 128; float acc = 0.f;
#pragma unroll 8
        for (int q = 0; q < 128; ++q) acc += wr[q] * vn[q * 256 + ch];
        const float u = bf2f(Z[(size_t)(row0 + p) * 512 + ch]);
        Y[(size_t)(row0 + p) * D + 512 + ch] = (bf16)f2bf(u * (acc + bg[p]));
    }
    __syncthreads();
}

__device__ __forceinline__ void conv_rows(const bf16* YC, const float* cw, const float* cb, const float* lg, const float* lb, bf16* Y, int row0, int nrows, int lane, int wave) {
    const int c0 = lane * 4;
    for (int rr = wave; rr < nrows; rr += NWAVES) {
        const int r = row0 + rr;
        f32x4 acc = *(const f32x4*)(cb + c0);
        int base, pos, len, stride;
        if (r < ML) { const int b = r >> 11, t = r & 2047;
            if (lane < 32) { base = (b << 11) + (t & ~63); pos = t & 63; len = 64; stride = 1; }
            else           { base = (b << 11) + (t & 63); pos = t >> 6; len = 32; stride = 64; } }
        else { const int rc = r - ML; base = ML + (rc & ~255); pos = rc & 255; len = 256; stride = 1; }
#pragma unroll 1
        for (int k = 0; k < 31; ++k) { const int p = pos + k - 15;
            if (p >= 0 && p < len) { const v2u raw = *(const v2u*)(YC + (size_t)(base + p * stride) * 256 + c0); const f32x4 w = *(const f32x4*)(cw + k * 256 + c0);
                acc.x += w.x * bflo(raw.x); acc.y += w.y * bfhi(raw.x); acc.z += w.z * bflo(raw.y); acc.w += w.w * bfhi(raw.y); } }
        const float mu = wave_sum((acc.x + acc.y) + (acc.z + acc.w)) * (1.0f / 256.0f);
        const float d0 = acc.x - mu, d1 = acc.y - mu, d2 = acc.z - mu, d3 = acc.w - mu;
        const float var = wave_sum((d0 * d0 + d1 * d1) + (d2 * d2 + d3 * d3)) * (1.0f / 256.0f);
        const float rs = 1.0f / sqrtf(var + EPS);
        const f32x4 g = *(const f32x4*)(lg + c0), bb = *(const f32x4*)(lb + c0);
        float y0 = d0 * rs * g.x + bb.x, y1 = d1 * rs * g.y + bb.y, y2 = d2 * rs * g.z + bb.z, y3 = d3 * rs * g.w + bb.w;
        y0 *= fsigmoid(y0); y1 *= fsigmoid(y1); y2 *= fsigmoid(y2); y3 *= fsigmoid(y3);
        v2u o; o.x = pk2(y0, y1); o.y = pk2(y2, y3);
        *(v2u*)(Y + (size_t)r * D + 768 + c0) = o;
    }
}
typedef short bf16x8_t __attribute__((ext_vector_type(8)));
typedef short s16x4_t __attribute__((ext_vector_type(4)));
typedef short v4i16_t __attribute__((ext_vector_type(4)));
typedef float f32x16 __attribute__((ext_vector_type(16)));
typedef __bf16 bf16x2_t __attribute__((ext_vector_type(2)));
__device__ __forceinline__ unsigned cvtpk(float lo, float hi) { f32x2 v = {lo, hi}; bf16x2_t b = __builtin_convertvector(v, bf16x2_t); return __builtin_bit_cast(unsigned, b); }
__device__ __forceinline__ s16x4_t tr16(const LAS unsigned char* p) { return __builtin_bit_cast(s16x4_t, __builtin_amdgcn_ds_read_tr16_b64_v4i16((LAS v4i16_t*)p)); }
__device__ __forceinline__ bf16x8_t cat8(s16x4_t lo, s16x4_t hi) { return __builtin_shufflevector(lo, hi, 0, 1, 2, 3, 4, 5, 6, 7); }
#define MFMA32(a, b, c) __builtin_amdgcn_mfma_f32_32x32x16_bf16((a), (b), (c), 0, 0, 0)
__device__ __forceinline__ int crow(int reg, int hh) { return (reg & 3) + 8 * (reg >> 2) + 4 * hh; }
__device__ __forceinline__ int chunk_row0(int b, int a) { return a < 2 ? ML + b * CTXL + a * 128 : b * SEQ + (a - 2) * 128; }
__device__ __forceinline__ int chunk_of_step(int j, int dir) { return dir == 0 ? j : (j == 0 ? 1 : (j == 1 ? 0 : 19 - j)); }
__device__ __forceinline__ float log_sigmoid(float x) { return fminf(x, 0.f) - log1pf(__expf(-fabsf(x))); }
__device__ __forceinline__ float lane_get(float x, int src_lane) { return __builtin_bit_cast(float, __builtin_amdgcn_ds_bpermute(src_lane << 2, __builtin_bit_cast(int, x))); }
__device__ __forceinline__ float wave_incl_add(float x, int lane) {
#pragma unroll
    for (int o = 1; o < 64; o <<= 1) { const float y = lane_get(x, lane - o); if (lane >= o) x += y; }
    return x;
}
__device__ __forceinline__ float wave_incl_max(float x, int lane) {
#pragma unroll
    for (int o = 1; o < 64; o <<= 1) { const float y = lane_get(x, lane - o); if (lane >= o) x = fmaxf(x, y); }
    return x;
}
__device__ __forceinline__ float wave_max(float v, int lane) {
#pragma unroll
    for (int o = 1; o < 64; o <<= 1) v = fmaxf(v, lane_get(v, lane ^ o));
    return v;
}
__device__ __forceinline__ v4u scale8(const v4u& w, float s) {
    v4u o; o.x = cvtpk(bflo(w.x) * s, bfhi(w.x) * s); o.y = cvtpk(bflo(w.y) * s, bfhi(w.y) * s); o.z = cvtpk(bflo(w.z) * s, bfhi(w.z) * s); o.w = cvtpk(bflo(w.w) * s, bfhi(w.w) * s); return o;
}
constexpr int MX_OFF = RING_BYTES + 1024;

#define dpp_f(x, ctrl) __builtin_bit_cast(float, __builtin_amdgcn_update_dpp(0, __builtin_bit_cast(int, (float)(x)), (ctrl), 0xf, 0xf, false))
#define ROW_SUM16(x) do { x += dpp_f(x, 0x121); x += dpp_f(x, 0x122); x += dpp_f(x, 0x124); x += dpp_f(x, 0x128); } while (0)
__device__ __forceinline__ int swz_off(int row, int chunk) { return row * 256 + 16 * (chunk ^ (((row & 3) << 2) | ((row >> 2) & 3))); }

#define LDS_BARRIER() do { asm volatile("s_waitcnt lgkmcnt(0)" ::: "memory"); __builtin_amdgcn_s_barrier(); asm volatile("" ::: "memory"); } while (0)
#define ST_LOAD(kr, vr, jj) do { const int row0_ = chunk_row0(b, chunk_of_step((jj), dir)); \
        _Pragma("unroll") for (int i = 0; i < 4; ++i) { const int pc = tid + NTHREADS * i; kr[i] = *(const v4u*)(K + (size_t)(row0_ + (pc >> 4)) * HW + h * 128 + (pc & 15) * 8); } \
        _Pragma("unroll") for (int i = 0; i < 2; ++i) { const int pc = tid + NTHREADS * i; vr[i] = *(const v4u*)(V + (size_t)(row0_ + (pc >> 3)) * HW + h * 128 + dvh * 64 + (pc & 7) * 8); } } while (0)
#define ST_WRITE(kr, vr, jj) do { LAS unsigned char* Kn = Kimg + ((jj) & 1) * 32768; LAS unsigned char* Vn = Vimg + ((jj) & 1) * 16384; \
        _Pragma("unroll") for (int i = 0; i < 4; ++i) { const int pc = tid + NTHREADS * i; *(LAS v4u*)(Kn + pc * 16) = kr[i]; } \
        _Pragma("unroll") for (int i = 0; i < 2; ++i) { const int pc = tid + NTHREADS * i, s_ = pc >> 3; *(LAS v4u*)(Vn + pc * 16) = scale8(vr[i], kpn[(jj) * 128 + s_]); } } while (0)
#define ST_STEP(j, krL, vrL, krW, vrW) do { \
        LDS_BARRIER(); \
        const int a = chunk_of_step((j), dir); \
        if ((j) + 2 < 18) ST_LOAD(krL, vrL, (j) + 2); \
        if (a >= 2 || store_ctx) { \
            bf16* cp = CT + ((size_t)(seq * 18 + a) * 128 + dvh * 64 + dvt * 32 + r) * 128 + dkt * 32 + 4 * hh; \
            _Pragma("unroll") for (int g = 0; g < 4; ++g) { v2u o; o.x = cvtpk(acc[4 * g], acc[4 * g + 1]); o.y = cvtpk(acc[4 * g + 2], acc[4 * g + 3]); *(v2u*)(cp + 8 * g) = o; } \
            if (dvh == 0 && dvt == 0) NS[(size_t)(seq * 18 + a) * 256 + hh * 128 + dkt * 32 + r] = nn; } \
        const float delta = cs[64 + (j)]; \
        _Pragma("unroll") for (int i = 0; i < 16; ++i) acc[i] *= delta; \
        const LAS unsigned char* Kb = Kimg + ((j) & 1) * 32768; const LAS unsigned char* Vb = Vimg + ((j) & 1) * 16384; \
        bf16x8_t Af[8], Bf[8]; \
        _Pragma("unroll") for (int ks = 0; ks < 8; ++ks) { \
            const LAS unsigned char* ka = Kb + (16 * ks + 8 * hh + q) * 256 + 2 * (32 * dkt + 16 * blk + 4 * p); \
            const LAS unsigned char* va = Vb + (16 * ks + 8 * hh + q) * 128 + 2 * (32 * dvt + 16 * blk + 4 * p); \
            Af[ks] = cat8(tr16(ka), tr16(ka + 4 * 256)); Bf[ks] = cat8(tr16(va), tr16(va + 4 * 128)); } \
        f32x16 acc2; _Pragma("unroll") for (int i = 0; i < 16; ++i) acc2[i] = 0.f; \
        _Pragma("unroll") for (int ks = 0; ks < 8; ks += 2) { acc = MFMA32(Af[ks], Bf[ks], acc); acc2 = MFMA32(Af[ks + 1], Bf[ks + 1], acc2); } \
        if (dvh == 0 && dvt == 0) { float s_ = 0.f;        \
            _Pragma("unroll") for (int ks = 0; ks < 8; ++ks) { const LAS f32x4* kp4 = (const LAS f32x4*)(kpn + (j) * 128 + 16 * ks + 8 * hh); const f32x4 k0 = kp4[0], k1 = kp4[1]; \
                s_ += k0.x * bf2f((unsigned short)Af[ks][0]) + k0.y * bf2f((unsigned short)Af[ks][1]) + k0.z * bf2f((unsigned short)Af[ks][2]) + k0.w * bf2f((unsigned short)Af[ks][3]) \
                    + k1.x * bf2f((unsigned short)Af[ks][4]) + k1.y * bf2f((unsigned short)Af[ks][5]) + k1.z * bf2f((unsigned short)Af[ks][6]) + k1.w * bf2f((unsigned short)Af[ks][7]); } \
            nn = delta * nn + s_; } \
        _Pragma("unroll") for (int i = 0; i < 16; ++i) acc[i] += acc2[i]; \
        if ((j) + 1 < 18) ST_WRITE(krW, vrW, (j) + 1); \
    } while (0)
__device__ __forceinline__ void mlstm_state_item(const bf16* K, const bf16* V, const float* GT, bf16* CT, float* NS, float* TAB, int item, bool store_ctx, LAS unsigned char* lds, int tid) {
    asm volatile("" : "+v"(tid));
    const int lane = tid & 63, wave = __builtin_amdgcn_readfirstlane(tid >> 6);
    const int dvh = item & 1, dir = (item >> 1) & 1, h = (item >> 2) & 3, b = item >> 4;
    const int seq = (b * 4 + h) * 2 + dir;
    LAS unsigned char* Kimg = lds;
    LAS unsigned char* Vimg = lds + 65536;
    LAS float* kap = (LAS float*)(lds + 98304);
    LAS float* gb = kap + 2304;
    LAS float* ib = gb + 2304;
    LAS float* cs = ib + 2304;
    for (int e = tid; e < 2304; e += NTHREADS) { const int j = e >> 7, tau = e & 127, a = chunk_of_step(j, dir), t = dir ? 127 - tau : tau;
        const float* gp = GT + (size_t)(chunk_row0(b, a) + t) * 16 + dir * 8 + h; ib[e] = gp[0]; gb[e] = log_sigmoid(gp[4]); }
    __syncthreads();
    for (int j = wave; j < 18; j += NWAVES) {
        const float x0 = gb[j * 128 + 2 * lane], x1 = gb[j * 128 + 2 * lane + 1];
        const float sc = wave_incl_add(x0 + x1, lane);
        const float b0 = sc - x1, b1 = sc, g0 = ib[j * 128 + 2 * lane] - b0, g1 = ib[j * 128 + 2 * lane + 1] - b1;
        const float ip = wave_incl_max(fmaxf(g0, g1), lane);
        float ex = lane_get(ip, lane - 1); if (lane == 0) ex = -INFINITY;
        gb[j * 128 + 2 * lane] = g0; gb[j * 128 + 2 * lane + 1] = g1;
        ib[j * 128 + 2 * lane] = fmaxf(ex, g0); ib[j * 128 + 2 * lane + 1] = ip;
        kap[j * 128 + 2 * lane] = b0; kap[j * 128 + 2 * lane + 1] = b1;
        const float pm = lane_get(ip, 63), bl = lane_get(sc, 63);
        if (lane == 0) { cs[j] = bl; cs[32 + j] = pm; }
    }
    __syncthreads();
    if (tid < 18) { float m = 0.f, mp = 0.f, Ml = 0.f;
        for (int j = 0; j <= tid; ++j) { mp = m; Ml = fmaxf(m, cs[32 + j]); m = cs[j] + Ml; }
        cs[64 + tid] = __expf(mp - Ml); cs[96 + tid] = Ml; cs[128 + tid] = mp; }
    __syncthreads();
    float kv[5];
#pragma unroll
    for (int i = 0; i < 5; ++i) { const int e = tid + NTHREADS * i; kv[i] = 0.f;
        if (e < 2304) { const int j = e >> 7, tau = e & 127;
            const float g = gb[e], pm = ib[e], bb = kap[e], mp = cs[128 + j], M = fmaxf(mp, pm);
            if (dvh == 0) { const int a = chunk_of_step(j, dir), t = dir ? 127 - tau : tau; float* tp = TAB + (size_t)(seq * 18 + a) * 512 + t;
                tp[0] = g; tp[128] = M; tp[256] = __expf(mp - M); tp[384] = __expf(-(bb + M)); }
            kv[i] = __expf(g - cs[96 + j]); } }
    __syncthreads();
    LAS float* kpn = gb;
#pragma unroll
    for (int i = 0; i < 5; ++i) { const int e = tid + NTHREADS * i; if (e < 2304) { const int j = e >> 7, tau = e & 127; kpn[j * 128 + (dir ? 127 - tau : tau)] = kv[i]; } }
    __syncthreads();

    const int r = lane & 31, hh = lane >> 5, i16 = lane & 15, q = i16 >> 2, p = i16 & 3, blk = (lane >> 4) & 1;
    const int dkt = wave & 3, dvt = wave >> 2;
    f32x16 acc;
#pragma unroll
    for (int i = 0; i < 16; ++i) acc[i] = 0.f;
    float nn = 0.f;
    v4u kA[4], vA[2], kB[4], vB[2];
    ST_LOAD(kA, vA, 0); ST_WRITE(kA, vA, 0); ST_LOAD(kB, vB, 1);
#pragma unroll 1
    for (int jj = 0; jj < 18; jj += 2) {
        ST_STEP(jj, kA, vA, kB, vB);
        ST_STEP(jj + 1, kB, vB, kA, vA);
    }
    __syncthreads();
}
#undef ST_LOAD
#undef ST_WRITE
#undef ST_STEP

template <int TB>
__device__ __forceinline__ void mlstm_weights(const f32x16 (&S)[4], bf16x8_t (&pb)[4][2], const LAS float* GA, int t, int hh, int lane, float qnf, float qnb, float& sff, float& sfb) {
    const float Mf = GA[128 + t], Mb = GA[512 + 128 + t];
    float rsf = 0.f, rsb = 0.f;
#pragma unroll
    for (int st = 0; st < 4; ++st) {
#pragma unroll
        for (int g = 0; g < 4; ++g) {
            const int s0 = 32 * st + 8 * g + 4 * hh;
            if (st < TB) { const f32x4 gv = *(const LAS f32x4*)(GA + s0);
#pragma unroll
                for (int e = 0; e < 4; ++e) rsf += S[st][4 * g + e] * __expf(gv[e] - Mf);
            } else if (st > TB) { const f32x4 gv = *(const LAS f32x4*)(GA + 512 + s0);
#pragma unroll
                for (int e = 0; e < 4; ++e) rsb += S[st][4 * g + e] * __expf(gv[e] - Mb);
            } else { const f32x4 gf = *(const LAS f32x4*)(GA + s0), gbv = *(const LAS f32x4*)(GA + 512 + s0);
#pragma unroll
                for (int e = 0; e < 4; ++e) { const float dts = (float)(t - (s0 + e));
                    const float wf = __expf(gf[e] - Mf + fminf(dts, 0.f) * 1e30f), wb = __expf(gbv[e] - Mb - fmaxf(dts, 0.f) * 1e30f);
                    rsf += S[st][4 * g + e] * wf; rsb += S[st][4 * g + e] * wb; }
            }
        }
        __builtin_amdgcn_sched_barrier(0);
    }
    rsf += lane_get(rsf, lane ^ 32); rsb += lane_get(rsb, lane ^ 32);
    const float alf = GA[256 + t], alb = GA[512 + 256 + t];
    const float invf = 1.0f / fmaxf(fabsf(alf * qnf + rsf), GA[384 + t]), invb = 1.0f / fmaxf(fabsf(alb * qnb + rsb), GA[512 + 384 + t]);
    sff = alf * invf; sfb = alb * invb;
    __builtin_amdgcn_sched_barrier(0);
    float Mf2 = Mf, Mb2 = Mb; asm volatile("" : "+v"(Mf2), "+v"(Mb2));
#pragma unroll
    for (int st = 0; st < 4; ++st) {
        float pv[16];
#pragma unroll
        for (int g = 0; g < 4; ++g) {
            const int s0 = 32 * st + 8 * g + 4 * hh;
            if (st < TB) { const f32x4 gv = *(const LAS f32x4*)(GA + s0);
#pragma unroll
                for (int e = 0; e < 4; ++e) pv[4 * g + e] = S[st][4 * g + e] * (__expf(gv[e] - Mf2) * invf);
            } else if (st > TB) { const f32x4 gv = *(const LAS f32x4*)(GA + 512 + s0);
#pragma unroll
                for (int e = 0; e < 4; ++e) pv[4 * g + e] = S[st][4 * g + e] * (__expf(gv[e] - Mb2) * invb);
            } else { const f32x4 gf = *(const LAS f32x4*)(GA + s0), gbv = *(const LAS f32x4*)(GA + 512 + s0);
#pragma unroll
                for (int e = 0; e < 4; ++e) { const float dts = (float)(t - (s0 + e));
                    const float wf = __expf(gf[e] - Mf2 + fminf(dts, 0.f) * 1e30f), wb = __expf(gbv[e] - Mb2 - fmaxf(dts, 0.f) * 1e30f);
                    pv[4 * g + e] = S[st][4 * g + e] * (wf * invf + wb * invb); }
            }
        }
#pragma unroll
        for (int sp = 0; sp < 2; ++sp) { v4u w; w.x = cvtpk(pv[8 * sp], pv[8 * sp + 1]); w.y = cvtpk(pv[8 * sp + 2], pv[8 * sp + 3]); w.z = cvtpk(pv[8 * sp + 4], pv[8 * sp + 5]); w.w = cvtpk(pv[8 * sp + 6], pv[8 * sp + 7]);
            pb[st][sp] = __builtin_bit_cast(bf16x8_t, w); }
        __builtin_amdgcn_sched_barrier(0);
    }
}

__device__ __forceinline__ void mlstm_out_phase(const bf16* Q, const bf16* K, const bf16* V, const bf16* OG, const bf16* CT, const float* NS, const float* TAB,
                                                const float* mg, bf16* Y, int abase, int G, LAS unsigned char* lds, int tid) {
    asm volatile("" : "+v"(tid));
    const int wave = __builtin_amdgcn_readfirstlane(tid >> 6);
    const int na = 18 - abase, nitems = 64 * na;
    int it = blockIdx.x;
    if (it >= nitems) return;
    LAS unsigned char* Kimg = lds; LAS unsigned char* Vimg = lds + 32768; LAS unsigned char* Cf = lds + 65536; LAS unsigned char* Cb = lds + 98304;
    LAS float* GA = (LAS float*)(lds + MX_OFF);
    LAS float* NSL = GA + 1024;
    LAS float* SSQ = NSL + 256;
    const int tb = wave & 3, dh = wave >> 2;
    v4u kr[4], vr[4], tabr; float nsr[4];
#define OUT_PREFETCH(item_) do { const int bh_ = (item_) / na, a_ = abase + (item_) % na, b_ = bh_ >> 2, h_ = bh_ & 3, row0_ = chunk_row0(b_, a_), sq_ = (b_ * 4 + h_) * 2; \
        _Pragma("unroll") for (int i = 0; i < 4; ++i) { const int pc = tid + NTHREADS * i; const size_t go = (size_t)(row0_ + (pc >> 4)) * HW + h_ * 128 + (pc & 15) * 8; kr[i] = *(const v4u*)(K + go); vr[i] = *(const v4u*)(V + go); } \
        if (tid < 256) tabr = *(const v4u*)(TAB + (size_t)((sq_ + (tid >> 7)) * 18 + a_) * 512 + (tid & 127) * 4); \
        else { const int e_ = tid - 256; const float* np_ = NS + (size_t)((sq_ + (e_ >> 7)) * 18 + a_) * 256 + (e_ & 127); nsr[0] = np_[0]; nsr[1] = np_[128]; nsr[2] = 0.f; nsr[3] = 0.f; } } while (0)
    OUT_PREFETCH(it);
#pragma unroll 1
    for (;;) {
        asm volatile("" : "+v"(tid));
        const int lane = tid & 63, r = lane & 31, hh = lane >> 5, i16 = lane & 15, q = i16 >> 2, p = i16 & 3, blk = (lane >> 4) & 1;
        const int t = 32 * tb + r;
        const int bh = it / na, a = abase + it % na, b = bh >> 2, h = bh & 3;
        const int row0 = chunk_row0(b, a), seqf = (b * 4 + h) * 2, seqb = seqf + 1;
#pragma unroll
        for (int i = 0; i < 4; ++i) { const int pc = tid + NTHREADS * i, so = swz_off(pc >> 4, pc & 15); *(LAS v4u*)(Kimg + so) = kr[i]; *(LAS v4u*)(Vimg + so) = vr[i]; }
        if (tid < 256) *(LAS v4u*)(GA + (tid >> 7) * 512 + (tid & 127) * 4) = tabr;
        else NSL[tid - 256] = (nsr[0] + nsr[1]) + (nsr[2] + nsr[3]);
        bf16x8_t qf[8];
#pragma unroll
        for (int ks = 0; ks < 8; ++ks) qf[ks] = *(const bf16x8_t*)(Q + (size_t)(row0 + t) * HW + h * 128 + 16 * ks + 8 * hh);
        __syncthreads();
        f32x16 S[4];
#pragma unroll
        for (int st = 0; st < 4; ++st)
#pragma unroll
            for (int i = 0; i < 16; ++i) S[st][i] = 0.f;
        int la = lane; asm volatile("" : "+v"(la));
        const int ra = la & 31, ha = la >> 5;
#pragma unroll
        for (int ks = 0; ks < 8; ++ks) {
#pragma unroll
            for (int st = 0; st < 4; ++st) { const bf16x8_t A = *(const LAS bf16x8_t*)(Kimg + swz_off(32 * st + ra, 2 * ks + ha)); S[st] = MFMA32(A, qf[ks], S[st]); }
            __builtin_amdgcn_sched_barrier(0); }
        { const unsigned char* cfp = (const unsigned char*)(CT + (size_t)(seqf * 18 + a) * 16384); const unsigned char* cbp = (const unsigned char*)(CT + (size_t)(seqb * 18 + a) * 16384);
#pragma unroll
          for (int i = 0; i < 4; ++i) { const int n = 4 * wave + i, row = 4 * n + (lane >> 4), dc = (lane & 15) ^ (((row & 3) << 2) | ((row >> 2) & 3)); const int go = row * 256 + dc * 16;
              __builtin_amdgcn_global_load_lds((const unsigned*)(cfp + go), (LAS unsigned*)(Cf + n * 1024), 16, 0, 0);
              __builtin_amdgcn_global_load_lds((const unsigned*)(cbp + go), (LAS unsigned*)(Cb + n * 1024), 16, 0, 0); } }
        __builtin_amdgcn_sched_barrier(0);
        float qnf = 0.f, qnb = 0.f;
#pragma unroll
        for (int ks = 0; ks < 8; ++ks)
#pragma unroll
            for (int j = 0; j < 8; ++j) { const float qv = bf2f((unsigned short)qf[ks][j]); const int dk = 16 * ks + 8 * hh + j; qnf += qv * NSL[dk]; qnb += qv * NSL[128 + dk]; }
        qnf += lane_get(qnf, lane ^ 32); qnb += lane_get(qnb, lane ^ 32);
        __builtin_amdgcn_sched_barrier(0);
        bf16x8_t pb[4][2];
        float sff, sfb;
        switch (tb) {
            case 0: mlstm_weights<0>(S, pb, GA, t, hh, lane, qnf, qnb, sff, sfb); break;
            case 1: mlstm_weights<1>(S, pb, GA, t, hh, lane, qnf, qnb, sff, sfb); break;
            case 2: mlstm_weights<2>(S, pb, GA, t, hh, lane, qnf, qnb, sff, sfb); break;
            default: mlstm_weights<3>(S, pb, GA, t, hh, lane, qnf, qnb, sff, sfb); break;
        }
        __builtin_amdgcn_sched_barrier(0);
        const int itn = it + G; const bool more = itn < nitems;
        bf16x8_t qf2[8];
#pragma unroll
        for (int ks = 0; ks < 8; ++ks) qf2[ks] = *(const bf16x8_t*)(Q + (size_t)(row0 + t) * HW + h * 128 + 16 * ks + 8 * hh);
        __syncthreads();
        if (more) OUT_PREFETCH(itn);
        f32x16 Hc[2];
#pragma unroll
        for (int d = 0; d < 2; ++d)
#pragma unroll
            for (int i = 0; i < 16; ++i) Hc[d][i] = 0.f;
        int lb_ = lane; asm volatile("" : "+v"(lb_));
        const int hb = lb_ >> 5, qb = (lb_ & 15) >> 2, pb_ = lb_ & 3, blkb = (lb_ >> 4) & 1;
#pragma unroll
        for (int d = 0; d < 2; ++d) { const int dvt = 2 * dh + d;
#pragma unroll
            for (int st = 0; st < 4; ++st)
#pragma unroll
                for (int sp = 0; sp < 2; ++sp) { const int vrow = 32 * st + 16 * sp + 4 * hb + qb, vch = 4 * dvt + 2 * blkb + (pb_ >> 1);
                    const bf16x8_t A = cat8(tr16(Vimg + swz_off(vrow, vch) + 8 * (pb_ & 1)), tr16(Vimg + swz_off(vrow + 8, vch) + 8 * (pb_ & 1))); Hc[d] = MFMA32(A, pb[st][sp], Hc[d]); if (sp) __builtin_amdgcn_sched_barrier(0); } }
        v2u ogr[2][4];
#pragma unroll
        for (int d = 0; d < 2; ++d)
#pragma unroll
            for (int g = 0; g < 4; ++g) ogr[d][g] = *(const v2u*)(OG + (size_t)(row0 + t) * HW + h * 128 + 32 * (2 * dh + d) + 8 * g + 4 * hh);
        __builtin_amdgcn_sched_barrier(0);
#pragma unroll
        for (int dd = 0; dd < 2; ++dd) {
            int lc = lane; asm volatile("" : "+v"(lc)); const int rc = lc & 31, hc = lc >> 5;
            const float sfac = dd ? sfb : sff; const LAS unsigned char* Cimg = dd ? Cb : Cf;
            bf16x8_t qs[8];
#pragma unroll
            for (int ks = 0; ks < 8; ++ks) { v4u w;
                w.x = cvtpk(bf2f((unsigned short)qf2[ks][0]) * sfac, bf2f((unsigned short)qf2[ks][1]) * sfac); w.y = cvtpk(bf2f((unsigned short)qf2[ks][2]) * sfac, bf2f((unsigned short)qf2[ks][3]) * sfac);
                w.z = cvtpk(bf2f((unsigned short)qf2[ks][4]) * sfac, bf2f((unsigned short)qf2[ks][5]) * sfac); w.w = cvtpk(bf2f((unsigned short)qf2[ks][6]) * sfac, bf2f((unsigned short)qf2[ks][7]) * sfac);
                qs[ks] = __builtin_bit_cast(bf16x8_t, w); }
#pragma unroll
            for (int d = 0; d < 2; ++d) { const int dvt = 2 * dh + d;
#pragma unroll
                for (int ks = 0; ks < 8; ++ks) { const bf16x8_t A = *(const LAS bf16x8_t*)(Cimg + swz_off(32 * dvt + rc, 2 * ks + hc)); Hc[d] = MFMA32(A, qs[ks], Hc[d]); if (ks & 1) __builtin_amdgcn_sched_barrier(0); } }
        }
        __builtin_amdgcn_sched_barrier(0);
        float ss = 0.f;
#pragma unroll
        for (int d = 0; d < 2; ++d)
#pragma unroll
            for (int i = 0; i < 16; ++i) ss += Hc[d][i] * Hc[d][i];
        ss += lane_get(ss, lane ^ 32);
        if (hh == 0) SSQ[dh * 128 + t] = ss;
        LDS_BARRIER();
        const float rr = 1.0f / sqrtf((SSQ[t] + SSQ[128 + t]) * (1.0f / 128.0f) + EPS);
#pragma unroll
        for (int d = 0; d < 2; ++d)
#pragma unroll
            for (int g = 0; g < 4; ++g) { const int dv = 32 * (2 * dh + d) + 8 * g + 4 * hh;
                const v2u og = ogr[d][g]; const f32x4 gg = *(const f32x4*)(mg + h * 128 + dv);
                v2u o; o.x = cvtpk(Hc[d][4 * g] * rr * gg.x * bflo(og.x), Hc[d][4 * g + 1] * rr * gg.y * bfhi(og.x)); o.y = cvtpk(Hc[d][4 * g + 2] * rr * gg.z * bflo(og.y), Hc[d][4 * g + 3] * rr * gg.w * bfhi(og.y));
                *(v2u*)(Y + (size_t)(row0 + t) * D + h * 128 + dv) = o; }
        if (!more) break;
        it = itn;
    }
#undef OUT_PREFETCH
    __syncthreads();
}
__device__ __forceinline__ void sgu_item_mfma(const bf16* Z, const float* lg, const float* lb, const bf16* swb, const float* sb, bf16* Y, int chunk, LAS unsigned char* lds, int tid) {
    asm volatile("" : "+v"(tid));
    const int lane = tid & 63, wave = __builtin_amdgcn_readfirstlane(tid >> 6);
    const int row0 = chunk * 128;
    LAS unsigned char* VN = lds;
    const int r = lane & 31, hh = lane >> 5, i16 = lane & 15, q = i16 >> 2, p = i16 & 3, blk = (lane >> 4) & 1;
    const int g = wave >> 1, ct = wave & 1;
    const bf16* wg = swb + (size_t)g * 128 * 128;
#define SGU_LOAD(BF, UU, BS, pt_) do { _Pragma("unroll") for (int ks = 0; ks < 8; ++ks) BF[ks] = *(const bf16x8_t*)(wg + (size_t)(32 * (pt_) + r) * 128 + 16 * ks + 8 * hh); \
        BS = sb[g * 128 + 32 * (pt_) + r]; \
        _Pragma("unroll") for (int gq = 0; gq < 4; ++gq) UU[gq] = *(const v2u*)(Z + (size_t)(row0 + 32 * (pt_) + r) * 512 + 64 * g + 32 * ct + 8 * gq + 4 * hh); } while (0)
#define SGU_TILE(BF, UU, BS, pt_) do { f32x16 acc; _Pragma("unroll") for (int i = 0; i < 16; ++i) acc[i] = 0.f; \
        _Pragma("unroll") for (int ks = 0; ks < 8; ++ks) acc = MFMA32(af[ks], BF[ks], acc); \
        const int tok = row0 + 32 * (pt_) + r; \
        _Pragma("unroll") for (int gq = 0; gq < 4; ++gq) { const int ch = 64 * g + 32 * ct + 8 * gq + 4 * hh; const v2u u = UU[gq]; \
            v2u o; o.x = cvtpk(bflo(u.x) * (acc[4 * gq] + BS), bfhi(u.x) * (acc[4 * gq + 1] + BS)); o.y = cvtpk(bflo(u.y) * (acc[4 * gq + 2] + BS), bfhi(u.y) * (acc[4 * gq + 3] + BS)); \
            *(v2u*)(Y + (size_t)tok * D + 512 + ch) = o; } } while (0)
    bf16x8_t bfA[8], bfB[8]; v2u uA[4], uB[4]; float bsA, bsB;
    SGU_LOAD(bfA, uA, bsA, 0);
    {
        const int l16 = lane & 15, tq = lane >> 4;
        f32x4 gg[4], bb[4];
#pragma unroll
        for (int c = 0; c < 4; ++c) { gg[c] = *(const f32x4*)(lg + l16 * 16 + 4 * c); bb[c] = *(const f32x4*)(lb + l16 * 16 + 4 * c); }
        v4u raw[4][2];
#pragma unroll
        for (int tt = 0; tt < 4; ++tt) { const bf16* zp = Z + (size_t)(row0 + wave * 16 + 4 * tt + tq) * 512 + 256 + l16 * 16; raw[tt][0] = *(const v4u*)zp; raw[tt][1] = *(const v4u*)(zp + 8); }
#pragma unroll
        for (int tt = 0; tt < 4; ++tt) { const int t = wave * 16 + 4 * tt + tq;
            float x[16];
#pragma unroll
            for (int c = 0; c < 2; ++c) { x[8 * c] = bflo(raw[tt][c].x); x[8 * c + 1] = bfhi(raw[tt][c].x); x[8 * c + 2] = bflo(raw[tt][c].y); x[8 * c + 3] = bfhi(raw[tt][c].y);
                x[8 * c + 4] = bflo(raw[tt][c].z); x[8 * c + 5] = bfhi(raw[tt][c].z); x[8 * c + 6] = bflo(raw[tt][c].w); x[8 * c + 7] = bfhi(raw[tt][c].w); }
            float s = 0.f;
#pragma unroll
            for (int c = 0; c < 16; ++c) s += x[c];
            ROW_SUM16(s);
            const float mu = s * (1.0f / 256.0f); float vs = 0.f;
#pragma unroll
            for (int c = 0; c < 16; ++c) { x[c] -= mu; vs += x[c] * x[c]; }
            ROW_SUM16(vs);
            const float rs = 1.0f / sqrtf(vs * (1.0f / 256.0f) + EPS);
            v4u o0, o1;
            o0.x = cvtpk(x[0] * rs * gg[0].x + bb[0].x, x[1] * rs * gg[0].y + bb[0].y); o0.y = cvtpk(x[2] * rs * gg[0].z + bb[0].z, x[3] * rs * gg[0].w + bb[0].w);
            o0.z = cvtpk(x[4] * rs * gg[1].x + bb[1].x, x[5] * rs * gg[1].y + bb[1].y); o0.w = cvtpk(x[6] * rs * gg[1].z + bb[1].z, x[7] * rs * gg[1].w + bb[1].w);
            o1.x = cvtpk(x[8] * rs * gg[2].x + bb[2].x, x[9] * rs * gg[2].y + bb[2].y); o1.y = cvtpk(x[10] * rs * gg[2].z + bb[2].z, x[11] * rs * gg[2].w + bb[2].w);
            o1.z = cvtpk(x[12] * rs * gg[3].x + bb[3].x, x[13] * rs * gg[3].y + bb[3].y); o1.w = cvtpk(x[14] * rs * gg[3].z + bb[3].z, x[15] * rs * gg[3].w + bb[3].w);
            *(LAS v4u*)(VN + t * 512 + l16 * 32) = o0; *(LAS v4u*)(VN + t * 512 + l16 * 32 + 16) = o1; }
    }
    __syncthreads();
    bf16x8_t af[8];
#pragma unroll
    for (int ks = 0; ks < 8; ++ks) { const LAS unsigned char* va = VN + (16 * ks + 8 * hh + q) * 512 + 2 * (64 * g + 32 * ct + 16 * blk + 4 * p); af[ks] = cat8(tr16(va), tr16(va + 4 * 512)); }
    SGU_LOAD(bfB, uB, bsB, 1); SGU_TILE(bfA, uA, bsA, 0);
    SGU_LOAD(bfA, uA, bsA, 2); SGU_TILE(bfB, uB, bsB, 1);
    SGU_LOAD(bfB, uB, bsB, 3); SGU_TILE(bfA, uA, bsA, 2);
    SGU_TILE(bfB, uB, bsB, 3);
#undef SGU_LOAD
#undef SGU_TILE
    __syncthreads();
}

__device__ __forceinline__ void conv_wave_item(const bf16* YC, const float* cw, const float* cb, float* CV, int item, int lane) {
    int base, stride, len, p0, ch0;
    if (item < 1024) { const int b = item >> 6, gr = (item >> 1) & 31; base = b * SEQ + gr * 64; stride = 1; len = 64; p0 = 32 * (item & 1); ch0 = 0; }
    else if (item < 2048) { const int it = item - 1024, b = it >> 6, c = it & 63; base = b * SEQ + c; stride = 64; len = 32; p0 = 0; ch0 = 128; }
    else { const int it = item - 2048, b = it >> 4, half = (it >> 3) & 1, sg = it & 7; base = ML + b * CTXL; stride = 1; len = 256; p0 = 32 * sg; ch0 = 128 * half; }
    const int ch = ch0 + 2 * lane;
    unsigned xin[62];
#pragma unroll
    for (int pp = 0; pp < 62; ++pp) { const int pos = p0 + pp - 15;
        xin[pp] = (pos >= 0 && pos < len) ? *(const unsigned*)(YC + (size_t)(base + pos * stride) * 256 + ch) : 0u; }
    f32x2 wk[31];
#pragma unroll
    for (int k = 0; k < 31; ++k) wk[k] = *(const f32x2*)(cw + k * 256 + ch);
    const f32x2 bias = *(const f32x2*)(cb + ch);
#pragma unroll
    for (int o = 0; o < 32; ++o) { f32x2 acc = bias;
#pragma unroll
        for (int k = 0; k < 31; ++k) { const unsigned w = xin[o + k]; acc.x += wk[k].x * bflo(w); acc.y += wk[k].y * bfhi(w); }
        *(f32x2*)(CV + (size_t)(base + (p0 + o) * stride) * 256 + ch) = acc; }
}

__device__ __forceinline__ void conv_finalize(const float* CV, const float* lg, const float* lb, bf16* Y, int nrows, int G, int tid) {
    asm volatile("" : "+v"(tid));
    const int lane = tid & 63, wave = __builtin_amdgcn_readfirstlane(tid >> 6);
    const int gw = blockIdx.x * NWAVES + wave, NGW = G * NWAVES;
    const int l16 = lane & 15, tq = lane >> 4;
    f32x4 gg[4], bb[4];
#pragma unroll
    for (int c = 0; c < 4; ++c) { gg[c] = *(const f32x4*)(lg + l16 * 16 + 4 * c); bb[c] = *(const f32x4*)(lb + l16 * 16 + 4 * c); }
#pragma unroll 2
    for (int r4 = gw; r4 < nrows / 4; r4 += NGW) {
        const int r = 4 * r4 + tq;
        f32x4 x[4];
#pragma unroll
        for (int c = 0; c < 4; ++c) x[c] = *(const f32x4*)(CV + (size_t)r * 256 + l16 * 16 + 4 * c);
        float s = 0.f;
#pragma unroll
        for (int c = 0; c < 4; ++c) s += (x[c].x + x[c].y) + (x[c].z + x[c].w);
        ROW_SUM16(s);
        const float mu = s * (1.0f / 256.0f); float vs = 0.f;
#pragma unroll
        for (int c = 0; c < 4; ++c) { x[c] = x[c] - mu; vs += (x[c].x * x[c].x + x[c].y * x[c].y) + (x[c].z * x[c].z + x[c].w * x[c].w); }
        ROW_SUM16(vs);
        const float rs = 1.0f / sqrtf(vs * (1.0f / 256.0f) + EPS);
        unsigned o[8];
#pragma unroll
        for (int c = 0; c < 4; ++c) { f32x4 y = x[c] * rs * gg[c] + bb[c];
            y.x *= fsigmoid(y.x); y.y *= fsigmoid(y.y); y.z *= fsigmoid(y.z); y.w *= fsigmoid(y.w);
            o[2 * c] = cvtpk(y.x, y.y); o[2 * c + 1] = cvtpk(y.z, y.w); }
        bf16* yp = Y + (size_t)r * D + 768 + l16 * 16;
        *(v4u*)yp = (v4u){o[0], o[1], o[2], o[3]}; *(v4u*)(yp + 8) = (v4u){o[4], o[5], o[6], o[7]};
    }
}
constexpr int N_PHASES = 18;
#ifndef MK_ONE_LAUNCH
#define MK_ONE_LAUNCH 0
#endif
#ifndef PH_MASK
#define PH_MASK 0x3ff
#endif
#ifndef REP_MASK
#define REP_MASK 0
#endif
#ifndef DEFER
#define DEFER 1
#endif
#ifndef SUBREP
#define SUBREP 0
#endif
#define SUBREPS(b) ((((SUBREP) >> (b)) & 1) + 1)
#define PH_EN(b) (((PH_MASK) >> (b)) & 1)

__global__ void __launch_bounds__(NTHREADS, 2) fwd_kernel(Args args) {
    extern __shared__ __attribute__((aligned(16))) unsigned char lds_raw[];
    LAS unsigned char* lds = (LAS unsigned char*)lds_raw;
    const int G = gridDim.x;
    unsigned char* ws = args.ws;
    volatile LAS unsigned* MISC = (volatile LAS unsigned*)(lds + MISC_OFF);
    for (int u = threadIdx.x; u < (LDS_BYTES - RING_BYTES) / 4; u += NTHREADS) ((LAS unsigned*)(lds + RING_BYTES))[u] = 0u;
    __syncthreads();
    XcdBarrier bar; bar.bar = (unsigned*)(ws + WS_CTL) + 4096; bar.x = 0; bar.st = nullptr;
    const int lo = args.ph_lo, hi = args.ph_hi;
    if (hi - lo > 1) bar = xcd_barrier_post((unsigned*)(ws + WS_CTL) + 4096, MISC + 8);
#define IN(k) (lo <= (k) && (k) < hi)
#define SEAM(k) do { if (IN(k) && IN((k) + 1)) xcd_barrier(bar); } while (0)

#pragma unroll 1
    for (int ph = lo; ph < hi; ++ph) {
#if REP_MASK
#pragma unroll 1
      for (int rep = 0; rep < ((ph >= 1 && ph <= 16 && (((REP_MASK) >> ((ph - 1) & 7)) & 1)) ? 2 : 1); ++rep) {
#else
      {
#endif
        int tid = threadIdx.x; asm volatile("" : "+v"(tid));
        const int lane = tid & 63, wave = __builtin_amdgcn_readfirstlane(tid >> 6);
        if (ph == 0) { if (PH_EN(8)) phase_prologue(args, lds, G, tid, lane, wave); }
        else if (ph == N_PHASES - 1) { if (PH_EN(9)) phase_final(args.out, args.in[I_FG], G, lane, wave); }
        else {
            const int l = (ph - 1) >> 3, k = (ph - 1) & 7;
            if (DEFER && (k == 5 || (k == 0 && l == 1))) continue;
            {
            const bool last = (l == DEPTH - 1);
            const int mrest = last ? ML : MT;
            const float* modl = (const float*)(ws + WS_MOD) + (size_t)l * 17 * MODW;
            const unsigned char* wl = ws + WS_W + (size_t)l * W_LAYER;
            if (k == 0 && PH_EN(0)) {
                phase_norm(l == 0 ? args.in[I_X] : args.out, l == 0 ? args.in[I_CTX] : (const float*)(ws + WS_XC), (bf16*)(ws + WS_A), args.in[I_N1G] + l * D, modl, 0, MT, G, lane, wave);
                if (DEFER) phase_shifts(args, lds, G, tid);
            } else if (k == 1 && PH_EN(1)) {
                int tk1 = tid; asm volatile("" : "+v"(tk1));
                pg8::Gemm g{(const bf16*)(ws + WS_A), (const bf16*)(wl + WO_IN), MT, NIN, D}; pg8::InLastOrder S; S.init(last, G, (int)blockIdx.x);
                pg8::EpiIn E{ws + WS_P, (!DEFER || l == 0) ? (const float*)(ws + WS_BIN) + l * NIN : (const float*)(ws + WS_SHIN), (!DEFER || l == 0) ? 0 : NIN, (!DEFER || l == 0) ? nullptr : (const float*)(ws + WS_SS) + 2 * MT};
                pg8::gemm_phase<pg8::EpiIn, pg8::InLastOrder, true, true>(lds, g, S, E, tk1);
            } else if (k == 2 && PH_EN(2)) {
                for (int rp = 0; rp < SUBREPS(0); ++rp)
                for (int it = blockIdx.x; it < 256; it += G)
                    mlstm_state_item((const bf16*)(ws + WS_K), (const bf16*)(ws + WS_V), (const float*)(ws + WS_GT), (bf16*)(ws + WS_CT), (float*)(ws + WS_NS), (float*)(ws + WS_TAB), it, !last, lds, tid);
                const int nch = mrest / 128;
                for (int rp = 0; rp < SUBREPS(1); ++rp)
                for (int it = blockIdx.x; it < nch; it += G)
                    sgu_item_mfma((const bf16*)(ws + WS_Z), args.in[I_SLG] + l * 256, args.in[I_SLB] + l * 256, (const bf16*)(ws + WS_SWB) + (size_t)l * 4 * 128 * 128, args.in[I_SB] + l * 4 * 128, (bf16*)(ws + WS_Y), it, lds, tid);
                { int tid2 = tid; asm volatile("" : "+v"(tid2)); const int lane2 = tid2 & 63, wave2 = __builtin_amdgcn_readfirstlane(tid2 >> 6);
                  const int ncv = last ? 2048 : 2304;
#pragma unroll 1
                  for (int rp = 0; rp < SUBREPS(2); ++rp)
#pragma unroll 1
                  for (int it = (int)((blockIdx.x + G / 2) % G) * NWAVES + wave2; it < ncv; it += G * NWAVES)
                      conv_wave_item((const bf16*)(ws + WS_YC), args.in[I_CW] + l * 31 * 256, args.in[I_CB] + l * 256, (float*)(ws + WS_CV), it, lane2); }
            } else if (k == 3 && PH_EN(3)) {
                for (int rp = 0; rp < SUBREPS(3); ++rp)
                mlstm_out_phase((const bf16*)(ws + WS_Q), (const bf16*)(ws + WS_K), (const bf16*)(ws + WS_V), (const bf16*)(ws + WS_OG), (const bf16*)(ws + WS_CT), (const float*)(ws + WS_NS), (const float*)(ws + WS_TAB),
                                args.in[I_MG] + l * HW, (bf16*)(ws + WS_Y), last ? 2 : 0, G, lds, tid);
                for (int rp = 0; rp < SUBREPS(4); ++rp)
                conv_finalize((const float*)(ws + WS_CV), args.in[I_CLG] + l * 256, args.in[I_CLB] + l * 256, (bf16*)(ws + WS_Y), mrest, G, tid);
            } else if (k == 4 && PH_EN(4)) {
                int tk2 = tid; asm volatile("" : "+v"(tk2));
                pg8::Gemm g{(const bf16*)(ws + WS_Y), (const bf16*)(wl + WO_OUT), mrest, D, D}; pg8::StaticOrder S; S.init(mrest, D, G, (int)blockIdx.x);
                pg8::EpiRes<DEFER != 0> E{l == 0 ? args.in[I_X] : args.out, args.out, l == 0 ? args.in[I_CTX] : (const float*)(ws + WS_XC), (float*)(ws + WS_XC), modl + 2 * D, ML,
                              (bf16*)(ws + WS_A), (const float*)(ws + WS_GS) + (size_t)((l * 2 + 1) * 17) * 1024, (float*)(ws + WS_SS) + (size_t)l * MT, lds + MX_OFF};
                pg8::gemm_phase<pg8::EpiRes<DEFER != 0>, pg8::StaticOrder, true, true>(lds, g, S, E, tk2);
            } else if (k == 5 && PH_EN(5)) {
                phase_norm(args.out, (const float*)(ws + WS_XC), (bf16*)(ws + WS_A), args.in[I_N2G] + l * D, modl, 3 * D, mrest, G, lane, wave);
            } else if (k == 6 && PH_EN(6)) {
                int tk3 = tid; asm volatile("" : "+v"(tk3));
                pg8::Gemm g{(const bf16*)(ws + WS_A), (const bf16*)(wl + WO_GU), mrest, NGU, D}; pg8::StaticOrder S; S.init(mrest, NGU, G, (int)blockIdx.x);
                pg8::EpiGU E{(bf16*)(ws + WS_H), DEFER ? (const float*)(ws + WS_SS) + (size_t)l * MT : nullptr, DEFER ? (const float*)(ws + WS_SHGU) + (size_t)l * 17 * NGU : nullptr};
                pg8::gemm_phase<pg8::EpiGU, pg8::StaticOrder, true, true>(lds, g, S, E, tk3);
            } else if (PH_EN(7)) {
                int tk4 = tid; asm volatile("" : "+v"(tk4));
                pg8::Gemm g{(const bf16*)(ws + WS_H), (const bf16*)(wl + WO_DOWN), mrest, D, FF}; pg8::StaticOrder S; S.init(mrest, D, G, (int)blockIdx.x);
                pg8::EpiRes<DEFER != 0> E{args.out, args.out, (const float*)(ws + WS_XC), (float*)(ws + WS_XC), modl + 5 * D, ML,
                              (bf16*)(ws + WS_A), (const float*)(ws + WS_GS) + (size_t)(2 * 17) * 1024, (float*)(ws + WS_SS) + 2 * (size_t)MT, lds + MX_OFF};
                pg8::gemm_phase<pg8::EpiRes<DEFER != 0>, pg8::StaticOrder, true, true>(lds, g, S, E, tk4);
            }
            }
        }
      }
        if (ph + 1 < hi) xcd_barrier(bar);
    }
#undef IN
#undef SEAM
}

extern "C" void kernel_launch(void* const* d_in, const int* in_sizes, int n_in, void* d_out, int out_size, void* d_ws, size_t ws_size, hipStream_t stream) {
    static int grid = 0;
    if (grid == 0) {
        if (n_in != 23 || in_sizes[0] != ML * D || out_size != ML * D || ws_size < WS_END) {
            fprintf(stderr, "kernel_launch: unexpected problem (n_in %d, in0 %d, out %d, ws %zu < %zu); nothing launched\n", n_in, n_in > 0 ? in_sizes[0] : -1, out_size, ws_size, (size_t)WS_END); grid = -1; return; }
        int dev = 0, cus = 0, per_cu = 0;
        if (hipGetDevice(&dev) != hipSuccess || hipDeviceGetAttribute(&cus, hipDeviceAttributeMultiprocessorCount, dev) != hipSuccess) { grid = -1; return; }
        if (hipFuncSetAttribute((const void*)fwd_kernel, hipFuncAttributeMaxDynamicSharedMemorySize, LDS_BYTES) != hipSuccess) { fprintf(stderr, "kernel_launch: hipFuncSetAttribute failed\n"); grid = -1; return; }
        if (hipOccupancyMaxActiveBlocksPerMultiprocessor(&per_cu, (const void*)fwd_kernel, NTHREADS, LDS_BYTES) != hipSuccess || per_cu < 1) {
            fprintf(stderr, "kernel_launch: occupancy query reports %d blocks per CU\n", per_cu); per_cu = 1; }
        (void)hipGetLastError();
        grid = cus;
    }
    if (grid < 0) return;
    if (hipMemsetAsync((char*)d_ws + WS_CTL, 0, ZERO_BYTES, stream) != hipSuccess) { fprintf(stderr, "kernel_launch: memset failed\n"); return; }
    Args a{};
    for (int i = 0; i < 23; ++i) a.in[i] = (const float*)d_in[i];
    a.out = (float*)d_out; a.ws = (unsigned char*)d_ws;
#if MK_ONE_LAUNCH
    a.ph_lo = 0; a.ph_hi = N_PHASES;
    hipLaunchKernelGGL(fwd_kernel, dim3(grid), dim3(NTHREADS), LDS_BYTES, stream, a);
#else
    for (int p = 0; p < N_PHASES; ++p) { a.ph_lo = p; a.ph_hi = p + 1; hipLaunchKernelGGL(fwd_kernel, dim3(grid), dim3(NTHREADS), LDS_BYTES, stream, a); }
#endif
    const hipError_t le = hipPeekAtLastError();
    if (le != hipSuccess) fprintf(stderr, "kernel_launch: launch failed: %s\n", hipGetErrorName(le));
}
```

```cpp
#include <hip/hip_runtime.h>
#include <cstdio>
#include <cstdint>
#ifndef MK_ONE_LAUNCH
#define MK_ONE_LAUNCH 1
#endif
namespace pg8 {
#define PG8_LAS __attribute__((address_space(3)))
typedef unsigned short bf16_t;
typedef short bf16x8 __attribute__((ext_vector_type(8)));
typedef float f32x4 __attribute__((ext_vector_type(4)));
typedef unsigned u32x4 __attribute__((ext_vector_type(4)));
constexpr int BM = 256, BK = 64, HALF = 128, HTB = HALF * BK * 2  , STAGE_BYTES = 8 * HTB, NXCD = 8, WGM = 4;

__host__ __device__ __forceinline__ int lds_byte(int r, int c) { const int st = (r >> 4) * 2 + (c >> 5), rr = r & 15, cc = c & 31, ob = rr * 64 + cc * 2; return st * 1024 + (ob ^ (((ob >> 9) & 1) << 5)); }
__host__ __device__ __forceinline__ void stage_rc(int b, int& R, int& C) { const int st = b / 1024, sb = b % 1024, swz = sb ^ (((sb >> 9) & 1) << 5); R = (st >> 1) * 16 + swz / 64; C = (st & 1) * 32 + (swz % 64) / 2; }
__host__ __device__ __forceinline__ int perm32(int rho) { const int n = rho >> 4, i = rho & 15; return 8 * (i >> 2) + 4 * n + (i & 3); }

struct Unit { int pm, pn; };
struct Gemm { const bf16_t* A; const bf16_t* Bt; int M, N, K; };

struct StaticOrder {
    int nM, nN, nwg, G, c;
    __host__ __device__ void init(int M, int N, int G_, int c_) { nM = M / BM; nN = N / BM; nwg = nM * nN; G = G_; c = c_; }
    __host__ __device__ bool next(int i, Unit& u) const {
        const long L = (long)i * G + c; if (L >= nwg) return false;
        int wgid = (int)L; { const int q = nwg / NXCD, r = nwg % NXCD, xcd = wgid % NXCD, off = wgid / NXCD; wgid = (xcd < r ? xcd * (q + 1) : r * (q + 1) + (xcd - r) * q) + off; }
        const int nig = WGM * nN, gid = wgid / nig, fm = gid * WGM, gsz = (nM - fm) < WGM ? (nM - fm) : WGM;
        u.pm = fm + ((wgid % nig) % gsz); u.pn = (wgid % nig) / gsz; return true;
    }
    __device__ __forceinline__ void a_ready(const Unit&) const {}
    __device__ __forceinline__ void done(const Unit&) const {}
};

__device__ __forceinline__ unsigned cvt_pk_bf16(float lo, float hi) { unsigned r; asm volatile("v_cvt_pk_bf16_f32 %0, %1, %2" : "=v"(r) : "v"(lo), "v"(hi)); return r; }
template <class Epi, class Sched, bool ALIGN_EPI = false, bool SP2 = false>
__device__ __forceinline__ void gemm_phase(PG8_LAS unsigned char* lds, const Gemm g, const Sched& S, const Epi& E, const int tid) {
    const int wid = __builtin_amdgcn_readfirstlane(tid >> 6), lane = tid & 63, wr = wid >> 2, wc = wid & 3, fr = lane & 15, fq = lane >> 4;
    const int K = g.K, nt = K / BK;
    unsigned voffA[2], voffB[2];
#pragma unroll
    for (int i = 0; i < 2; ++i) { int R, C; stage_rc(tid * 16 + i * 8192, R, C); const int Rb = Epi::PERM ? ((R & ~31) + perm32(R & 31)) : R;
        voffA[i] = (unsigned)(R * K + C) * 2u; voffB[i] = (unsigned)(Rb * K + C) * 2u; }
    const size_t kstep = (size_t)(BK * 2);
    const size_t hstep = (size_t)HALF * K * 2;
    const size_t tstep = 2 * hstep;
    const unsigned ldsw = (unsigned)wid * 1024u;
    const int aoff = lds_byte(wr * 64 + fr, fq * 8), boff = lds_byte(wc * 32 + fr, fq * 8);
#define PG8_SA(b, h) (((b) * 2 + (h)) * HTB)
#define PG8_SB(b, h) ((4 + (b) * 2 + (h)) * HTB)
#define PG8_STAGE(bufoff, gbase, voff) do { _Pragma("unroll") for (int _i = 0; _i < 2; ++_i) \
        __builtin_amdgcn_global_load_lds((const unsigned*)((const char*)(gbase) + (voff)[_i]), (PG8_LAS unsigned*)(lds + (bufoff) + ldsw + _i * 8192), 16, 0, 0); } while (0)
#define PG8_LDA(dst, b, h) do { _Pragma("unroll") for (int m = 0; m < 4; ++m) _Pragma("unroll") for (int k = 0; k < 2; ++k) dst[m][k] = *(const PG8_LAS bf16x8*)(lds + PG8_SA(b, h) + aoff + m * 2048 + k * 1024); } while (0)
#define PG8_LDB(dst, b, h) do { _Pragma("unroll") for (int n = 0; n < 2; ++n) _Pragma("unroll") for (int k = 0; k < 2; ++k) dst[n][k] = *(const PG8_LAS bf16x8*)(lds + PG8_SB(b, h) + boff + n * 2048 + k * 1024); } while (0)
#define PG8_MMA(ai, bj, At, Bt) do { __builtin_amdgcn_s_setprio(1); _Pragma("unroll") for (int m = 0; m < 4; ++m) _Pragma("unroll") for (int n = 0; n < 2; ++n) _Pragma("unroll") for (int k = 0; k < 2; ++k) \
        acc[ai][bj][m][n] = __builtin_amdgcn_mfma_f32_16x16x32_bf16(Bt[n][k], At[m][k], acc[ai][bj][m][n], 0, 0, 0); __builtin_amdgcn_s_setprio(0); } while (0)
#define PG8_WAIT_V(n) asm volatile("s_waitcnt vmcnt(" #n ")" ::: "memory")
#define PG8_WAIT_L(n) asm volatile("s_waitcnt lgkmcnt(" #n ")" ::: "memory")
#define PG8_BAR __builtin_amdgcn_s_barrier()
#define PG8_SCHED __builtin_amdgcn_sched_barrier(0)
    Unit cur, nxt; int ui = 0;
    if (!S.next(0, cur)) return;
    f32x4 acc[2][2][4][2];
#pragma unroll
    for (int a = 0; a < 2; ++a)
#pragma unroll
        for (int b = 0; b < 2; ++b)
#pragma unroll
            for (int m = 0; m < 4; ++m)
#pragma unroll
                for (int n = 0; n < 2; ++n) acc[a][b][m][n] = (f32x4){0.f, 0.f, 0.f, 0.f};
    bf16x8 At[4][2], B0[2][2], B1[2][2];
    const char* cA = (const char*)g.A + (size_t)cur.pm * tstep; const char* cB = (const char*)g.Bt + (size_t)cur.pn * tstep;
    S.a_ready(cur);
    if constexpr (SP2) {
        PG8_STAGE(PG8_SB(0, 0), cB, voffB); PG8_STAGE(PG8_SB(0, 1), cB + hstep, voffB); PG8_STAGE(PG8_SA(0, 0), cA, voffA); PG8_STAGE(PG8_SA(0, 1), cA + hstep, voffA);
        if (wr == 1) PG8_BAR;
        PG8_WAIT_V(2); PG8_BAR;
        PG8_STAGE(PG8_SB(1, 0), cB + kstep, voffB); PG8_STAGE(PG8_SA(1, 0), cA + kstep, voffA); PG8_STAGE(PG8_SB(1, 1), cB + hstep + kstep, voffB);
        PG8_WAIT_V(6); PG8_BAR;
    } else {
        PG8_STAGE(PG8_SB(0, 0), cB, voffB); PG8_STAGE(PG8_SA(0, 0), cA, voffA); PG8_STAGE(PG8_SB(0, 1), cB + hstep, voffB); PG8_STAGE(PG8_SA(0, 1), cA + hstep, voffA);
        if (wr == 1) PG8_BAR;
        PG8_WAIT_V(4); PG8_BAR;
        PG8_STAGE(PG8_SB(1, 0), cB + kstep, voffB); PG8_STAGE(PG8_SA(1, 0), cA + kstep, voffA); PG8_STAGE(PG8_SB(1, 1), cB + hstep + kstep, voffB);
        PG8_WAIT_V(6); PG8_BAR;
    }
    for (;;) {
        const bool has_next = S.next(ui + 1, nxt);
        const char* nA = has_next ? (const char*)g.A + (size_t)nxt.pm * tstep : cA; const char* nB = has_next ? (const char*)g.Bt + (size_t)nxt.pn * tstep : cB;
        for (int t = 0; t < nt; t += 2) {
            const bool last = (t == nt - 2);
            const char* a1 = cA + (size_t)(t + 1) * kstep;
            const char* a2 = last ? nA : cA + (size_t)(t + 2) * kstep; const char* b2 = last ? nB : cB + (size_t)(t + 2) * kstep;
            const char* a3 = a2 + kstep; const char* b3 = b2 + kstep;
            if (last && has_next) S.a_ready(nxt);
            if constexpr (SP2) {
            PG8_LDB(B0, 0, 0); PG8_LDB(B1, 0, 1); PG8_SCHED; PG8_LDA(At, 0, 0); PG8_STAGE(PG8_SA(1, 1), a1 + hstep, voffA);
            PG8_WAIT_V(8); PG8_WAIT_L(0); PG8_BAR; PG8_MMA(0, 0, At, B0); PG8_MMA(0, 1, At, B1); PG8_BAR; PG8_SCHED;
            PG8_LDA(At, 0, 1); PG8_STAGE(PG8_SB(0, 0), b2, voffB); PG8_STAGE(PG8_SB(0, 1), b2 + hstep, voffB); PG8_STAGE(PG8_SA(0, 0), a2, voffA);
            PG8_WAIT_V(8); PG8_WAIT_L(0); PG8_BAR; PG8_MMA(1, 0, At, B0); PG8_MMA(1, 1, At, B1); PG8_BAR; PG8_SCHED;
            PG8_LDB(B0, 1, 0); PG8_LDB(B1, 1, 1); PG8_SCHED; PG8_LDA(At, 1, 0); PG8_STAGE(PG8_SA(0, 1), a2 + hstep, voffA);
            PG8_WAIT_V(8); PG8_WAIT_L(0); PG8_BAR; PG8_MMA(0, 0, At, B0); PG8_MMA(0, 1, At, B1); PG8_BAR; PG8_SCHED;
            PG8_LDA(At, 1, 1); PG8_STAGE(PG8_SB(1, 0), b3, voffB); PG8_STAGE(PG8_SB(1, 1), b3 + hstep, voffB); PG8_STAGE(PG8_SA(1, 0), a3, voffA);
            PG8_WAIT_V(8); PG8_WAIT_L(0); PG8_BAR; PG8_MMA(1, 0, At, B0); PG8_MMA(1, 1, At, B1); PG8_BAR; PG8_SCHED;
            } else {
            PG8_LDB(B0, 0, 0); PG8_SCHED; PG8_LDA(At, 0, 0); PG8_STAGE(PG8_SA(1, 1), a1 + hstep, voffA);
            PG8_WAIT_L(8); PG8_BAR; PG8_WAIT_L(0); PG8_MMA(0, 0, At, B0); PG8_BAR; PG8_SCHED;
            PG8_LDB(B1, 0, 1); PG8_STAGE(PG8_SB(0, 0), b2, voffB);
            PG8_BAR; PG8_WAIT_L(0); PG8_MMA(0, 1, At, B1); PG8_BAR;
            PG8_LDA(At, 0, 1); PG8_STAGE(PG8_SA(0, 0), a2, voffA);
            PG8_BAR; PG8_WAIT_L(0); PG8_MMA(1, 0, At, B0); PG8_BAR; PG8_SCHED;
            PG8_STAGE(PG8_SB(0, 1), b2 + hstep, voffB);
            PG8_WAIT_V(6); PG8_BAR; PG8_MMA(1, 1, At, B1); PG8_BAR;
            PG8_LDB(B0, 1, 0); PG8_SCHED; PG8_LDA(At, 1, 0); PG8_STAGE(PG8_SA(0, 1), a2 + hstep, voffA);
            PG8_WAIT_L(8); PG8_BAR; PG8_WAIT_L(0); PG8_MMA(0, 0, At, B0); PG8_BAR; PG8_SCHED;
            PG8_LDB(B1, 1, 1); PG8_STAGE(PG8_SB(1, 0), b3, voffB);
            PG8_BAR; PG8_WAIT_L(0); PG8_MMA(0, 1, At, B1); PG8_BAR;
            PG8_LDA(At, 1, 1); PG8_STAGE(PG8_SA(1, 0), a3, voffA);
            PG8_BAR; PG8_WAIT_L(0); PG8_MMA(1, 0, At, B0); PG8_BAR; PG8_SCHED;
            PG8_STAGE(PG8_SB(1, 1), b3 + hstep, voffB);
            PG8_WAIT_V(6); PG8_BAR; PG8_MMA(1, 1, At, B1); PG8_BAR;
            }
        }
        if constexpr (ALIGN_EPI) { if (wr == 0) PG8_BAR; }
        if constexpr (!Epi::AFTER_DRAIN) { E(acc, cur, wr, wc, fr, fq); S.done(cur); }
        if (!has_next) break;
#pragma unroll
        for (int a = 0; a < 2; ++a)
#pragma unroll
            for (int b = 0; b < 2; ++b)
#pragma unroll
                for (int m = 0; m < 4; ++m)
#pragma unroll
                    for (int n = 0; n < 2; ++n) acc[a][b][m][n] = (f32x4){0.f, 0.f, 0.f, 0.f};
        cur = nxt; cA = nA; cB = nB; ++ui;
        if constexpr (ALIGN_EPI) { if (wr == 1) PG8_BAR; }
    }
    PG8_WAIT_V(0);
    if constexpr (!ALIGN_EPI) { if (wr == 0) PG8_BAR; }
    PG8_BAR;
    if constexpr (Epi::AFTER_DRAIN) { E.fused(acc, cur, wr, wc, fr, fq, lds, wid, lane); S.done(cur); }
#undef PG8_SA
#undef PG8_SB
#undef PG8_STAGE
#undef PG8_LDA
#undef PG8_LDB
#undef PG8_MMA
#undef PG8_WAIT_V
#undef PG8_WAIT_L
#undef PG8_BAR
#undef PG8_SCHED
}
}
namespace pg8 {
struct InLastOrder {
    StaticOrder main; int G, c;
    int ntail;
    __device__ void init(bool last, int G_, int c_) { main.init((last ? 128 : 144) * BM, 13 * BM, G_, c_); G = G_; c = c_; ntail = last ? 80 : 0; }
    __device__ bool next(int i, Unit& u) const {
        const long L = (long)i * G + c;
        if (L < main.nwg) return main.next(i, u);
        const int e = (int)(L - main.nwg); if (e >= ntail) return false;
        const int q = e % 5; u.pm = 128 + e / 5; u.pn = q < 4 ? 2 + q : 12; return true;
    }
    __device__ __forceinline__ void a_ready(const Unit&) const {}
    __device__ __forceinline__ void done(const Unit&) const {}
};
__device__ __forceinline__ u32x4 pack8(const f32x4& v0, const f32x4& v1) { u32x4 w; w.x = cvt_pk_bf16(v0[0], v0[1]); w.y = cvt_pk_bf16(v0[2], v0[3]); w.z = cvt_pk_bf16(v1[0], v1[1]); w.w = cvt_pk_bf16(v1[2], v1[3]); return w; }
__device__ __forceinline__ float sigm(float x) { return __builtin_amdgcn_rcpf(1.0f + __expf(-x)); }
__device__ __forceinline__ f32x4 sigm4(const f32x4& v) { return (f32x4){sigm(v[0]), sigm(v[1]), sigm(v[2]), sigm(v[3])}; }
__device__ __forceinline__ float gelu_t(float x) { const float u = 1.5957691216057308f * (x + 0.044715f * x * x * x); return x * sigm(u); }
__device__ __forceinline__ f32x4 gelu4(const f32x4& v) { return (f32x4){gelu_t(v[0]), gelu_t(v[1]), gelu_t(v[2]), gelu_t(v[3])}; }

struct EpiIn {
    static constexpr bool PERM = true, AFTER_DRAIN = false;
    unsigned char* P; const float* bias; int bstride; const float* ss;
    __device__ __forceinline__ void operator()(const f32x4 (&acc)[2][2][4][2], const Unit& u, int wr, int wc, int fr, int fq) const {
        const int pn = u.pn, row0 = u.pm * BM + wr * 64 + fr, cl = wc * 32 + 8 * fq;
        const float* bp = bias + (size_t)(u.pm < 128 ? (u.pm >> 3) : 16) * bstride;
        f32x4 bv[2][2];
#pragma unroll
        for (int bj = 0; bj < 2; ++bj)
#pragma unroll
            for (int n = 0; n < 2; ++n) bv[bj][n] = *(const f32x4*)(bp + pn * BM + bj * HALF + cl + 4 * n);
        float rsc[2][4];
#pragma unroll
        for (int ai = 0; ai < 2; ++ai)
#pragma unroll
            for (int m = 0; m < 4; ++m) rsc[ai][m] = ss ? 1.0f / sqrtf(ss[row0 + ai * HALF + m * 16] * (1.0f / 1024.0f) + 1e-6f) : 1.0f;
        if (pn < 10) {
            bf16_t* base = (bf16_t*)(P + (size_t)(pn >> 1) * (36u << 20));
            const float sc = (pn >= 2 && pn < 4) ? 0.08838834764831845f : 1.0f;
            const int act = pn < 6 ? 0 : pn < 8 ? 1 : 2;
            const int dcol = (pn & 1) * BM + cl;
#pragma unroll
            for (int ai = 0; ai < 2; ++ai)
#pragma unroll
                for (int m = 0; m < 4; ++m) { bf16_t* rowp = base + (size_t)(row0 + ai * HALF + m * 16) * 512 + dcol;
#pragma unroll
                    for (int bj = 0; bj < 2; ++bj) { f32x4 v0 = acc[ai][bj][m][0] * rsc[ai][m] + bv[bj][0], v1 = acc[ai][bj][m][1] * rsc[ai][m] + bv[bj][1];
                        if (act == 1) { v0 = sigm4(v0); v1 = sigm4(v1); } else if (act == 2) { v0 = gelu4(v0); v1 = gelu4(v1); } else { v0 = v0 * sc; v1 = v1 * sc; }
                        *(u32x4*)(rowp + bj * HALF) = pack8(v0, v1); } }
        } else if (pn < 12) {
            const int dcol = (pn - 10) * HALF + cl;
#pragma unroll
            for (int ai = 0; ai < 2; ++ai)
#pragma unroll
                for (int m = 0; m < 4; ++m) { bf16_t* rowp = (bf16_t*)(P + (size_t)5 * (36u << 20)) + (size_t)(row0 + ai * HALF + m * 16) * 256 + dcol;
                    const f32x4 a0 = acc[ai][0][m][0] * rsc[ai][m] + bv[0][0], a1 = acc[ai][0][m][1] * rsc[ai][m] + bv[0][1];
                    const f32x4 g0 = sigm4(acc[ai][1][m][0] * rsc[ai][m] + bv[1][0]), g1 = sigm4(acc[ai][1][m][1] * rsc[ai][m] + bv[1][1]);
                    *(u32x4*)rowp = pack8(a0 * g0, a1 * g1); }
        } else {
            if (wc == 0 && fq < 2) {
#pragma unroll
                for (int ai = 0; ai < 2; ++ai)
#pragma unroll
                    for (int m = 0; m < 4; ++m) { float* rowp = (float*)(P + (size_t)5 * (36u << 20) + (18u << 20)) + (size_t)(row0 + ai * HALF + m * 16) * 16 + 8 * fq;
                        *(f32x4*)rowp = acc[ai][0][m][0] * rsc[ai][m] + bv[0][0]; *(f32x4*)(rowp + 4) = acc[ai][0][m][1] * rsc[ai][m] + bv[0][1]; }
            }
        }
    }
};

struct EpiGU {
    static constexpr bool PERM = true, AFTER_DRAIN = false;
    bf16_t* H; const float* ss; const float* shb;
    __device__ __forceinline__ void operator()(const f32x4 (&acc)[2][2][4][2], const Unit& u, int wr, int wc, int fr, int fq) const {
        const int row0 = u.pm * BM + wr * 64 + fr, cl = wc * 32 + 8 * fq, dcol = u.pn * HALF + cl;
        f32x4 sg0 = {0.f, 0.f, 0.f, 0.f}, sg1 = sg0, su0 = sg0, su1 = sg0;
        if (shb) { const float* sp = shb + (size_t)(u.pm < 128 ? (u.pm >> 3) : 16) * 5632 + u.pn * BM + cl; sg0 = *(const f32x4*)sp; sg1 = *(const f32x4*)(sp + 4); su0 = *(const f32x4*)(sp + HALF); su1 = *(const f32x4*)(sp + HALF + 4); }
#pragma unroll
        for (int ai = 0; ai < 2; ++ai)
#pragma unroll
            for (int m = 0; m < 4; ++m) { const int row = row0 + ai * HALF + m * 16; bf16_t* rowp = H + (size_t)row * 2816 + dcol;
                const float rs = ss ? 1.0f / sqrtf(ss[row] * (1.0f / 1024.0f) + 1e-6f) : 1.0f;
                const f32x4 g0 = acc[ai][0][m][0] * rs + sg0, g1 = acc[ai][0][m][1] * rs + sg1;
                *(u32x4*)rowp = pack8(g0 * sigm4(g0) * (acc[ai][1][m][0] * rs + su0), g1 * sigm4(g1) * (acc[ai][1][m][1] * rs + su1)); }
    }
};

template <bool WA2> struct EpiRes {
    static constexpr bool PERM = false, AFTER_DRAIN = false;
    const float* baseL; float* outL; const float* baseC; float* outC; const float* gate; int nlat;
    bf16_t* A2; const float* gs; float* ss;
    PG8_LAS unsigned char* xl;
    __device__ __forceinline__ void operator()(const f32x4 (&acc)[2][2][4][2], const Unit& u, int wr, int wc, int fr, int fq) const {
        const int trow = u.pm * BM; const bool lat = trow < nlat;
        const char* base = (const char*)(lat ? baseL + (size_t)trow * 1024 : baseC + (size_t)(trow - nlat) * 1024);
        char* out = (char*)(lat ? outL + (size_t)trow * 1024 : outC + (size_t)(trow - nlat) * 1024);
        char* ap = (char*)(A2 + (size_t)trow * 1024);
        const int mrow = lat ? (trow >> 11) : 16;
        const float* gv = gate + (size_t)mrow * 6144; const float* gsv = gs + (size_t)mrow * 1024;
        PG8_LAS float* sl = (PG8_LAS float*)(xl + (wr * 4 + wc) * 2304);
        const int lane = fr + 16 * fq, rr = lane >> 3, cq = lane & 7;
        const int colm = u.pn * BM + wc * 32 + 4 * fq;
        const int colr = u.pn * BM + wc * 32 + 4 * cq;
        f32x4 g[2][2], gsc[2];
#pragma unroll
        for (int bj = 0; bj < 2; ++bj) { gsc[bj] = WA2 ? *(const f32x4*)(gsv + colr + bj * HALF) : (f32x4){0.f, 0.f, 0.f, 0.f};
#pragma unroll
            for (int n = 0; n < 2; ++n) g[bj][n] = *(const f32x4*)(gv + colm + bj * HALF + n * 16); }
        const unsigned lo = (unsigned)((wr * 64 + rr) * 1024 + colr) * 4u;
        f32x4 bv[2][2][2];
#define ER_LOAD(gi) do { _Pragma("unroll") for (int bj = 0; bj < 2; ++bj) _Pragma("unroll") for (int ps = 0; ps < 2; ++ps) \
            bv[(gi) & 1][bj][ps] = *(const f32x4*)(base + (size_t)(lo + (unsigned)(((((gi) >> 2) * HALF + ((gi) & 3) * 16 + 8 * ps) * 1024 + bj * HALF) * 4))); } while (0)
        ER_LOAD(0);
#pragma unroll
        for (int gi = 0; gi < 8; ++gi) { const int ai = gi >> 2, m = gi & 3;
            float q0 = 0.f, q1 = 0.f;
            f32x4 o[2][2];
#pragma unroll
            for (int bj = 0; bj < 2; ++bj) {
                *(PG8_LAS f32x4*)(sl + fr * 36 + 4 * fq) = g[bj][0] * acc[ai][bj][m][0]; *(PG8_LAS f32x4*)(sl + fr * 36 + 16 + 4 * fq) = g[bj][1] * acc[ai][bj][m][1];
                o[bj][0] = bv[gi & 1][bj][0] + *(const PG8_LAS f32x4*)(sl + rr * 36 + 4 * cq); o[bj][1] = bv[gi & 1][bj][1] + *(const PG8_LAS f32x4*)(sl + (rr + 8) * 36 + 4 * cq);
            }
            asm volatile("" ::: "memory");
            if (gi < 7) ER_LOAD(gi + 1);
            asm volatile("" ::: "memory");
#pragma unroll
            for (int bj = 0; bj < 2; ++bj)
#pragma unroll
                for (int ps = 0; ps < 2; ++ps) { const unsigned off = lo + (unsigned)((((ai * HALF + m * 16 + 8 * ps) * 1024) + bj * HALF) * 4); const f32x4 v = o[bj][ps];
                    *(f32x4*)(out + (size_t)off) = v;
                    if (WA2) { const float qq = (v[0] * v[0] + v[1] * v[1]) + (v[2] * v[2] + v[3] * v[3]); if (ps) q1 += qq; else q0 += qq; const f32x4 a = v * gsc[bj];
                        typedef unsigned u32x2v __attribute__((ext_vector_type(2))); u32x2v w; w.x = cvt_pk_bf16(a[0], a[1]); w.y = cvt_pk_bf16(a[2], a[3]);
                        *(u32x2v*)(ap + (size_t)(off >> 1)) = w; } }
            if (WA2) {
                q0 += __shfl_xor(q0, 1); q0 += __shfl_xor(q0, 2); q0 += __shfl_xor(q0, 4); q1 += __shfl_xor(q1, 1); q1 += __shfl_xor(q1, 2); q1 += __shfl_xor(q1, 4);
                if (cq == 0) { float* sp = ss + trow + wr * 64 + ai * HALF + m * 16 + rr; atomicAdd(sp, q0); atomicAdd(sp + 8, q1); } }
            asm volatile("" ::: "memory");
        }
#undef ER_LOAD
    }
};
}
constexpr int D = 1024, NB = 16, SEQ = 2048, CTXL = 256, DEPTH = 2;
constexpr int ML = NB * SEQ, MC = NB * CTXL, MT = ML + MC;
constexpr int NIN_O = 3088, NIN = 3328, FF = 2816, NGU = 2 * FF;
constexpr int HW = 512;
constexpr int MODW = 6 * D;
constexpr float EPS = 1e-6f;
constexpr int NWAVES = 8, NTHREADS = 512;

constexpr size_t MiB = 1u << 20;
constexpr size_t WS_CTL = 0;
constexpr size_t WS_MOD = 1 * MiB;
constexpr size_t WS_SHGU = 2 * MiB;
constexpr size_t WS_SHIN = 2 * MiB + 768 * 1024;
constexpr size_t WS_SS = 3 * MiB;
constexpr size_t ZERO_BYTES = 3 * MiB + 512 * 1024;
constexpr size_t WS_BIN = 3 * MiB + 512 * 1024;
constexpr size_t WS_SWB = WS_BIN + 65536;
constexpr size_t WS_GS = 4 * MiB;
constexpr size_t WS_W = 5 * MiB, W_LAYER = 25 * MiB;
constexpr size_t WO_IN = 0, WO_OUT = 6 * MiB + 512 * 1024, WO_GU = WO_OUT + 2 * MiB, WO_DOWN = WO_GU + 11 * MiB;
constexpr size_t WS_XC = 55 * MiB;
constexpr size_t WS_A = 71 * MiB;
constexpr size_t WS_P = 143 * MiB;
constexpr size_t WS_Q = WS_P, WS_K = WS_Q + 36 * MiB, WS_V = WS_K + 36 * MiB, WS_OG = WS_V + 36 * MiB, WS_Z = WS_OG + 36 * MiB, WS_YC = WS_Z + 36 * MiB, WS_GT = WS_YC + 18 * MiB;
constexpr size_t WS_H = WS_P;
constexpr size_t WS_Y = 344 * MiB;
constexpr size_t WS_CT = WS_A;
constexpr size_t WS_NS = 454 * MiB, WS_TAB = 460 * MiB;
constexpr size_t WS_CV = 418 * MiB;
constexpr size_t WS_END = 486 * MiB;
static_assert(WS_GT + (size_t)MT * 16 * 4 <= WS_Y && WS_H + (size_t)MT * FF * 2 <= WS_Y && WS_W + 2 * W_LAYER <= WS_XC && WO_DOWN + (size_t)D * FF * 2 <= W_LAYER && WS_Y + (size_t)MT * D * 2 <= WS_CV && WS_SS + 3 * (size_t)MT * 4 <= ZERO_BYTES && WS_SHIN + 17 * (size_t)NIN * 4 <= WS_SS && WS_SHGU + 2 * 17 * (size_t)NGU * 4 <= WS_SHIN && WS_GS + 4 * 17 * 1024 * 4 <= WS_W, "ws map");

constexpr int RING_BYTES = 131072, MISC_OFF = RING_BYTES + 320, LDS_BYTES = 151552;

#define GAS __attribute__((address_space(1)))
#define LAS __attribute__((address_space(3)))
typedef unsigned short bf16;
typedef unsigned v4u __attribute__((ext_vector_type(4)));
typedef unsigned v2u __attribute__((ext_vector_type(2)));
typedef float f32x4 __attribute__((ext_vector_type(4)));
typedef float f32x2 __attribute__((ext_vector_type(2)));
#define LDS_WAIT() asm volatile("s_waitcnt lgkmcnt(0)" ::: "memory")
__device__ __forceinline__ unsigned f2bf(float f) { unsigned u = __builtin_bit_cast(unsigned, f); return (u + 0x7fffu + ((u >> 16) & 1u)) >> 16; }
__device__ __forceinline__ unsigned pk2(float lo, float hi) { return f2bf(lo) | (f2bf(hi) << 16); }
__device__ __forceinline__ float bf2f(unsigned short b) { return __builtin_bit_cast(float, (unsigned)b << 16); }
__device__ __forceinline__ float bflo(unsigned w) { return __builtin_bit_cast(float, w << 16); }
__device__ __forceinline__ float bfhi(unsigned w) { return __builtin_bit_cast(float, w & 0xffff0000u); }
__device__ __forceinline__ float fsigmoid(float x) { return __builtin_amdgcn_rcpf(1.0f + __expf(-x)); }
__device__ __forceinline__ float wave_sum(float v) {
#pragma unroll
    for (int o = 1; o < 64; o <<= 1) v += __shfl_xor(v, o);
    return v;
}
__device__ __forceinline__ int modrow_of(int row) { return row < ML ? (row >> 11) : 16; }
#define XB_TMO      128
#define XB_XCNT(j)  (256  + 64 * (j))
#define XB_XSUB(j)  (1280 + 64 * (j))
#define XB_XGEN(j)  (2304 + 64 * (j))
#define XB_TOP      3328
#define XB_TOPGEN   3392
#define XCD_BAR_WORDS 3456
#define XB_SPIN_CAP (1u << 18)

__device__ __forceinline__ unsigned xb_ld(unsigned* p)              { return __hip_atomic_load(p, __ATOMIC_RELAXED, __HIP_MEMORY_SCOPE_AGENT); }
__device__ __forceinline__ unsigned xb_add(unsigned* p, unsigned v) { return __hip_atomic_fetch_add(p, v, __ATOMIC_RELAXED, __HIP_MEMORY_SCOPE_AGENT); }
__device__ __forceinline__ unsigned xb_xcc_id() { return (unsigned)__builtin_amdgcn_s_getreg((3 << 11) | 20) & 0xFu; }
#define XB_SPIN(cond, bar) do { unsigned _sp = 0; while (cond) { __builtin_amdgcn_s_sleep(1); \
    if ((++_sp & 255u) == 0u) { if (xb_ld(&(bar)[XB_TMO])) break; if (_sp > XB_SPIN_CAP) { atomicAdd(&(bar)[XB_TMO], 1u); break; } } } } while (0)

struct XcdBarrier {
    unsigned* bar; unsigned x;
    volatile LAS unsigned* st;
};

__device__ __forceinline__ XcdBarrier xcd_barrier_post(unsigned* bar, volatile LAS unsigned* st) {
    XcdBarrier b; b.bar = bar; b.x = xb_xcc_id(); b.st = st;
    if (threadIdx.x == 0) (void)xb_add(&bar[XB_XCNT(b.x)], 1u);
    return b;
}
__device__ __forceinline__ void xcd_barrier_complete(unsigned* bar, unsigned x, unsigned& nloc, unsigned& nx) {
    const unsigned G = gridDim.x * gridDim.y * gridDim.z;
    unsigned sum, cnt, mine, sp = 0u;
    for (;;) {
        sum = 0u; cnt = 0u; mine = 0u;
#pragma unroll
        for (unsigned j = 0; j < 16; ++j) { const unsigned c = xb_ld(&bar[XB_XCNT(j)]); sum += c; cnt += (c > 0u) ? 1u : 0u; mine = (j == x) ? c : mine; }
        if (sum == G) break;
        __builtin_amdgcn_s_sleep(1);
        if ((++sp & 255u) == 0u) { if (xb_ld(&bar[XB_TMO])) break; if (sp > XB_SPIN_CAP) { atomicAdd(&bar[XB_TMO], 1u); break; } }
    }
    nloc = mine > 0u ? mine : 1u; nx = cnt > 0u ? cnt : 1u;
}

__device__ __forceinline__ void xcd_barrier(const XcdBarrier& b) {
    asm volatile("s_waitcnt vmcnt(0)" ::: "memory");
    __syncthreads();
    if (threadIdx.x == 0) {
        unsigned* bar = b.bar;
        __builtin_amdgcn_s_waitcnt(0);
        unsigned nloc = b.st[0], nx = b.st[1];
        if (nloc == 0u) { xcd_barrier_complete(bar, b.x, nloc, nx); b.st[0] = nloc; b.st[1] = nx; }
        const unsigned old = xb_add(&bar[XB_XSUB(b.x)], 1u);
        const unsigned gen = old / nloc;
        if (old + 1u == (gen + 1u) * nloc) {
            __builtin_amdgcn_fence(__ATOMIC_RELEASE, "agent");
            asm volatile("s_waitcnt vmcnt(0)" ::: "memory");
            const unsigned og = xb_add(&bar[XB_TOP], 1u);
            const unsigned tg = og / nx;
            if (og + 1u == (tg + 1u) * nx) xb_add(&bar[XB_TOPGEN], 1u);
            else XB_SPIN(xb_ld(&bar[XB_TOPGEN]) == tg, bar);
            __builtin_amdgcn_fence(__ATOMIC_ACQUIRE, "agent");
            xb_add(&bar[XB_XGEN(b.x)], 1u);
            asm volatile("s_waitcnt vmcnt(0)" ::: "memory");
        } else {
            XB_SPIN(xb_ld(&bar[XB_XGEN(b.x)]) == gen, bar);
            __builtin_amdgcn_fence(__ATOMIC_ACQUIRE, "agent");
            asm volatile("s_waitcnt vmcnt(0)" ::: "memory");
        }
    }
    __syncthreads();
}

struct Args { const float* in[23]; float* out; unsigned char* ws; int ph_lo, ph_hi; };
enum { I_X = 0, I_C, I_CTX, I_CCTX, I_WMOD, I_BMOD, I_N1G, I_WIN, I_BIN, I_MG, I_SLG, I_SLB, I_SW, I_SB, I_CW, I_CB, I_CLG, I_CLB, I_WOUT, I_N2G, I_WGU, I_WDOWN, I_FG };

__device__ __forceinline__ int win_src_col(int n) {
    if (n < 2048) return n;
    if (n < 2560) return n + 16;
    if (n < 3072) { const int j = n - 2560, tile = j >> 8, jj = j & 255; return 2576 + (jj >> 7) * 256 + tile * 128 + (jj & 127); }
    if (n < 3088) return 2048 + (n - 3072);
    return -1;
}
__device__ __forceinline__ int wgu_src_col(int n) { const int tile = n >> 8, jj = n & 255; return (jj >> 7) * FF + tile * 128 + (jj & 127); }

__device__ __forceinline__ void transpose_item(const float* W, int K, int Nsrc, bf16* WT, int n0, int srcc0, int nvalid, int k0, LAS float* scr, int lane) {
    const int c4 = (lane & 7) * 4, r8 = lane >> 3;
    f32x4 v[8];
#pragma unroll
    for (int i = 0; i < 8; ++i) { v[i] = (f32x4){0.f, 0.f, 0.f, 0.f}; if (srcc0 >= 0 && c4 < nvalid) v[i] = *(const f32x4*)(W + (size_t)(k0 + 8 * i + r8) * Nsrc + srcc0 + c4); }
#pragma unroll
    for (int i = 0; i < 8; ++i) { LAS float* d = scr + (8 * i + r8) * 33 + c4; d[0] = v[i].x; d[1] = v[i].y; d[2] = v[i].z; d[3] = v[i].w; }
    LDS_WAIT(); asm volatile("" ::: "memory");
    const int c8 = lane & 7;
#pragma unroll
    for (int j = 0; j < 4; ++j) { const int n = (lane >> 3) + 8 * j; const LAS float* s = scr + (8 * c8) * 33 + n;
        v4u o; o.x = pk2(s[0 * 33], s[1 * 33]); o.y = pk2(s[2 * 33], s[3 * 33]); o.z = pk2(s[4 * 33], s[5 * 33]); o.w = pk2(s[6 * 33], s[7 * 33]);
        *(v4u*)(WT + (size_t)(n0 + n) * K + k0 + 8 * c8) = o; }
    LDS_WAIT(); asm volatile("" ::: "memory");
}

template <int NB>
__device__ __forceinline__ void gemv17_cols(const LAS float* SL, LAS float* RED, const float* W, int N, int j0, int tid) {
    const int lane = tid & 63, wave = __builtin_amdgcn_readfirstlane(tid >> 6);
    const int j = j0 + lane; const bool ok = j < N;
    float acc[17];
#pragma unroll
    for (int r = 0; r < 17; ++r) acc[r] = 0.f;
    const float* wp = W + (size_t)(wave * 128) * N + (ok ? j : 0);
    const LAS float* sp = SL + wave * 128 * 20;
#pragma unroll 1
    for (int k0 = 0; k0 < 128; k0 += NB) {
    float wv[NB];
#pragma unroll
    for (int kk = 0; kk < NB; ++kk) wv[kk] = ok ? wp[(size_t)(k0 + kk) * N] : 0.f;
#pragma unroll
    for (int kk = 0; kk < NB; ++kk) { const int k = k0 + kk; const float w = wv[kk];
        const LAS f32x4* s4 = (const LAS f32x4*)(sp + k * 20);
        const f32x4 a = s4[0], b = s4[1], c = s4[2], d = s4[3]; const float e = sp[k * 20 + 16];
        acc[0] += a.x * w; acc[1] += a.y * w; acc[2] += a.z * w; acc[3] += a.w * w; acc[4] += b.x * w; acc[5] += b.y * w; acc[6] += b.z * w; acc[7] += b.w * w;
        acc[8] += c.x * w; acc[9] += c.y * w; acc[10] += c.z * w; acc[11] += c.w * w; acc[12] += d.x * w; acc[13] += d.y * w; acc[14] += d.z * w; acc[15] += d.w * w; acc[16] += e * w; }
    }
#pragma unroll
    for (int r = 0; r < 17; ++r) RED[(wave * 17 + r) * 64 + lane] = acc[r];
}
__device__ __forceinline__ float gemv17_sum(const LAS float* RED, int e) {
    float s = 0.f;
#pragma unroll
    for (int w = 0; w < 8; ++w) s += RED[w * 17 * 64 + e];
    return s;
}

constexpr int TI_IN = 16 * (NIN / 32), TI_OUT = 16 * 32, TI_GU = 16 * (NGU / 32), TI_DN = (FF / 64) * 32, TI_LAYER = TI_IN + TI_OUT + TI_GU + TI_DN;
__device__ __forceinline__ void transpose_range(const Args& a, LAS unsigned char* lds, int first, int count, int wi, int nw, int lane, int wave) {
    unsigned char* ws = a.ws;
    LAS float* scr = (LAS float*)(lds + wave * 16384);
    for (int it = first + wi; it < first + count; it += nw) {
        const int l = it / TI_LAYER; int r = it % TI_LAYER;
        unsigned char* wl = ws + WS_W + (size_t)l * W_LAYER;
        if (r < TI_IN) { const int kb = r / (NIN / 32), nb = r % (NIN / 32), n0 = nb * 32, sc = win_src_col(n0);
            transpose_item(a.in[I_WIN] + (size_t)l * D * NIN_O, D, NIN_O, (bf16*)(wl + WO_IN), n0, sc, n0 == 3072 ? 16 : 32, kb * 64, scr, lane); continue; }
        r -= TI_IN;
        if (r < TI_OUT) { const int kb = r / 32, nb = r % 32;
            transpose_item(a.in[I_WOUT] + (size_t)l * D * D, D, D, (bf16*)(wl + WO_OUT), nb * 32, nb * 32, 32, kb * 64, scr, lane); continue; }
        r -= TI_OUT;
        if (r < TI_GU) { const int kb = r / (NGU / 32), nb = r % (NGU / 32), n0 = nb * 32;
            transpose_item(a.in[I_WGU] + (size_t)l * D * NGU, D, NGU, (bf16*)(wl + WO_GU), n0, wgu_src_col(n0), 32, kb * 64, scr, lane); continue; }
        r -= TI_GU;
        { const int kb = r / 32, nb = r % 32;
            transpose_item(a.in[I_WDOWN] + (size_t)l * FF * D, FF, D, (bf16*)(wl + WO_DOWN), nb * 32, nb * 32, 32, kb * 64, scr, lane); }
    }
}
__device__ __forceinline__ void phase_prologue(const Args& a, LAS unsigned char* lds, int G, int tid, int lane, int wave) {
    unsigned char* ws = a.ws;
    transpose_range(a, lds, 0, G == 256 ? TI_IN : 2 * TI_LAYER, blockIdx.x * NWAVES + wave, G * NWAVES, lane, wave);
    for (int e = blockIdx.x * NTHREADS + tid; e < 2 * NIN; e += G * NTHREADS) { const int l = e / NIN, n = e % NIN, s = win_src_col(n);
        ((float*)(ws + WS_BIN))[e] = s >= 0 ? a.in[I_BIN][l * NIN_O + s] : 0.f; }
    for (int e = blockIdx.x * NTHREADS + tid; e < 2 * 4 * 128 * 128; e += G * NTHREADS) ((bf16*)(ws + WS_SWB))[e] = (bf16)f2bf(a.in[I_SW][e]);
    __syncthreads();
    asm volatile("" : "+v"(tid));
    LAS float* SL = (LAS float*)lds; LAS float* RED = SL + 1024 * 20;
    float* MOD = (float*)(ws + WS_MOD);
    bool filled = false;
    for (int it = blockIdx.x; it < 2 * 96; it += G) {
        const int l = it / 96, j0 = (it % 96) * 64;
        if (!filled) {
#pragma unroll 2
            for (int e = tid; e < 17 * 1024; e += NTHREADS) { const int r = e >> 10, k = e & 1023; const float cv = r < 16 ? a.in[I_C][r * D + k] : a.in[I_CCTX][k]; SL[k * 20 + r] = cv * fsigmoid(cv); } filled = true; }
        __syncthreads();
        gemv17_cols<16>(SL, RED, a.in[I_WMOD] + (size_t)l * D * MODW, MODW, j0, tid);
        __syncthreads();
        for (int e = tid; e < 17 * 64; e += NTHREADS) { const int r = e >> 6, j = j0 + (e & 63); MOD[(size_t)(l * 17 + r) * MODW + j] = gemv17_sum(RED, e) + a.in[I_BMOD][l * MODW + j]; }
    }
    __syncthreads();
}

__device__ __forceinline__ int wgu_dst_col(int c) { const int half = c >= FF ? 1 : 0, cc = c - half * FF; return (cc >> 7) * 256 + half * 128 + (cc & 127); }
__device__ __forceinline__ int win_dst_col(int c) {
    if (c < 2048) return c;
    if (c < 2064) return 3072 + (c - 2048);
    if (c < 2576) return c - 16;
    const int cc = c - 2576, half = cc >> 8, w = cc & 255; return 2560 + (w >> 7) * 256 + half * 128 + (w & 127);
}
__device__ __forceinline__ void phase_shifts(const Args& a, LAS unsigned char* lds, int G, int tid) {
    unsigned char* ws = a.ws; const float* MOD = (const float*)(ws + WS_MOD);
    for (int e = blockIdx.x * NTHREADS + tid; e < 2 * 2 * 17 * 1024; e += G * NTHREADS) { const int l = e / (2 * 17 * 1024), w = (e / (17 * 1024)) & 1, r = (e >> 10) % 17, c = e & 1023;
        ((float*)(ws + WS_GS))[e] = (w ? a.in[I_N2G] : a.in[I_N1G])[l * D + c] * (1.0f + MOD[(size_t)(l * 17 + r) * MODW + (w ? 4 : 1) * D + c]); }
    LAS float* SL = (LAS float*)lds; LAS float* RED = SL + 1024 * 20;
    for (int it = blockIdx.x; it < 176 + 49; it += G) {
        const bool gu = it < 176; const int l = gu ? it / 88 : 1, j0 = gu ? (it % 88) * 64 : (it - 176) * 64;
        const int shoff = gu ? 3 * D : 0, Nsrc = gu ? NGU : NIN_O;
        __syncthreads();
#pragma unroll 4
        for (int e = tid; e < 17 * 1024; e += NTHREADS) { const int r = e >> 10, k = e & 1023; SL[k * 20 + r] = MOD[(size_t)(l * 17 + r) * MODW + shoff + k]; }
        __syncthreads();
        gemv17_cols<16>(SL, RED, gu ? a.in[I_WGU] + (size_t)l * D * NGU : a.in[I_WIN] + (size_t)D * NIN_O, Nsrc, j0, tid);
        __syncthreads();
        for (int e = tid; e < 17 * 64; e += NTHREADS) { const int r = e >> 6, j = j0 + (e & 63);
            if (j < Nsrc) { const float v = gemv17_sum(RED, e);
                if (gu) ((float*)(ws + WS_SHGU))[(size_t)(l * 17 + r) * NGU + wgu_dst_col(j)] = v;
                else ((float*)(ws + WS_SHIN))[(size_t)r * NIN + win_dst_col(j)] = v + a.in[I_BIN][NIN_O + j]; } }
    }
    __syncthreads();
}

__device__ __forceinline__ void phase_norm(const float* xl, const float* xc, bf16* A, const float* g, const float* mod, int sh_off, int nrows, int G, int lane, int wave) {
    const int gw = blockIdx.x * NWAVES + wave, NGW = G * NWAVES;
    for (int r = gw; r < nrows; r += NGW) {
        const float* xr = r < ML ? xl + (size_t)r * D : xc + (size_t)(r - ML) * D;
        const float* mr = mod + (size_t)modrow_of(r) * MODW + sh_off;
        f32x4 v[4]; float s = 0.f;
#pragma unroll
        for (int j = 0; j < 4; ++j) { v[j] = ((const f32x4*)xr)[lane + 64 * j]; s += (v[j].x * v[j].x + v[j].y * v[j].y) + (v[j].z * v[j].z + v[j].w * v[j].w); }
        const float rstd = 1.0f / sqrtf(wave_sum(s) * (1.0f / D) + EPS);
        unsigned long long* o8 = (unsigned long long*)(A + (size_t)r * D) + lane;
#pragma unroll
        for (int j = 0; j < 4; ++j) { const int c = (lane + 64 * j) * 4;
            const f32x4 gg = *(const f32x4*)(g + c), sh = *(const f32x4*)(mr + c), sc = *(const f32x4*)(mr + D + c);
            const f32x4 y = v[j] * rstd * gg * (1.0f + sc) + sh;
            o8[64 * j] = (unsigned long long)pk2(y.x, y.y) | ((unsigned long long)pk2(y.z, y.w) << 32); }
    }
}

__device__ __forceinline__ void phase_final(float* x, const float* g, int G, int lane, int wave) {
    const int gw = blockIdx.x * NWAVES + wave, NGW = G * NWAVES;
    for (int r = gw; r < ML; r += NGW) {
        float* xr = x + (size_t)r * D;
        f32x4 v[4]; float s = 0.f;
#pragma unroll
        for (int j = 0; j < 4; ++j) { v[j] = ((const f32x4*)xr)[lane + 64 * j]; s += (v[j].x * v[j].x + v[j].y * v[j].y) + (v[j].z * v[j].z + v[j].w * v[j].w); }
        const float rstd = 1.0f / sqrtf(wave_sum(s) * (1.0f / D) + EPS);
#pragma unroll
        for (int j = 0; j < 4; ++j) { const f32x4 gg = ((const f32x4*)g)[lane + 64 * j]; ((f32x4*)xr)[lane + 64 * j] = v[j] * rstd * gg; }
    }
}

constexpr int TB = 16;
__device__ __forceinline__ void mlstm_scan_item(const bf16* Q, const bf16* K, const bf16* V, const float* GT, float* HS0, float* HS1, int item, bool ctx_out, LAS unsigned char* lds, int tid) {
    const int b = item >> 3, h = (item >> 1) & 3, dir = item & 1;
    const int dv = tid & 127, kq = tid >> 7;
    LAS float* kbuf = (LAS float*)lds;
    LAS float* vbuf = kbuf + TB * 128;
    LAS float* qbuf = vbuf + TB * 128;
    LAS float* ibuf = qbuf + TB * 128;
    LAS float* fbuf = ibuf + TB;
    LAS float* red = fbuf + TB;
    LAS float* redd = red + 2 * 4 * 128;
    float* HS = dir ? HS1 : HS0;
    float C[32], nn[32];
#pragma unroll
    for (int j = 0; j < 32; ++j) { C[j] = 0.f; nn[j] = 0.f; }
    float m = 0.f; int par = 0;
    for (int s0 = 0; s0 < CTXL + SEQ; s0 += TB) {
        const bool isctx = s0 < CTXL; const int len = isctx ? CTXL : SEQ, i0 = isctx ? s0 : s0 - CTXL;
        const int rbase = isctx ? ML + b * CTXL : b * SEQ;
        for (int e = tid; e < TB * 384; e += NTHREADS) { const int tok = e / 384, c = e % 384, which = c >> 7, d = c & 127;
            const int t = dir ? (len - 1 - (i0 + tok)) : (i0 + tok); const size_t off = (size_t)(rbase + t) * HW + h * 128 + d;
            const bf16* src = which == 0 ? K : which == 1 ? V : Q;
            (which == 0 ? kbuf : which == 1 ? vbuf : qbuf)[tok * 128 + d] = bf2f(src[off]); }
        if (tid < TB) { const int t = dir ? (len - 1 - (i0 + tid)) : (i0 + tid); const float* gp = GT + (size_t)(rbase + t) * 16 + dir * 8 + h;
            const float iv = gp[0], fv = gp[4];
            ibuf[tid] = iv; fbuf[tid] = fminf(fv, 0.f) - log1pf(__expf(-fabsf(fv))); }
        __syncthreads();
        const bool wr_out = !isctx || ctx_out;
        for (int tok = 0; tok < TB; ++tok) {
            const float it = ibuf[tok], lf = fbuf[tok];
            const float mn = fmaxf(lf + m, it), aa = __expf(lf + m - mn), bc = __expf(it - mn); m = mn;
            const float vv = vbuf[tok * 128 + dv] * bc;
            float part = 0.f, dpart = 0.f;
            const LAS float* kp = kbuf + tok * 128 + kq * 32; const LAS float* qp = qbuf + tok * 128 + kq * 32;
#pragma unroll
            for (int j = 0; j < 32; ++j) { const float kk = kp[j], qq = qp[j];
                C[j] = aa * C[j] + kk * vv; part += C[j] * qq;
                nn[j] = aa * nn[j] + bc * kk; dpart += nn[j] * qq; }
            red[(par * 4 + kq) * 128 + dv] = part; if (dv == 0) redd[par * 4 + kq] = dpart;
            __syncthreads();
            if (tid < 128 && wr_out) {
                const float num = (red[(par * 4 + 0) * 128 + tid] + red[(par * 4 + 1) * 128 + tid]) + (red[(par * 4 + 2) * 128 + tid] + red[(par * 4 + 3) * 128 + tid]);
                const float den = (redd[par * 4 + 0] + redd[par * 4 + 1]) + (redd[par * 4 + 2] + redd[par * 4 + 3]);
                const int t = dir ? (len - 1 - (i0 + tok)) : (i0 + tok);
                HS[(size_t)(rbase + t) * HW + h * 128 + tid] = num / fmaxf(fabsf(den), __expf(-m));
            }
            par ^= 1;
        }
    }
    __syncthreads();
}

__device__ __forceinline__ void phase_mlstm_post(const float* HS0, const float* HS1, const bf16* OG, const float* mg, bf16* Y, int nrows, int G, int lane, int wave) {
    const int gw = blockIdx.x * NWAVES + wave, NGW = G * NWAVES;
    for (int r = gw; r < nrows; r += NGW) {
        const size_t off = (size_t)r * HW + lane * 8;
        const f32x4 a0 = *(const f32x4*)(HS0 + off), a1 = *(const f32x4*)(HS0 + off + 4), b0 = *(const f32x4*)(HS1 + off), b1 = *(const f32x4*)(HS1 + off + 4);
        const f32x4 h0 = a0 + b0, h1 = a1 + b1;
        float s = (h0.x * h0.x + h0.y * h0.y) + (h0.z * h0.z + h0.w * h0.w) + (h1.x * h1.x + h1.y * h1.y) + (h1.z * h1.z + h1.w * h1.w);
        s += __shfl_xor(s, 1); s += __shfl_xor(s, 2); s += __shfl_xor(s, 4); s += __shfl_xor(s, 8);
        const float rs = 1.0f / sqrtf(s * (1.0f / 128.0f) + EPS);
        const v4u og = *(const v4u*)(OG + off);
        const f32x4 g0 = *(const f32x4*)(mg + lane * 8), g1 = *(const f32x4*)(mg + lane * 8 + 4);
        v4u o;
        o.x = pk2(h0.x * rs * g0.x * bflo(og.x), h0.y * rs * g0.y * bfhi(og.x)); o.y = pk2(h0.z * rs * g0.z * bflo(og.y), h0.w * rs * g0.w * bfhi(og.y));
        o.z = pk2(h1.x * rs * g1.x * bflo(og.z), h1.y * rs * g1.y * bfhi(og.z)); o.w = pk2(h1.z * rs * g1.z * bflo(og.w), h1.w * rs * g1.w * bfhi(og.w));
        *(v4u*)(Y + (size_t)r * D + lane * 8) = o;
    }
}

__device__ __forceinline__ void sgu_item(const bf16* Z, const float* lg, const float* lb, const float* sw, const float* sb, bf16* Y, int chunk, LAS unsigned char* lds, int tid, int lane, int wave) {
    LAS float* vn = (LAS float*)lds;
    const int row0 = chunk * 128;
    for (int t = wave; t < 128; t += NWAVES) {
        const v2u raw = *(const v2u*)(Z + (size_t)(row0 + t) * 512 + 256 + lane * 4);
        const float x0 = bflo(raw.x), x1 = bfhi(raw.x), x2 = bflo(raw.y), x3 = bfhi(raw.y);
        const float mu = wave_sum((x0 + x1) + (x2 + x3)) * (1.0f / 256.0f);
        const float d0 = x0 - mu, d1 = x1 - mu, d2 = x2 - mu, d3 = x3 - mu;
        const float var = wave_sum((d0 * d0 + d1 * d1) + (d2 * d2 + d3 * d3)) * (1.0f / 256.0f);
        const float rs = 1.0f / sqrtf(var + EPS);
        const f32x4 g = *(const f32x4*)(lg + lane * 4), bb = *(const f32x4*)(lb + lane * 4);
        *(LAS f32x4*)(vn + t * 256 + lane * 4) = (f32x4){d0 * rs * g.x + bb.x, d1 * rs * g.y + bb.y, d2 * rs * g.z + bb.z, d3 * rs * g.w + bb.w};
    }
    __syncthreads();
    const int ch = tid & 255, ph = tid >> 8, g = __builtin_amdgcn_readfirstlane(ch >> 6);
    const float* wg = sw + (size_t)g * 128 * 128; const float* bg = sb + g * 128;
    for (int p = ph * 64; p < ph * 64 + 64; ++p) {
        const float* wr = wg + p * 128; float acc = 0.f;
#pragma unroll 8
        for (int q = 0; q < 128; ++q) acc += wr[q] * vn[q * 256 + ch];
        const float u = bf2f(Z[(size_t)(row0 + p) * 512 + ch]);
        Y[(size_t)(row0 + p) * D + 512 + ch] = (bf16)f2bf(u * (acc + bg[p]));
    }
    __syncthreads();
}

__device__ __forceinline__ void conv_rows(const bf16* YC, const float* cw, const float* cb, const float* lg, const float* lb, bf16* Y, int row0, int nrows, int lane, int wave) {
    const int c0 = lane * 4;
    for (int rr = wave; rr < nrows; rr += NWAVES) {
        const int r = row0 + rr;
        f32x4 acc = *(const f32x4*)(cb + c0);
        int base, pos, len, stride;
        if (r < ML) { const int b = r >> 11, t = r & 2047;
            if (lane < 32) { base = (b << 11) + (t & ~63); pos = t & 63; len = 64; stride = 1; }
            else           { base = (b << 11) + (t & 63); pos = t >> 6; len = 32; stride = 64; } }
        else { const int rc = r - ML; base = ML + (rc & ~255); pos = rc & 255; len = 256; stride = 1; }
#pragma unroll 1
        for (int k = 0; k < 31; ++k) { const int p = pos + k - 15;
            if (p >= 0 && p < len) { const v2u raw = *(const v2u*)(YC + (size_t)(base + p * stride) * 256 + c0); const f32x4 w = *(const f32x4*)(cw + k * 256 + c0);
                acc.x += w.x * bflo(raw.x); acc.y += w.y * bfhi(raw.x); acc.z += w.z * bflo(raw.y); acc.w += w.w * bfhi(raw.y); } }
        const float mu = wave_sum((acc.x + acc.y) + (acc.z + acc.w)) * (1.0f / 256.0f);
        const float d0 = acc.x - mu, d1 = acc.y - mu, d2 = acc.z - mu, d3 = acc.w - mu;
        const float var = wave_sum((d0 * d0 + d1 * d1) + (d2 * d2 + d3 * d3)) * (1.0f / 256.0f);
        const float rs = 1.0f / sqrtf(var + EPS);
        const f32x4 g = *(const f32x4*)(lg + c0), bb = *(const f32x4*)(lb + c0);
        float y0 = d0 * rs * g.x + bb.x, y1 = d1 * rs * g.y + bb.y, y2 = d2 * rs * g.z + bb.z, y3 = d3 * rs * g.w + bb.w;
        y0 *= fsigmoid(y0); y1 *= fsigmoid(y1); y2 *= fsigmoid(y2); y3 *= fsigmoid(y3);
        v2u o; o.x = pk2(y0, y1); o.y = pk2(y2, y3);
        *(v2u*)(Y + (size_t)r * D + 768 + c0) = o;
    }
}
typedef short bf16x8_t __attribute__((ext_vector_type(8)));
typedef short s16x4_t __attribute__((ext_vector_type(4)));
typedef short v4i16_t __attribute__((ext_vector_type(4)));
typedef float f32x16 __attribute__((ext_vector_type(16)));
typedef __bf16 bf16x2_t __attribute__((ext_vector_type(2)));
__device__ __forceinline__ unsigned cvtpk(float lo, float hi) { f32x2 v = {lo, hi}; bf16x2_t b = __builtin_convertvector(v, bf16x2_t); return __builtin_bit_cast(unsigned, b); }
__device__ __forceinline__ s16x4_t tr16(const LAS unsigned char* p) { return __builtin_bit_cast(s16x4_t, __builtin_amdgcn_ds_read_tr16_b64_v4i16((LAS v4i16_t*)p)); }
__device__ __forceinline__ bf16x8_t cat8(s16x4_t lo, s16x4_t hi) { return __builtin_shufflevector(lo, hi, 0, 1, 2, 3, 4, 5, 6, 7); }
#define MFMA32(a, b, c) __builtin_amdgcn_mfma_f32_32x32x16_bf16((a), (b), (c), 0, 0, 0)
__device__ __forceinline__ int crow(int reg, int hh) { return (reg & 3) + 8 * (reg >> 2) + 4 * hh; }
__device__ __forceinline__ int chunk_row0(int b, int a) { return a < 2 ? ML + b * CTXL + a * 128 : b * SEQ + (a - 2) * 128; }
__device__ __forceinline__ int chunk_of_step(int j, int dir) { return dir == 0 ? j : (j == 0 ? 1 : (j == 1 ? 0 : 19 - j)); }
__device__ __forceinline__ float log_sigmoid(float x) { return fminf(x, 0.f) - log1pf(__expf(-fabsf(x))); }
__device__ __forceinline__ float lane_get(float x, int src_lane) { return __builtin_bit_cast(float, __builtin_amdgcn_ds_bpermute(src_lane << 2, __builtin_bit_cast(int, x))); }
__device__ __forceinline__ float wave_incl_add(float x, int lane) {
#pragma unroll
    for (int o = 1; o < 64; o <<= 1) { const float y = lane_get(x, lane - o); if (lane >= o) x += y; }
    return x;
}
__device__ __forceinline__ float wave_incl_max(float x, int lane) {
#pragma unroll
    for (int o = 1; o < 64; o <<= 1) { const float y = lane_get(x, lane - o); if (lane >= o) x = fmaxf(x, y); }
    return x;
}
__device__ __forceinline__ float wave_max(float v, int lane) {
#pragma unroll
    for (int o = 1; o < 64; o <<= 1) v = fmaxf(v, lane_get(v, lane ^ o));
    return v;
}
__device__ __forceinline__ v4u scale8(const v4u& w, float s) {
    v4u o; o.x = cvtpk(bflo(w.x) * s, bfhi(w.x) * s); o.y = cvtpk(bflo(w.y) * s, bfhi(w.y) * s); o.z = cvtpk(bflo(w.z) * s, bfhi(w.z) * s); o.w = cvtpk(bflo(w.w) * s, bfhi(w.w) * s); return o;
}
constexpr int MX_OFF = RING_BYTES + 1024;

#define dpp_f(x, ctrl) __builtin_bit_cast(float, __builtin_amdgcn_update_dpp(0, __builtin_bit_cast(int, (float)(x)), (ctrl), 0xf, 0xf, false))
#define ROW_SUM16(x) do { x += dpp_f(x, 0x121); x += dpp_f(x, 0x122); x += dpp_f(x, 0x124); x += dpp_f(x, 0x128); } while (0)
__device__ __forceinline__ int swz_off(int row, int chunk) { return row * 256 + 16 * (chunk ^ (((row & 3) << 2) | ((row >> 2) & 3))); }

#define LDS_BARRIER() do { asm volatile("s_waitcnt lgkmcnt(0)" ::: "memory"); __builtin_amdgcn_s_barrier(); asm volatile("" ::: "memory"); } while (0)
#define ST_LOAD(kr, vr, jj) do { const int row0_ = chunk_row0(b, chunk_of_step((jj), dir)); \
        _Pragma("unroll") for (int i = 0; i < 4; ++i) { const int pc = tid + NTHREADS * i; kr[i] = *(const v4u*)(K + (size_t)(row0_ + (pc >> 4)) * HW + h * 128 + (pc & 15) * 8); } \
        _Pragma("unroll") for (int i = 0; i < 2; ++i) { const int pc = tid + NTHREADS * i; vr[i] = *(const v4u*)(V + (size_t)(row0_ + (pc >> 3)) * HW + h * 128 + dvh * 64 + (pc & 7) * 8); } } while (0)
#define ST_WRITE(kr, vr, jj) do { LAS unsigned char* Kn = Kimg + ((jj) & 1) * 32768; LAS unsigned char* Vn = Vimg + ((jj) & 1) * 16384; \
        _Pragma("unroll") for (int i = 0; i < 4; ++i) { const int pc = tid + NTHREADS * i; *(LAS v4u*)(Kn + pc * 16) = kr[i]; } \
        _Pragma("unroll") for (int i = 0; i < 2; ++i) { const int pc = tid + NTHREADS * i, s_ = pc >> 3; *(LAS v4u*)(Vn + pc * 16) = scale8(vr[i], kpn[(jj) * 128 + s_]); } } while (0)
#define ST_STEP(j, krL, vrL, krW, vrW) do { \
        LDS_BARRIER(); \
        const int a = chunk_of_step((j), dir); \
        if ((j) + 2 < 18) ST_LOAD(krL, vrL, (j) + 2); \
        if (a >= 2 || store_ctx) { \
            bf16* cp = CT + ((size_t)(seq * 18 + a) * 128 + dvh * 64 + dvt * 32 + r) * 128 + dkt * 32 + 4 * hh; \
            _Pragma("unroll") for (int g = 0; g < 4; ++g) { v2u o; o.x = cvtpk(acc[4 * g], acc[4 * g + 1]); o.y = cvtpk(acc[4 * g + 2], acc[4 * g + 3]); *(v2u*)(cp + 8 * g) = o; } \
            if (dvh == 0 && dvt == 0) NS[(size_t)(seq * 18 + a) * 256 + hh * 128 + dkt * 32 + r] = nn; } \
        const float delta = cs[64 + (j)]; \
        _Pragma("unroll") for (int i = 0; i < 16; ++i) acc[i] *= delta; \
        const LAS unsigned char* Kb = Kimg + ((j) & 1) * 32768; const LAS unsigned char* Vb = Vimg + ((j) & 1) * 16384; \
        bf16x8_t Af[8], Bf[8]; \
        _Pragma("unroll") for (int ks = 0; ks < 8; ++ks) { \
            const LAS unsigned char* ka = Kb + (16 * ks + 8 * hh + q) * 256 + 2 * (32 * dkt + 16 * blk + 4 * p); \
            const LAS unsigned char* va = Vb + (16 * ks + 8 * hh + q) * 128 + 2 * (32 * dvt + 16 * blk + 4 * p); \
            Af[ks] = cat8(tr16(ka), tr16(ka + 4 * 256)); Bf[ks] = cat8(tr16(va), tr16(va + 4 * 128)); } \
        f32x16 acc2; _Pragma("unroll") for (int i = 0; i < 16; ++i) acc2[i] = 0.f; \
        _Pragma("unroll") for (int ks = 0; ks < 8; ks += 2) { acc = MFMA32(Af[ks], Bf[ks], acc); acc2 = MFMA32(Af[ks + 1], Bf[ks + 1], acc2); } \
        if (dvh == 0 && dvt == 0) { float s_ = 0.f;        \
            _Pragma("unroll") for (int ks = 0; ks < 8; ++ks) { const LAS f32x4* kp4 = (const LAS f32x4*)(kpn + (j) * 128 + 16 * ks + 8 * hh); const f32x4 k0 = kp4[0], k1 = kp4[1]; \
                s_ += k0.x * bf2f((unsigned short)Af[ks][0]) + k0.y * bf2f((unsigned short)Af[ks][1]) + k0.z * bf2f((unsigned short)Af[ks][2]) + k0.w * bf2f((unsigned short)Af[ks][3]) \
                    + k1.x * bf2f((unsigned short)Af[ks][4]) + k1.y * bf2f((unsigned short)Af[ks][5]) + k1.z * bf2f((unsigned short)Af[ks][6]) + k1.w * bf2f((unsigned short)Af[ks][7]); } \
            nn = delta * nn + s_; } \
        _Pragma("unroll") for (int i = 0; i < 16; ++i) acc[i] += acc2[i]; \
        if ((j) + 1 < 18) ST_WRITE(krW, vrW, (j) + 1); \
    } while (0)
__device__ __forceinline__ void mlstm_state_item(const bf16* K, const bf16* V, const float* GT, bf16* CT, float* NS, float* TAB, int item, bool store_ctx, LAS unsigned char* lds, int tid) {
    asm volatile("" : "+v"(tid));
    const int lane = tid & 63, wave = __builtin_amdgcn_readfirstlane(tid >> 6);
    const int dvh = item & 1, dir = (item >> 1) & 1, h = (item >> 2) & 3, b = item >> 4;
    const int seq = (b * 4 + h) * 2 + dir;
    LAS unsigned char* Kimg = lds;
    LAS unsigned char* Vimg = lds + 65536;
    LAS float* kap = (LAS float*)(lds + 98304);
    LAS float* gb = kap + 2304;
    LAS float* ib = gb + 2304;
    LAS float* cs = ib + 2304;
    for (int e = tid; e < 2304; e += NTHREADS) { const int j = e >> 7, tau = e & 127, a = chunk_of_step(j, dir), t = dir ? 127 - tau : tau;
        const float* gp = GT + (size_t)(chunk_row0(b, a) + t) * 16 + dir * 8 + h; ib[e] = gp[0]; gb[e] = log_sigmoid(gp[4]); }
    __syncthreads();
    for (int j = wave; j < 18; j += NWAVES) {
        const float x0 = gb[j * 128 + 2 * lane], x1 = gb[j * 128 + 2 * lane + 1];
        const float sc = wave_incl_add(x0 + x1, lane);
        const float b0 = sc - x1, b1 = sc, g0 = ib[j * 128 + 2 * lane] - b0, g1 = ib[j * 128 + 2 * lane + 1] - b1;
        const float ip = wave_incl_max(fmaxf(g0, g1), lane);
        float ex = lane_get(ip, lane - 1); if (lane == 0) ex = -INFINITY;
        gb[j * 128 + 2 * lane] = g0; gb[j * 128 + 2 * lane + 1] = g1;
        ib[j * 128 + 2 * lane] = fmaxf(ex, g0); ib[j * 128 + 2 * lane + 1] = ip;
        kap[j * 128 + 2 * lane] = b0; kap[j * 128 + 2 * lane + 1] = b1;
        const float pm = lane_get(ip, 63), bl = lane_get(sc, 63);
        if (lane == 0) { cs[j] = bl; cs[32 + j] = pm; }
    }
    __syncthreads();
    if (tid < 18) { float m = 0.f, mp = 0.f, Ml = 0.f;
        for (int j = 0; j <= tid; ++j) { mp = m; Ml = fmaxf(m, cs[32 + j]); m = cs[j] + Ml; }
        cs[64 + tid] = __expf(mp - Ml); cs[96 + tid] = Ml; cs[128 + tid] = mp; }
    __syncthreads();
    float kv[5];
#pragma unroll
    for (int i = 0; i < 5; ++i) { const int e = tid + NTHREADS * i; kv[i] = 0.f;
        if (e < 2304) { const int j = e >> 7, tau = e & 127;
            const float g = gb[e], pm = ib[e], bb = kap[e], mp = cs[128 + j], M = fmaxf(mp, pm);
            if (dvh == 0) { const int a = chunk_of_step(j, dir), t = dir ? 127 - tau : tau; float* tp = TAB + (size_t)(seq * 18 + a) * 512 + t;
                tp[0] = g; tp[128] = M; tp[256] = __expf(mp - M); tp[384] = __expf(-(bb + M)); }
            kv[i] = __expf(g - cs[96 + j]); } }
    __syncthreads();
    LAS float* kpn = gb;
#pragma unroll
    for (int i = 0; i < 5; ++i) { const int e = tid + NTHREADS * i; if (e < 2304) { const int j = e >> 7, tau = e & 127; kpn[j * 128 + (dir ? 127 - tau : tau)] = kv[i]; } }
    __syncthreads();

    const int r = lane & 31, hh = lane >> 5, i16 = lane & 15, q = i16 >> 2, p = i16 & 3, blk = (lane >> 4) & 1;
    const int dkt = wave & 3, dvt = wave >> 2;
    f32x16 acc;
#pragma unroll
    for (int i = 0; i < 16; ++i) acc[i] = 0.f;
    float nn = 0.f;
    v4u kA[4], vA[2], kB[4], vB[2];
    ST_LOAD(kA, vA, 0); ST_WRITE(kA, vA, 0); ST_LOAD(kB, vB, 1);
#pragma unroll 1
    for (int jj = 0; jj < 18; jj += 2) {
        ST_STEP(jj, kA, vA, kB, vB);
        ST_STEP(jj + 1, kB, vB, kA, vA);
    }
    __syncthreads();
}
#undef ST_LOAD
#undef ST_WRITE
#undef ST_STEP

template <int TB>
__device__ __forceinline__ void mlstm_weights(const f32x16 (&S)[4], bf16x8_t (&pb)[4][2], const LAS float* GA, int t, int hh, int lane, float qnf, float qnb, float& sff, float& sfb) {
    const float Mf = GA[128 + t], Mb = GA[512 + 128 + t];
    float rsf = 0.f, rsb = 0.f;
#pragma unroll
    for (int st = 0; st < 4; ++st) {
#pragma unroll
        for (int g = 0; g < 4; ++g) {
            const int s0 = 32 * st + 8 * g + 4 * hh;
            if (st < TB) { const f32x4 gv = *(const LAS f32x4*)(GA + s0);
#pragma unroll
                for (int e = 0; e < 4; ++e) rsf += S[st][4 * g + e] * __expf(gv[e] - Mf);
            } else if (st > TB) { const f32x4 gv = *(const LAS f32x4*)(GA + 512 + s0);
#pragma unroll
                for (int e = 0; e < 4; ++e) rsb += S[st][4 * g + e] * __expf(gv[e] - Mb);
            } else { const f32x4 gf = *(const LAS f32x4*)(GA + s0), gbv = *(const LAS f32x4*)(GA + 512 + s0);
#pragma unroll
                for (int e = 0; e < 4; ++e) { const float dts = (float)(t - (s0 + e));
                    const float wf = __expf(gf[e] - Mf + fminf(dts, 0.f) * 1e30f), wb = __expf(gbv[e] - Mb - fmaxf(dts, 0.f) * 1e30f);
                    rsf += S[st][4 * g + e] * wf; rsb += S[st][4 * g + e] * wb; }
            }
        }
        __builtin_amdgcn_sched_barrier(0);
    }
    rsf += lane_get(rsf, lane ^ 32); rsb += lane_get(rsb, lane ^ 32);
    const float alf = GA[256 + t], alb = GA[512 + 256 + t];
    const float invf = 1.0f / fmaxf(fabsf(alf * qnf + rsf), GA[384 + t]), invb = 1.0f / fmaxf(fabsf(alb * qnb + rsb), GA[512 + 384 + t]);
    sff = alf * invf; sfb = alb * invb;
    __builtin_amdgcn_sched_barrier(0);
    float Mf2 = Mf, Mb2 = Mb; asm volatile("" : "+v"(Mf2), "+v"(Mb2));
#pragma unroll
    for (int st = 0; st < 4; ++st) {
        float pv[16];
#pragma unroll
        for (int g = 0; g < 4; ++g) {
            const int s0 = 32 * st + 8 * g + 4 * hh;
            if (st < TB) { const f32x4 gv = *(const LAS f32x4*)(GA + s0);
#pragma unroll
                for (int e = 0; e < 4; ++e) pv[4 * g + e] = S[st][4 * g + e] * (__expf(gv[e] - Mf2) * invf);
            } else if (st > TB) { const f32x4 gv = *(const LAS f32x4*)(GA + 512 + s0);
#pragma unroll
                for (int e = 0; e < 4; ++e) pv[4 * g + e] = S[st][4 * g + e] * (__expf(gv[e] - Mb2) * invb);
            } else { const f32x4 gf = *(const LAS f32x4*)(GA + s0), gbv = *(const LAS f32x4*)(GA + 512 + s0);
#pragma unroll
                for (int e = 0; e < 4; ++e) { const float dts = (float)(t - (s0 + e));
                    const float wf = __expf(gf[e] - Mf2 + fminf(dts, 0.f) * 1e30f), wb = __expf(gbv[e] - Mb2 - fmaxf(dts, 0.f) * 1e30f);
                    pv[4 * g + e] = S[st][4 * g + e] * (wf * invf + wb * invb); }
            }
        }
#pragma unroll
        for (int sp = 0; sp < 2; ++sp) { v4u w; w.x = cvtpk(pv[8 * sp], pv[8 * sp + 1]); w.y = cvtpk(pv[8 * sp + 2], pv[8 * sp + 3]); w.z = cvtpk(pv[8 * sp + 4], pv[8 * sp + 5]); w.w = cvtpk(pv[8 * sp + 6], pv[8 * sp + 7]);
            pb[st][sp] = __builtin_bit_cast(bf16x8_t, w); }
        __builtin_amdgcn_sched_barrier(0);
    }
}

__device__ __forceinline__ void mlstm_out_phase(const bf16* Q, const bf16* K, const bf16* V, const bf16* OG, const bf16* CT, const float* NS, const float* TAB,
                                                const float* mg, bf16* Y, int abase, int G, LAS unsigned char* lds, int tid) {
    asm volatile("" : "+v"(tid));
    const int wave = __builtin_amdgcn_readfirstlane(tid >> 6);
    const int na = 18 - abase, nitems = 64 * na;
    int it = blockIdx.x;
    if (it >= nitems) return;
    LAS unsigned char* Kimg = lds; LAS unsigned char* Vimg = lds + 32768; LAS unsigned char* Cf = lds + 65536; LAS unsigned char* Cb = lds + 98304;
    LAS float* GA = (LAS float*)(lds + MX_OFF);
    LAS float* NSL = GA + 1024;
    LAS float* SSQ = NSL + 256;
    const int tb = wave & 3, dh = wave >> 2;
    v4u kr[4], vr[4], tabr; float nsr[4];
#define OUT_PREFETCH(item_) do { const int bh_ = (item_) / na, a_ = abase + (item_) % na, b_ = bh_ >> 2, h_ = bh_ & 3, row0_ = chunk_row0(b_, a_), sq_ = (b_ * 4 + h_) * 2; \
        _Pragma("unroll") for (int i = 0; i < 4; ++i) { const int pc = tid + NTHREADS * i; const size_t go = (size_t)(row0_ + (pc >> 4)) * HW + h_ * 128 + (pc & 15) * 8; kr[i] = *(const v4u*)(K + go); vr[i] = *(const v4u*)(V + go); } \
        if (tid < 256) tabr = *(const v4u*)(TAB + (size_t)((sq_ + (tid >> 7)) * 18 + a_) * 512 + (tid & 127) * 4); \
        else { const int e_ = tid - 256; const float* np_ = NS + (size_t)((sq_ + (e_ >> 7)) * 18 + a_) * 256 + (e_ & 127); nsr[0] = np_[0]; nsr[1] = np_[128]; nsr[2] = 0.f; nsr[3] = 0.f; } } while (0)
    OUT_PREFETCH(it);
#pragma unroll 1
    for (;;) {
        asm volatile("" : "+v"(tid));
        const int lane = tid & 63, r = lane & 31, hh = lane >> 5, i16 = lane & 15, q = i16 >> 2, p = i16 & 3, blk = (lane >> 4) & 1;
        const int t = 32 * tb + r;
        const int bh = it / na, a = abase + it % na, b = bh >> 2, h = bh & 3;
        const int row0 = chunk_row0(b, a), seqf = (b * 4 + h) * 2, seqb = seqf + 1;
#pragma unroll
        for (int i = 0; i < 4; ++i) { const int pc = tid + NTHREADS * i, so = swz_off(pc >> 4, pc & 15); *(LAS v4u*)(Kimg + so) = kr[i]; *(LAS v4u*)(Vimg + so) = vr[i]; }
        if (tid < 256) *(LAS v4u*)(GA + (tid >> 7) * 512 + (tid & 127) * 4) = tabr;
        else NSL[tid - 256] = (nsr[0] + nsr[1]) + (nsr[2] + nsr[3]);
        bf16x8_t qf[8];
#pragma unroll
        for (int ks = 0; ks < 8; ++ks) qf[ks] = *(const bf16x8_t*)(Q + (size_t)(row0 + t) * HW + h * 128 + 16 * ks + 8 * hh);
        __syncthreads();
        f32x16 S[4];
#pragma unroll
        for (int st = 0; st < 4; ++st)
#pragma unroll
            for (int i = 0; i < 16; ++i) S[st][i] = 0.f;
        int la = lane; asm volatile("" : "+v"(la));
        const int ra = la & 31, ha = la >> 5;
#pragma unroll
        for (int ks = 0; ks < 8; ++ks) {
#pragma unroll
            for (int st = 0; st < 4; ++st) { const bf16x8_t A = *(const LAS bf16x8_t*)(Kimg + swz_off(32 * st + ra, 2 * ks + ha)); S[st] = MFMA32(A, qf[ks], S[st]); }
            __builtin_amdgcn_sched_barrier(0); }
        { const unsigned char* cfp = (const unsigned char*)(CT + (size_t)(seqf * 18 + a) * 16384); const unsigned char* cbp = (const unsigned char*)(CT + (size_t)(seqb * 18 + a) * 16384);
#pragma unroll
          for (int i = 0; i < 4; ++i) { const int n = 4 * wave + i, row = 4 * n + (lane >> 4), dc = (lane & 15) ^ (((row & 3) << 2) | ((row >> 2) & 3)); const int go = row * 256 + dc * 16;
              __builtin_amdgcn_global_load_lds((const unsigned*)(cfp + go), (LAS unsigned*)(Cf + n * 1024), 16, 0, 0);
              __builtin_amdgcn_global_load_lds((const unsigned*)(cbp + go), (LAS unsigned*)(Cb + n * 1024), 16, 0, 0); } }
        __builtin_amdgcn_sched_barrier(0);
        float qnf = 0.f, qnb = 0.f;
#pragma unroll
        for (int ks = 0; ks < 8; ++ks)
#pragma unroll
            for (int j = 0; j < 8; ++j) { const float qv = bf2f((unsigned short)qf[ks][j]); const int dk = 16 * ks + 8 * hh + j; qnf += qv * NSL[dk]; qnb += qv * NSL[128 + dk]; }
        qnf += lane_get(qnf, lane ^ 32); qnb += lane_get(qnb, lane ^ 32);
        __builtin_amdgcn_sched_barrier(0);
        bf16x8_t pb[4][2];
        float sff, sfb;
        switch (tb) {
            case 0: mlstm_weights<0>(S, pb, GA, t, hh, lane, qnf, qnb, sff, sfb); break;
            case 1: mlstm_weights<1>(S, pb, GA, t, hh, lane, qnf, qnb, sff, sfb); break;
            case 2: mlstm_weights<2>(S, pb, GA, t, hh, lane, qnf, qnb, sff, sfb); break;
            default: mlstm_weights<3>(S, pb, GA, t, hh, lane, qnf, qnb, sff, sfb); break;
        }
        __builtin_amdgcn_sched_barrier(0);
        const int itn = it + G; const bool more = itn < nitems;
        bf16x8_t qf2[8];
#pragma unroll
        for (int ks = 0; ks < 8; ++ks) qf2[ks] = *(const bf16x8_t*)(Q + (size_t)(row0 + t) * HW + h * 128 + 16 * ks + 8 * hh);
        __syncthreads();
        if (more) OUT_PREFETCH(itn);
        f32x16 Hc[2];
#pragma unroll
        for (int d = 0; d < 2; ++d)
#pragma unroll
            for (int i = 0; i < 16; ++i) Hc[d][i] = 0.f;
        int lb_ = lane; asm volatile("" : "+v"(lb_));
        const int hb = lb_ >> 5, qb = (lb_ & 15) >> 2, pb_ = lb_ & 3, blkb = (lb_ >> 4) & 1;
#pragma unroll
        for (int d = 0; d < 2; ++d) { const int dvt = 2 * dh + d;
#pragma unroll
            for (int st = 0; st < 4; ++st)
#pragma unroll
                for (int sp = 0; sp < 2; ++sp) { const int vrow = 32 * st + 16 * sp + 4 * hb + qb, vch = 4 * dvt + 2 * blkb + (pb_ >> 1);
                    const bf16x8_t A = cat8(tr16(Vimg + swz_off(vrow, vch) + 8 * (pb_ & 1)), tr16(Vimg + swz_off(vrow + 8, vch) + 8 * (pb_ & 1))); Hc[d] = MFMA32(A, pb[st][sp], Hc[d]); if (sp) __builtin_amdgcn_sched_barrier(0); } }
        v2u ogr[2][4];
#pragma unroll
        for (int d = 0; d < 2; ++d)
#pragma unroll
            for (int g = 0; g < 4; ++g) ogr[d][g] = *(const v2u*)(OG + (size_t)(row0 + t) * HW + h * 128 + 32 * (2 * dh + d) + 8 * g + 4 * hh);
        __builtin_amdgcn_sched_barrier(0);
#pragma unroll
        for (int dd = 0; dd < 2; ++dd) {
            int lc = lane; asm volatile("" : "+v"(lc)); const int rc = lc & 31, hc = lc >> 5;
            const float sfac = dd ? sfb : sff; const LAS unsigned char* Cimg = dd ? Cb : Cf;
            bf16x8_t qs[8];
#pragma unroll
            for (int ks = 0; ks < 8; ++ks) { v4u w;
                w.x = cvtpk(bf2f((unsigned short)qf2[ks][0]) * sfac, bf2f((unsigned short)qf2[ks][1]) * sfac); w.y = cvtpk(bf2f((unsigned short)qf2[ks][2]) * sfac, bf2f((unsigned short)qf2[ks][3]) * sfac);
                w.z = cvtpk(bf2f((unsigned short)qf2[ks][4]) * sfac, bf2f((unsigned short)qf2[ks][5]) * sfac); w.w = cvtpk(bf2f((unsigned short)qf2[ks][6]) * sfac, bf2f((unsigned short)qf2[ks][7]) * sfac);
                qs[ks] = __builtin_bit_cast(bf16x8_t, w); }
#pragma unroll
            for (int d = 0; d < 2; ++d) { const int dvt = 2 * dh + d;
#pragma unroll
                for (int ks = 0; ks < 8; ++ks) { const bf16x8_t A = *(const LAS bf16x8_t*)(Cimg + swz_off(32 * dvt + rc, 2 * ks + hc)); Hc[d] = MFMA32(A, qs[ks], Hc[d]); if (ks & 1) __builtin_amdgcn_sched_barrier(0); } }
        }
        __builtin_amdgcn_sched_barrier(0);
        float ss = 0.f;
#pragma unroll
        for (int d = 0; d < 2; ++d)
#pragma unroll
            for (int i = 0; i < 16; ++i) ss += Hc[d][i] * Hc[d][i];
        ss += lane_get(ss, lane ^ 32);
        if (hh == 0) SSQ[dh * 128 + t] = ss;
        LDS_BARRIER();
        const float rr = 1.0f / sqrtf((SSQ[t] + SSQ[128 + t]) * (1.0f / 128.0f) + EPS);
#pragma unroll
        for (int d = 0; d < 2; ++d)
#pragma unroll
            for (int g = 0; g < 4; ++g) { const int dv = 32 * (2 * dh + d) + 8 * g + 4 * hh;
                const v2u og = ogr[d][g]; const f32x4 gg = *(const f32x4*)(mg + h * 128 + dv);
                v2u o; o.x = cvtpk(Hc[d][4 * g] * rr * gg.x * bflo(og.x), Hc[d][4 * g + 1] * rr * gg.y * bfhi(og.x)); o.y = cvtpk(Hc[d][4 * g + 2] * rr * gg.z * bflo(og.y), Hc[d][4 * g + 3] * rr * gg.w * bfhi(og.y));
                *(v2u*)(Y + (size_t)(row0 + t) * D + h * 128 + dv) = o; }
        if (!more) break;
        it = itn;
    }
#undef OUT_PREFETCH
    __syncthreads();
}
__device__ __forceinline__ void sgu_item_mfma(const bf16* Z, const float* lg, const float* lb, const bf16* swb, const float* sb, bf16* Y, int chunk, LAS unsigned char* lds, int tid) {
    asm volatile("" : "+v"(tid));
    const int lane = tid & 63, wave = __builtin_amdgcn_readfirstlane(tid >> 6);
    const int row0 = chunk * 128;
    LAS unsigned char* VN = lds;
    const int r = lane & 31, hh = lane >> 5, i16 = lane & 15, q = i16 >> 2, p = i16 & 3, blk = (lane >> 4) & 1;
    const int g = wave >> 1, ct = wave & 1;
    const bf16* wg = swb + (size_t)g * 128 * 128;
#define SGU_LOAD(BF, UU, BS, pt_) do { _Pragma("unroll") for (int ks = 0; ks < 8; ++ks) BF[ks] = *(const bf16x8_t*)(wg + (size_t)(32 * (pt_) + r) * 128 + 16 * ks + 8 * hh); \
        BS = sb[g * 128 + 32 * (pt_) + r]; \
        _Pragma("unroll") for (int gq = 0; gq < 4; ++gq) UU[gq] = *(const v2u*)(Z + (size_t)(row0 + 32 * (pt_) + r) * 512 + 64 * g + 32 * ct + 8 * gq + 4 * hh); } while (0)
#define SGU_TILE(BF, UU, BS, pt_) do { f32x16 acc; _Pragma("unroll") for (int i = 0; i < 16; ++i) acc[i] = 0.f; \
        _Pragma("unroll") for (int ks = 0; ks < 8; ++ks) acc = MFMA32(af[ks], BF[ks], acc); \
        const int tok = row0 + 32 * (pt_) + r; \
        _Pragma("unroll") for (int gq = 0; gq < 4; ++gq) { const int ch = 64 * g + 32 * ct + 8 * gq + 4 * hh; const v2u u = UU[gq]; \
            v2u o; o.x = cvtpk(bflo(u.x) * (acc[4 * gq] + BS), bfhi(u.x) * (acc[4 * gq + 1] + BS)); o.y = cvtpk(bflo(u.y) * (acc[4 * gq + 2] + BS), bfhi(u.y) * (acc[4 * gq + 3] + BS)); \
            *(v2u*)(Y + (size_t)tok * D + 512 + ch) = o; } } while (0)
    bf16x8_t bfA[8], bfB[8]; v2u uA[4], uB[4]; float bsA, bsB;
    SGU_LOAD(bfA, uA, bsA, 0);
    {
        const int l16 = lane & 15, tq = lane >> 4;
        f32x4 gg[4], bb[4];
#pragma unroll
        for (int c = 0; c < 4; ++c) { gg[c] = *(const f32x4*)(lg + l16 * 16 + 4 * c); bb[c] = *(const f32x4*)(lb + l16 * 16 + 4 * c); }
        v4u raw[4][2];
#pragma unroll
        for (int tt = 0; tt < 4; ++tt) { const bf16* zp = Z + (size_t)(row0 + wave * 16 + 4 * tt + tq) * 512 + 256 + l16 * 16; raw[tt][0] = *(const v4u*)zp; raw[tt][1] = *(const v4u*)(zp + 8); }
#pragma unroll
        for (int tt = 0; tt < 4; ++tt) { const int t = wave * 16 + 4 * tt + tq;
            float x[16];
#pragma unroll
            for (int c = 0; c < 2; ++c) { x[8 * c] = bflo(raw[tt][c].x); x[8 * c + 1] = bfhi(raw[tt][c].x); x[8 * c + 2] = bflo(raw[tt][c].y); x[8 * c + 3] = bfhi(raw[tt][c].y);
                x[8 * c + 4] = bflo(raw[tt][c].z); x[8 * c + 5] = bfhi(raw[tt][c].z); x[8 * c + 6] = bflo(raw[tt][c].w); x[8 * c + 7] = bfhi(raw[tt][c].w); }
            float s = 0.f;
#pragma unroll
            for (int c = 0; c < 16; ++c) s += x[c];
            ROW_SUM16(s);
            const float mu = s * (1.0f / 256.0f); float vs = 0.f;
#pragma unroll
            for (int c = 0; c < 16; ++c) { x[c] -= mu; vs += x[c] * x[c]; }
            ROW_SUM16(vs);
            const float rs = 1.0f / sqrtf(vs * (1.0f / 256.0f) + EPS);
            v4u o0, o1;
            o0.x = cvtpk(x[0] * rs * gg[0].x + bb[0].x, x[1] * rs * gg[0].y + bb[0].y); o0.y = cvtpk(x[2] * rs * gg[0].z + bb[0].z, x[3] * rs * gg[0].w + bb[0].w);
            o0.z = cvtpk(x[4] * rs * gg[1].x + bb[1].x, x[5] * rs * gg[1].y + bb[1].y); o0.w = cvtpk(x[6] * rs * gg[1].z + bb[1].z, x[7] * rs * gg[1].w + bb[1].w);
            o1.x = cvtpk(x[8] * rs * gg[2].x + bb[2].x, x[9] * rs * gg[2].y + bb[2].y); o1.y = cvtpk(x[10] * rs * gg[2].z + bb[2].z, x[11] * rs * gg[2].w + bb[2].w);
            o1.z = cvtpk(x[12] * rs * gg[3].x + bb[3].x, x[13] * rs * gg[3].y + bb[3].y); o1.w = cvtpk(x[14] * rs * gg[3].z + bb[3].z, x[15] * rs * gg[3].w + bb[3].w);
            *(LAS v4u*)(VN + t * 512 + l16 * 32) = o0; *(LAS v4u*)(VN + t * 512 + l16 * 32 + 16) = o1; }
    }
    __syncthreads();
    bf16x8_t af[8];
#pragma unroll
    for (int ks = 0; ks < 8; ++ks) { const LAS unsigned char* va = VN + (16 * ks + 8 * hh + q) * 512 + 2 * (64 * g + 32 * ct + 16 * blk + 4 * p); af[ks] = cat8(tr16(va), tr16(va + 4 * 512)); }
    SGU_LOAD(bfB, uB, bsB, 1); SGU_TILE(bfA, uA, bsA, 0);
    SGU_LOAD(bfA, uA, bsA, 2); SGU_TILE(bfB, uB, bsB, 1);
    SGU_LOAD(bfB, uB, bsB, 3); SGU_TILE(bfA, uA, bsA, 2);
    SGU_TILE(bfB, uB, bsB, 3);
#undef SGU_LOAD
#undef SGU_TILE
    __syncthreads();
}

__device__ __forceinline__ void conv_wave_item(const bf16* YC, const float* cw, const float* cb, float* CV, int item, int lane) {
    int base, stride, len, p0, ch0;
    if (item < 1024) { const int b = item >> 6, gr = (item >> 1) & 31; base = b * SEQ + gr * 64; stride = 1; len = 64; p0 = 32 * (item & 1); ch0 = 0; }
    else if (item < 2048) { const int it = item - 1024, b = it >> 6, c = it & 63; base = b * SEQ + c; stride = 64; len = 32; p0 = 0; ch0 = 128; }
    else { const int it = item - 2048, b = it >> 4, half = (it >> 3) & 1, sg = it & 7; base = ML + b * CTXL; stride = 1; len = 256; p0 = 32 * sg; ch0 = 128 * half; }
    const int ch = ch0 + 2 * lane;
    unsigned xin[62];
#pragma unroll
    for (int pp = 0; pp < 62; ++pp) { const int pos = p0 + pp - 15;
        xin[pp] = (pos >= 0 && pos < len) ? *(const unsigned*)(YC + (size_t)(base + pos * stride) * 256 + ch) : 0u; }
    f32x2 wk[31];
#pragma unroll
    for (int k = 0; k < 31; ++k) wk[k] = *(const f32x2*)(cw + k * 256 + ch);
    const f32x2 bias = *(const f32x2*)(cb + ch);
#pragma unroll
    for (int o = 0; o < 32; ++o) { f32x2 acc = bias;
#pragma unroll
        for (int k = 0; k < 31; ++k) { const unsigned w = xin[o + k]; acc.x += wk[k].x * bflo(w); acc.y += wk[k].y * bfhi(w); }
        *(f32x2*)(CV + (size_t)(base + (p0 + o) * stride) * 256 + ch) = acc; }
}

__device__ __forceinline__ void conv_finalize(const float* CV, const float* lg, const float* lb, bf16* Y, int nrows, int G, int tid) {
    asm volatile("" : "+v"(tid));
    const int lane = tid & 63, wave = __builtin_amdgcn_readfirstlane(tid >> 6);
    const int gw = blockIdx.x * NWAVES + wave, NGW = G * NWAVES;
    const int l16 = lane & 15, tq = lane >> 4;
    f32x4 gg[4], bb[4];
#pragma unroll
    for (int c = 0; c < 4; ++c) { gg[c] = *(const f32x4*)(lg + l16 * 16 + 4 * c); bb[c] = *(const f32x4*)(lb + l16 * 16 + 4 * c); }
#pragma unroll 2
    for (int r4 = gw; r4 < nrows / 4; r4 += NGW) {
        const int r = 4 * r4 + tq;
        f32x4 x[4];
#pragma unroll
        for (int c = 0; c < 4; ++c) x[c] = *(const f32x4*)(CV + (size_t)r * 256 + l16 * 16 + 4 * c);
        float s = 0.f;
#pragma unroll
        for (int c = 0; c < 4; ++c) s += (x[c].x + x[c].y) + (x[c].z + x[c].w);
        ROW_SUM16(s);
        const float mu = s * (1.0f / 256.0f); float vs = 0.f;
#pragma unroll
        for (int c = 0; c < 4; ++c) { x[c] = x[c] - mu; vs += (x[c].x * x[c].x + x[c].y * x[c].y) + (x[c].z * x[c].z + x[c].w * x[c].w); }
        ROW_SUM16(vs);
        const float rs = 1.0f / sqrtf(vs * (1.0f / 256.0f) + EPS);
        unsigned o[8];
#pragma unroll
        for (int c = 0; c < 4; ++c) { f32x4 y = x[c] * rs * gg[c] + bb[c];
            y.x *= fsigmoid(y.x); y.y *= fsigmoid(y.y); y.z *= fsigmoid(y.z); y.w *= fsigmoid(y.w);
            o[2 * c] = cvtpk(y.x, y.y); o[2 * c + 1] = cvtpk(y.z, y.w); }
        bf16* yp = Y + (size_t)r * D + 768 + l16 * 16;
        *(v4u*)yp = (v4u){o[0], o[1], o[2], o[3]}; *(v4u*)(yp + 8) = (v4u){o[4], o[5], o[6], o[7]};
    }
}
constexpr int N_PHASES = 18;
#ifndef MK_ONE_LAUNCH
#define MK_ONE_LAUNCH 0
#endif
#ifndef PH_MASK
#define PH_MASK 0x3ff
#endif
#ifndef REP_MASK
#define REP_MASK 0
#endif
#ifndef DEFER
#define DEFER 1
#endif
#ifndef SUBREP
#define SUBREP 0
#endif
#define SUBREPS(b) ((((SUBREP) >> (b)) & 1) + 1)
#define PH_EN(b) (((PH_MASK) >> (b)) & 1)

__global__ void __launch_bounds__(NTHREADS, 2) fwd_kernel(Args args) {
    extern __shared__ __attribute__((aligned(16))) unsigned char lds_raw[];
    LAS unsigned char* lds = (LAS unsigned char*)lds_raw;
    const int G = gridDim.x;
    unsigned char* ws = args.ws;
    volatile LAS unsigned* MISC = (volatile LAS unsigned*)(lds + MISC_OFF);
    for (int u = threadIdx.x; u < (LDS_BYTES - RING_BYTES) / 4; u += NTHREADS) ((LAS unsigned*)(lds + RING_BYTES))[u] = 0u;
    __syncthreads();
    XcdBarrier bar; bar.bar = (unsigned*)(ws + WS_CTL) + 4096; bar.x = 0; bar.st = nullptr;
    const int lo = args.ph_lo, hi = args.ph_hi;
    if (hi - lo > 1) bar = xcd_barrier_post((unsigned*)(ws + WS_CTL) + 4096, MISC + 8);
#define IN(k) (lo <= (k) && (k) < hi)
#define SEAM(k) do { if (IN(k) && IN((k) + 1)) xcd_barrier(bar); } while (0)

#pragma unroll 1
    for (int ph = lo; ph < hi; ++ph) {
#if REP_MASK
#pragma unroll 1
      for (int rep = 0; rep < ((ph >= 1 && ph <= 16 && (((REP_MASK) >> ((ph - 1) & 7)) & 1)) ? 2 : 1); ++rep) {
#else
      {
#endif
        int tid = threadIdx.x; asm volatile("" : "+v"(tid));
        const int lane = tid & 63, wave = __builtin_amdgcn_readfirstlane(tid >> 6);
        if (ph == 0) { if (PH_EN(8)) phase_prologue(args, lds, G, tid, lane, wave); }
        else if (ph == N_PHASES - 1) { if (PH_EN(9)) phase_final(args.out, args.in[I_FG], G, lane, wave); }
        else {
            const int l = (ph - 1) >> 3, k = (ph - 1) & 7;
            if (DEFER && (k == 5 || (k == 0 && l == 1))) continue;
            {
            const bool last = (l == DEPTH - 1);
            const int mrest = last ? ML : MT;
            const float* modl = (const float*)(ws + WS_MOD) + (size_t)l * 17 * MODW;
            const unsigned char* wl = ws + WS_W + (size_t)l * W_LAYER;
            if (k == 0 && PH_EN(0)) {
                phase_norm(l == 0 ? args.in[I_X] : args.out, l == 0 ? args.in[I_CTX] : (const float*)(ws + WS_XC), (bf16*)(ws + WS_A), args.in[I_N1G] + l * D, modl, 0, MT, G, lane, wave);
                if (DEFER) phase_shifts(args, lds, G, tid);
            } else if (k == 1 && PH_EN(1)) {
                int tk1 = tid; asm volatile("" : "+v"(tk1));
                pg8::Gemm g{(const bf16*)(ws + WS_A), (const bf16*)(wl + WO_IN), MT, NIN, D}; pg8::InLastOrder S; S.init(last, G, (int)blockIdx.x);
                pg8::EpiIn E{ws + WS_P, (!DEFER || l == 0) ? (const float*)(ws + WS_BIN) + l * NIN : (const float*)(ws + WS_SHIN), (!DEFER || l == 0) ? 0 : NIN, (!DEFER || l == 0) ? nullptr : (const float*)(ws + WS_SS) + 2 * MT};
                pg8::gemm_phase<pg8::EpiIn, pg8::InLastOrder, true, true>(lds, g, S, E, tk1);
                if (l == 0 && G == 256 && blockIdx.x >= 80)
                    transpose_range(args, lds, TI_IN, TI_LAYER - TI_IN, (blockIdx.x - 80) * NWAVES + wave, 176 * NWAVES, lane, wave);
            } else if (k == 2 && PH_EN(2)) {
                for (int rp = 0; rp < SUBREPS(0); ++rp)
                for (int it = blockIdx.x; it < 256; it += G)
                    mlstm_state_item((const bf16*)(ws + WS_K), (const bf16*)(ws + WS_V), (const float*)(ws + WS_GT), (bf16*)(ws + WS_CT), (float*)(ws + WS_NS), (float*)(ws + WS_TAB), it, !last, lds, tid);
                const int nch = mrest / 128;
                for (int rp = 0; rp < SUBREPS(1); ++rp)
                for (int it = blockIdx.x; it < nch; it += G)
                    sgu_item_mfma((const bf16*)(ws + WS_Z), args.in[I_SLG] + l * 256, args.in[I_SLB] + l * 256, (const bf16*)(ws + WS_SWB) + (size_t)l * 4 * 128 * 128, args.in[I_SB] + l * 4 * 128, (bf16*)(ws + WS_Y), it, lds, tid);
                { int tid2 = tid; asm volatile("" : "+v"(tid2)); const int lane2 = tid2 & 63, wave2 = __builtin_amdgcn_readfirstlane(tid2 >> 6);
                  const int ncv = last ? 2048 : 2304;
#pragma unroll 1
                  for (int rp = 0; rp < SUBREPS(2); ++rp)
#pragma unroll 1
                  for (int it = (int)((blockIdx.x + G / 2) % G) * NWAVES + wave2; it < ncv; it += G * NWAVES)
                      conv_wave_item((const bf16*)(ws + WS_YC), args.in[I_CW] + l * 31 * 256, args.in[I_CB] + l * 256, (float*)(ws + WS_CV), it, lane2); }
            } else if (k == 3 && PH_EN(3)) {
                for (int rp = 0; rp < SUBREPS(3); ++rp)
                mlstm_out_phase((const bf16*)(ws + WS_Q), (const bf16*)(ws + WS_K), (const bf16*)(ws + WS_V), (const bf16*)(ws + WS_OG), (const bf16*)(ws + WS_CT), (const float*)(ws + WS_NS), (const float*)(ws + WS_TAB),
                                args.in[I_MG] + l * HW, (bf16*)(ws + WS_Y), last ? 2 : 0, G, lds, tid);
                for (int rp = 0; rp < SUBREPS(4); ++rp)
                conv_finalize((const float*)(ws + WS_CV), args.in[I_CLG] + l * 256, args.in[I_CLB] + l * 256, (bf16*)(ws + WS_Y), mrest, G, tid);
            } else if (k == 4 && PH_EN(4)) {
                int tk2 = tid; asm volatile("" : "+v"(tk2));
                pg8::Gemm g{(const bf16*)(ws + WS_Y), (const bf16*)(wl + WO_OUT), mrest, D, D}; pg8::StaticOrder S; S.init(mrest, D, G, (int)blockIdx.x);
                pg8::EpiRes<DEFER != 0> E{l == 0 ? args.in[I_X] : args.out, args.out, l == 0 ? args.in[I_CTX] : (const float*)(ws + WS_XC), (float*)(ws + WS_XC), modl + 2 * D, ML,
                              (bf16*)(ws + WS_A), (const float*)(ws + WS_GS) + (size_t)((l * 2 + 1) * 17) * 1024, (float*)(ws + WS_SS) + (size_t)l * MT, lds + MX_OFF};
                pg8::gemm_phase<pg8::EpiRes<DEFER != 0>, pg8::StaticOrder, true, true>(lds, g, S, E, tk2);
                if (l == 0 && G == 256 && blockIdx.x >= 64)
                    transpose_range(args, lds, TI_LAYER, TI_LAYER, (blockIdx.x - 64) * NWAVES + wave, 192 * NWAVES, lane, wave);
            } else if (k == 5 && PH_EN(5)) {
                phase_norm(args.out, (const float*)(ws + WS_XC), (bf16*)(ws + WS_A), args.in[I_N2G] + l * D, modl, 3 * D, mrest, G, lane, wave);
            } else if (k == 6 && PH_EN(6)) {
                int tk3 = tid; asm volatile("" : "+v"(tk3));
                pg8::Gemm g{(const bf16*)(ws + WS_A), (const bf16*)(wl + WO_GU), mrest, NGU, D}; pg8::StaticOrder S; S.init(mrest, NGU, G, (int)blockIdx.x);
                pg8::EpiGU E{(bf16*)(ws + WS_H), DEFER ? (const float*)(ws + WS_SS) + (size_t)l * MT : nullptr, DEFER ? (const float*)(ws + WS_SHGU) + (size_t)l * 17 * NGU : nullptr};
                pg8::gemm_phase<pg8::EpiGU, pg8::StaticOrder, true, true>(lds, g, S, E, tk3);
            } else if (PH_EN(7)) {
                int tk4 = tid; asm volatile("" : "+v"(tk4));
                pg8::Gemm g{(const bf16*)(ws + WS_H), (const bf16*)(wl + WO_DOWN), mrest, D, FF}; pg8::StaticOrder S; S.init(mrest, D, G, (int)blockIdx.x);
                pg8::EpiRes<DEFER != 0> E{args.out, args.out, (const float*)(ws + WS_XC), (float*)(ws + WS_XC), modl + 5 * D, ML,
                              (bf16*)(ws + WS_A), (const float*)(ws + WS_GS) + (size_t)(2 * 17) * 1024, (float*)(ws + WS_SS) + 2 * (size_t)MT, lds + MX_OFF};
                pg8::gemm_phase<pg8::EpiRes<DEFER != 0>, pg8::StaticOrder, true, true>(lds, g, S, E, tk4);
            }
            }
        }
      }
        if (ph + 1 < hi) xcd_barrier(bar);
    }
#undef IN
#undef SEAM
}

extern "C" void kernel_launch(void* const* d_in, const int* in_sizes, int n_in, void* d_out, int out_size, void* d_ws, size_t ws_size, hipStream_t stream) {
    static int grid = 0;
    if (grid == 0) {
        if (n_in != 23 || in_sizes[0] != ML * D || out_size != ML * D || ws_size < WS_END) {
            fprintf(stderr, "kernel_launch: unexpected problem (n_in %d, in0 %d, out %d, ws %zu < %zu); nothing launched\n", n_in, n_in > 0 ? in_sizes[0] : -1, out_size, ws_size, (size_t)WS_END); grid = -1; return; }
        int dev = 0, cus = 0, per_cu = 0;
        if (hipGetDevice(&dev) != hipSuccess || hipDeviceGetAttribute(&cus, hipDeviceAttributeMultiprocessorCount, dev) != hipSuccess) { grid = -1; return; }
        if (hipFuncSetAttribute((const void*)fwd_kernel, hipFuncAttributeMaxDynamicSharedMemorySize, LDS_BYTES) != hipSuccess) { fprintf(stderr, "kernel_launch: hipFuncSetAttribute failed\n"); grid = -1; return; }
        if (hipOccupancyMaxActiveBlocksPerMultiprocessor(&per_cu, (const void*)fwd_kernel, NTHREADS, LDS_BYTES) != hipSuccess || per_cu < 1) {
            fprintf(stderr, "kernel_launch: occupancy query reports %d blocks per CU\n", per_cu); per_cu = 1; }
        (void)hipGetLastError();
        grid = cus;
    }
    if (grid < 0) return;
    if (hipMemsetAsync((char*)d_ws + WS_CTL, 0, ZERO_BYTES, stream) != hipSuccess) { fprintf(stderr, "kernel_launch: memset failed\n"); return; }
    Args a{};
    for (int i = 0; i < 23; ++i) a.in[i] = (const float*)d_in[i];
    a.out = (float*)d_out; a.ws = (unsigned char*)d_ws;
#if MK_ONE_LAUNCH
    a.ph_lo = 0; a.ph_hi = N_PHASES;
    hipLaunchKernelGGL(fwd_kernel, dim3(grid), dim3(NTHREADS), LDS_BYTES, stream, a);
#else
    for (int p = 0; p < N_PHASES; ++p) { a.ph_lo = p; a.ph_hi = p + 1; hipLaunchKernelGGL(fwd_kernel, dim3(grid), dim3(NTHREADS), LDS_BYTES, stream, a); }
#endif
    const hipError_t le = hipPeekAtLastError();
    if (le != hipSuccess) fprintf(stderr, "kernel_launch: launch failed: %s\n", hipGetErrorName(le));
}
```
